# Optimizing an MI355X kernel written in HIP

```python
import math
import jax, jax.numpy as jnp
from jax import lax
import numpy as np

D_MODEL = 1024
BATCH = 8
SEQ = 2048
DEPTH = 4

GRID_W = 64
CTX_LEN = 256
EPS = 1e-6
D_RNN = 1024
LRU_BLOCKS = 16
LRU_BW = D_RNN // LRU_BLOCKS
CONV_W = 4
CONV_LEFT = 2
LRU_C = 8.0
ATTN_HEADS = 8
ATTN_DH = D_MODEL // (2 * ATTN_HEADS)
D_QK = ATTN_HEADS * 2 * ATTN_DH
D_V = ATTN_HEADS * 2 * ATTN_DH
Q_BLOCK = 128
ROPE_THETA = 10000.0
ROPE_FREQS = ATTN_DH // 4
PEER_HEADS = 8
N_KEYS = 128
N_EXPERTS = N_KEYS * N_KEYS
PEER_DQ = 128
PEER_TOPK = 16
PEER_CHUNK = 32
D_IN = 2 * D_RNN + 2 * D_QK + D_V + 2 * D_MODEL
SPLIT_AT = (D_RNN, 2 * D_RNN, 2 * D_RNN + D_QK, 2 * D_RNN + 2 * D_QK,
            2 * D_RNN + 2 * D_QK + D_V, 2 * D_RNN + 2 * D_QK + D_V + D_MODEL)

kernel_name = 'hybrid_rglru_diffattn_peer_dit'


def rmsnorm(x, g):
    xf = x.astype(jnp.float32)
    y = xf * lax.rsqrt(jnp.mean(xf * xf, axis=-1, keepdims=True) + EPS)
    return (y * g.astype(jnp.float32)).astype(x.dtype)


def modulate(h, shift, scale):
    return h * (1.0 + scale) + shift


def dwconv_centred(x, w, b):
    L = x.shape[1]
    xp = jnp.pad(x, ((0, 0), (CONV_LEFT, CONV_W - 1 - CONV_LEFT), (0, 0)))
    y = b
    for k in range(CONV_W):
        y = y + xp[:, k:k + L] * w[k]
    return y


def block_diag_linear(x, w, b):
    B, L, _ = x.shape
    xb = x.reshape(B, L, LRU_BLOCKS, LRU_BW)
    return jnp.einsum('blni,nij->blnj', xb, w).reshape(B, L, D_RNN) + b


def rglru_scan(u, w, b, lam, h0, reverse):
    uf = u.astype(jnp.float32)
    rec = jax.nn.sigmoid(block_diag_linear(u, w[0], b[0]).astype(jnp.float32))
    inp = jax.nn.sigmoid(block_diag_linear(u, w[1], b[1]).astype(jnp.float32))
    log_a = -LRU_C * rec * jax.nn.softplus(-lam.astype(jnp.float32))
    a = jnp.exp(log_a)
    drive = jnp.sqrt(-jnp.expm1(2.0 * log_a)) * (inp * uf)
    edge = -1 if reverse else 0
    drive = drive.at[:, edge].add(a[:, edge] * h0)

    def combine(earlier, later):
        return (earlier[0] * later[0], later[0] * earlier[1] + later[1])

    _, h = lax.associative_scan(combine, (a, drive), reverse=reverse, axis=1)
    return h, (h[:, 0] if reverse else h[:, -1])


def axial_rope_tables(n_tokens):
    rows = n_tokens // GRID_W
    row, col = jnp.meshgrid(jnp.arange(rows), jnp.arange(GRID_W), indexing='ij')
    pos = jnp.stack([row.reshape(-1), col.reshape(-1)], axis=-1).astype(jnp.float32)
    inv = ROPE_THETA ** (-jnp.arange(ROPE_FREQS, dtype=jnp.float32) / ROPE_FREQS)
    ang = pos[:, :, None] * inv
    return jnp.cos(ang), jnp.sin(ang)


def apply_rope(x, cos, sin):
    B, L, H, M, _ = x.shape
    xr = x.astype(jnp.float32).reshape(B, L, H, M, 2, 2, ROPE_FREQS)
    x1, x2 = xr[..., 0, :], xr[..., 1, :]
    c = cos[None, :, None, None]
    s = sin[None, :, None, None]
    out = jnp.stack([x1 * c - x2 * s, x2 * c + x1 * s], axis=-2)
    return out.reshape(x.shape).astype(x.dtype)


def diff_attend(q, k, v, lam):
    B, Lq = q.shape[:2]
    nb = Lq // Q_BLOCK
    qb = q.reshape(B, nb, Q_BLOCK, ATTN_HEADS, 2, ATTN_DH).swapaxes(0, 1)
    vf = v.astype(jnp.float32)

    def one_block(qi):
        s = jnp.einsum('bqhmd,bkhmd->bhmqk', qi, k, preferred_element_type=jnp.float32)
        p = jax.nn.softmax(s, axis=-1)
        w = p[:, :, 0] - lam * p[:, :, 1]
        return jnp.einsum('bhqk,bkhe->bqhe', w, vf)

    o = lax.map(one_block, qb)
    return o.swapaxes(0, 1).reshape(B, Lq, ATTN_HEADS, 2 * ATTN_DH)


def mixer(hx, hc, w_in, conv_w, conv_b, lru_w, lru_b, lru_lam, diff_lam, subln_g,
          w_br_lru, w_br_attn, w_out, lambda_init, cos, sin, update_ctx):
    B, L, _ = hx.shape
    C = hc.shape[1]
    dt = hx.dtype
    ul, gl, ql, kl, vl, gal, gbl = jnp.split(hx @ w_in, SPLIT_AT, axis=-1)
    uc, gc, qc, kc, vc, gac, gbc = jnp.split(hc @ w_in, SPLIT_AT, axis=-1)

    uc = dwconv_centred(uc, conv_w, conv_b)
    ul = dwconv_centred(ul, conv_w, conv_b)
    h0 = jnp.zeros((B, D_RNN), jnp.float32)
    hsum_c = jnp.zeros((B, C, D_RNN), jnp.float32)
    hsum_l = jnp.zeros((B, L, D_RNN), jnp.float32)
    for d, rev in enumerate((False, True)):
        h_c, state_c = rglru_scan(uc, lru_w[d], lru_b[d], lru_lam[d], h0, rev)
        h_l, _ = rglru_scan(ul, lru_w[d], lru_b[d], lru_lam[d], state_c, rev)
        hsum_c = hsum_c + h_c
        hsum_l = hsum_l + h_l

    def lru_branch(hsum, gate):
        return (hsum * jax.nn.gelu(gate.astype(jnp.float32))).astype(dt) @ w_br_lru

    lp = diff_lam.astype(jnp.float32)
    lam = jnp.exp(jnp.sum(lp[0] * lp[1])) - jnp.exp(jnp.sum(lp[2] * lp[3])) + lambda_init
    scale = ATTN_DH ** -0.5
    ql = apply_rope(ql.reshape(B, L, ATTN_HEADS, 2, ATTN_DH), cos, sin) * scale
    kl = apply_rope(kl.reshape(B, L, ATTN_HEADS, 2, ATTN_DH), cos, sin)
    qc = qc.reshape(B, C, ATTN_HEADS, 2, ATTN_DH) * scale
    kc = kc.reshape(B, C, ATTN_HEADS, 2, ATTN_DH)
    vl = vl.reshape(B, L, ATTN_HEADS, 2 * ATTN_DH)
    vc = vc.reshape(B, C, ATTN_HEADS, 2 * ATTN_DH)

    def attn_branch(q, k, v):
        o = rmsnorm(diff_attend(q, k, v, lam), subln_g) * (1.0 - lambda_init)
        return o.reshape(q.shape[0], q.shape[1], D_V).astype(dt) @ w_br_attn

    ya_l = attn_branch(ql, jnp.concatenate([kc, kl], axis=1), jnp.concatenate([vc, vl], axis=1))
    out_l = (jax.nn.sigmoid(gal) * lru_branch(hsum_l, gl) + jax.nn.sigmoid(gbl) * ya_l) @ w_out
    out_c = None
    if update_ctx:
        ya_c = attn_branch(qc, kc, vc)
        out_c = (jax.nn.sigmoid(gac) * lru_branch(hsum_c, gc) + jax.nn.sigmoid(gbc) * ya_c) @ w_out
    return out_l, out_c


def peer_ffn(h, wq, keys, u_tab, v_tab):
    B, L, D = h.shape
    q = (h @ wq).reshape(B, L, PEER_HEADS, 2, PEER_DQ // 2).astype(jnp.float32)
    s = jnp.einsum('blhpd,hpnd->blhpn', q, keys.astype(jnp.float32))
    v_top, i_top = lax.top_k(s, PEER_TOPK)
    cand = v_top[..., 0, :, None] + v_top[..., 1, None, :]
    best, pos = lax.top_k(cand.reshape(B, L, PEER_HEADS, PEER_TOPK * PEER_TOPK), PEER_TOPK)
    i1 = jnp.take_along_axis(i_top[..., 0, :], pos // PEER_TOPK, axis=-1)
    i2 = jnp.take_along_axis(i_top[..., 1, :], pos % PEER_TOPK, axis=-1)
    idx = i1 * N_KEYS + i2
    g = jax.nn.softmax(best, axis=-1)
    nc = L // PEER_CHUNK

    def chunk(a):
        return a.reshape((B, nc, PEER_CHUNK) + a.shape[2:]).swapaxes(0, 1)

    def body(args):
        hc, ic, gc = args
        act = jax.nn.gelu(jnp.einsum('btd,bthkd->bthk', hc, u_tab[ic]).astype(jnp.float32))
        return jnp.einsum('bthk,bthkd->btd', (act * gc).astype(h.dtype), v_tab[ic])

    y = lax.map(body, (chunk(h), chunk(idx), chunk(g)))
    return y.swapaxes(0, 1).reshape(B, L, D)


def setup_inputs(seed: int = 0) -> dict:
    key = jax.random.key(seed)
    ks = jax.random.split(key, 24)

    def nrm(k, shape, s):
        return jax.random.normal(k, shape, jnp.float32) * s

    D = D_MODEL
    u = jax.random.uniform(ks[13], (DEPTH, 2, D_RNN), jnp.float32, minval=0.9, maxval=0.999)
    a = u ** (1.0 / LRU_C)
    return {
        'x': nrm(ks[0], (BATCH, SEQ, D), 1.0),
        'c': nrm(ks[1], (BATCH, D), 1.0),
        'ctx': nrm(ks[2], (BATCH, CTX_LEN, D), 1.0),
        'c_ctx': nrm(ks[3], (D,), 1.0),
        'mod_w': nrm(ks[4], (DEPTH, D, 6 * D), 0.5 * D ** -0.5),
        'mod_b': nrm(ks[5], (DEPTH, 6 * D), 0.01),
        'norm1_g': 1.0 + nrm(ks[6], (DEPTH, D), 0.01),
        'norm2_g': 1.0 + nrm(ks[7], (DEPTH, D), 0.01),
        'w_in': nrm(ks[8], (DEPTH, D, D_IN), D ** -0.5),
        'conv_w': nrm(ks[9], (DEPTH, CONV_W, D_RNN), CONV_W ** -0.5),
        'conv_b': nrm(ks[10], (DEPTH, D_RNN), 0.01),
        'lru_w': nrm(ks[11], (DEPTH, 2, 2, LRU_BLOCKS, LRU_BW, LRU_BW), LRU_BW ** -0.5),
        'lru_b': nrm(ks[12], (DEPTH, 2, 2, D_RNN), 0.01),
        'lru_lam': jnp.log(a) - jnp.log1p(-a),
        'diff_lam': nrm(ks[14], (DEPTH, 4, ATTN_DH), 0.1),
        'subln_g': 1.0 + nrm(ks[15], (DEPTH, 2 * ATTN_DH), 0.01),
        'w_br_lru': nrm(ks[16], (DEPTH, D_RNN, D), D_RNN ** -0.5),
        'w_br_attn': nrm(ks[17], (DEPTH, D_V, D), D_V ** -0.5),
        'w_out': nrm(ks[18], (DEPTH, D, D), D ** -0.5),
        'peer_wq': nrm(ks[19], (DEPTH, D, PEER_HEADS * PEER_DQ), D ** -0.5),
        'peer_keys': nrm(ks[20], (DEPTH, PEER_HEADS, 2, N_KEYS, PEER_DQ // 2), (PEER_DQ // 2) ** -0.5),
        'peer_u': nrm(ks[21], (DEPTH, N_EXPERTS, D), D ** -0.5),
        'peer_v': nrm(ks[22], (DEPTH, N_EXPERTS, D), PEER_HEADS ** -0.5),
        'final_g': 1.0 + nrm(ks[23], (D,), 0.01),
    }


def reference(x, c, ctx, c_ctx, mod_w, mod_b, norm1_g, norm2_g, w_in, conv_w, conv_b,
              lru_w, lru_b, lru_lam, diff_lam, subln_g, w_br_lru, w_br_attn, w_out,
              peer_wq, peer_keys, peer_u, peer_v, final_g):
    L = x.shape[1]
    cos, sin = axial_rope_tables(L)
    s_lat = jax.nn.silu(c)
    s_ctx = jax.nn.silu(c_ctx)
    for li in range(DEPTH):
        update_ctx = li < DEPTH - 1
        lambda_init = 0.8 - 0.6 * math.exp(-0.3 * li)
        m_l = jnp.split((s_lat @ mod_w[li] + mod_b[li])[:, None, :], 6, axis=-1)
        m_c = jnp.split(s_ctx @ mod_w[li] + mod_b[li], 6, axis=-1)
        hx = modulate(rmsnorm(x, norm1_g[li]), m_l[0], m_l[1])
        hc = modulate(rmsnorm(ctx, norm1_g[li]), m_c[0], m_c[1])
        out_l, out_c = mixer(hx, hc, w_in[li], conv_w[li], conv_b[li], lru_w[li], lru_b[li],
                             lru_lam[li], diff_lam[li], subln_g[li], w_br_lru[li], w_br_attn[li],
                             w_out[li], lambda_init, cos, sin, update_ctx)
        x = x + m_l[2] * out_l
        x = x + m_l[5] * peer_ffn(modulate(rmsnorm(x, norm2_g[li]), m_l[3], m_l[4]),
                                  peer_wq[li], peer_keys[li], peer_u[li], peer_v[li])
        if update_ctx:
            ctx = ctx + m_c[2] * out_c
            ctx = ctx + m_c[5] * peer_ffn(modulate(rmsnorm(ctx, norm2_g[li]), m_c[3], m_c[4]),
                                          peer_wq[li], peer_keys[li], peer_u[li], peer_v[li])
    return rmsnorm(x, final_g)
```

```cpp
#include <hip/hip_runtime.h>
#include <cstdio>
#include <cstdint>

constexpr int D = 1024, NBATCH = 8, SEQ = 2048, CTXL = 256, DEPTH = 4;
constexpr int ML = NBATCH * SEQ, MC = NBATCH * CTXL, MT = ML + MC;
constexpr int DIN = 7168;
constexpr int C_U = 0, C_GL = 1024, C_Q = 2048, C_K = 3072, C_V = 4096, C_GA = 5120, C_GB = 6144;
constexpr float EPS = 1e-6f;
constexpr int NTHREADS = 512;

typedef unsigned short bf16_t;
__device__ __forceinline__ float bf2f(bf16_t v) { return __uint_as_float(((unsigned)v) << 16); }
__device__ __forceinline__ bf16_t f2bf(float f) { unsigned u = __float_as_uint(f); u = (u + 0x7fffu + ((u >> 16) & 1u)) >> 16; return (bf16_t)u; }
__device__ __forceinline__ float sigmoidf_(float x) { return 1.f / (1.f + __expf(-x)); }
__device__ __forceinline__ float gelu_tanh(float x) { const float u = 0.7978845608028654f * (x + 0.044715f * x * x * x); return 0.5f * x * (1.f + tanhf(u)); }
__device__ __forceinline__ float siluf_(float x) { return x / (1.f + expf(-x)); }

constexpr size_t MiB = 1u << 20;
constexpr size_t WS_CTL = 0;
constexpr size_t WS_X = 1 * MiB;
constexpr size_t WS_HX = WS_X + (size_t)MT * D * 4;
constexpr size_t WS_PROJ = WS_HX + (size_t)MT * D * 2;
constexpr size_t WS_LA = WS_PROJ + (size_t)MT * DIN * 2;
constexpr size_t WS_ATT = WS_LA + (size_t)MT * D * 2;
constexpr size_t WS_MIX = WS_ATT + (size_t)MT * D * 2;
constexpr size_t WS_IDX = WS_MIX + (size_t)MT * D * 2;
constexpr size_t WS_G = WS_IDX + (size_t)MT * 128 * 4;
constexpr size_t WS_MOD = WS_G + (size_t)MT * 128 * 4;
constexpr size_t WS_ROPE = WS_MOD + (size_t)4 * 9 * 6144 * 4;
constexpr size_t WS_LAM = WS_ROPE + (size_t)2048 * 32 * 2 * 4;
constexpr size_t WS_UC = WS_LAM + 256;
constexpr size_t WS_HD = WS_UC + (size_t)MT * D * 4;
constexpr size_t WS_END = WS_HD + (size_t)2 * MT * D * 4;
#define WS_PQ WS_LA

struct P {
    const float *x, *c, *ctx, *c_ctx, *mod_w, *mod_b, *norm1_g, *norm2_g, *w_in, *conv_w, *conv_b, *lru_w, *lru_b, *lru_lam, *diff_lam, *subln_g,
        *w_br_lru, *w_br_attn, *w_out, *peer_wq, *peer_keys, *peer_u, *peer_v, *final_g;
    float* out; unsigned char* ws; int lo, hi;
};

__device__ __forceinline__ int row_mod_idx(int row) { return row < ML ? (row >> 11) : 8; }
__device__ __forceinline__ float lambda_init_of(int li) { return 0.8f - 0.6f * expf(-0.3f * (float)li); }

__device__ void ph_prologue(const P& p, int bid, int nb, unsigned char* lds) {
    const int tid = threadIdx.x; const long gtid = (long)bid * NTHREADS + tid, gsz = (long)nb * NTHREADS;
    float4* X4 = (float4*)(p.ws + WS_X); const float4* x4 = (const float4*)p.x; const float4* c4 = (const float4*)p.ctx;
    for (long i = gtid; i < (long)ML * D / 4; i += gsz) X4[i] = x4[i];
    for (long i = gtid; i < (long)MC * D / 4; i += gsz) X4[(long)ML * D / 4 + i] = c4[i];
    float* s = (float*)lds;
    for (int i = tid; i < 9 * 1024; i += NTHREADS) { const int r = i >> 10, k = i & 1023; const float v = r < 8 ? p.c[r * 1024 + k] : p.c_ctx[k]; s[i] = siluf_(v); }
    __syncthreads();
    float* MOD = (float*)(p.ws + WS_MOD);
    for (long i = gtid; i < 4 * 6144; i += gsz) {
        const int li = (int)(i / 6144), j = (int)(i % 6144); const float* W = p.mod_w + (size_t)li * 1024 * 6144 + j;
        float a0 = 0, a1 = 0, a2 = 0, a3 = 0, a4 = 0, a5 = 0, a6 = 0, a7 = 0, a8 = 0;
        for (int k = 0; k < 1024; ++k) { const float w = W[(size_t)k * 6144];
            a0 += s[k] * w; a1 += s[1024 + k] * w; a2 += s[2048 + k] * w; a3 += s[3072 + k] * w; a4 += s[4096 + k] * w; a5 += s[5120 + k] * w; a6 += s[6144 + k] * w; a7 += s[7168 + k] * w; a8 += s[8192 + k] * w; }
        const float bb = p.mod_b[li * 6144 + j]; float* o = MOD + (size_t)li * 9 * 6144 + j;
        o[0 * 6144] = a0 + bb; o[1 * 6144] = a1 + bb; o[2 * 6144] = a2 + bb; o[3 * 6144] = a3 + bb; o[4 * 6144] = a4 + bb; o[5 * 6144] = a5 + bb; o[6 * 6144] = a6 + bb; o[7 * 6144] = a7 + bb; o[8 * 6144] = a8 + bb;
    }
    float2* R = (float2*)(p.ws + WS_ROPE);
    for (long i = gtid; i < 2048 * 32; i += gsz) { const int t = (int)(i >> 5), j = (int)(i & 31), a = j >> 4, f = j & 15;
        const double pos = a == 0 ? (double)(t >> 6) : (double)(t & 63); const double inv = exp(-(double)f / 16.0 * log(10000.0)); const double ang = pos * inv;
        R[i] = make_float2((float)cos(ang), (float)sin(ang)); }
    if (gtid < 4) { const int li = (int)gtid; const float* lp = p.diff_lam + li * 4 * 64; float s0 = 0, s1 = 0; for (int d = 0; d < 64; ++d) { s0 += lp[d] * lp[64 + d]; s1 += lp[128 + d] * lp[192 + d]; }
        ((float*)(p.ws + WS_LAM))[li] = expf(s0) - expf(s1) + lambda_init_of(li); }
}

__device__ __forceinline__ float wave_sum(float v) {
#pragma unroll
    for (int o = 1; o < 64; o <<= 1) v += __shfl_xor(v, o);
    return v;
}

__device__ void ph_norm(const P& p, int bid, int nb, const float* g, int li, int sh_i, int sc_i, int Mrows, bf16_t* out) {
    const int lane = threadIdx.x & 63, wave = threadIdx.x >> 6; const float* X = (const float*)(p.ws + WS_X); const float* MOD = (const float*)(p.ws + WS_MOD);
    for (int row = bid * 8 + wave; row < Mrows; row += nb * 8) {
        const float4* xr = (const float4*)(X + (size_t)row * D); float4 v[4]; float ss = 0;
#pragma unroll
        for (int j = 0; j < 4; ++j) { v[j] = xr[64 * j + lane]; ss += v[j].x * v[j].x + v[j].y * v[j].y + v[j].z * v[j].z + v[j].w * v[j].w; }
        const float rs = rsqrtf(wave_sum(ss) * (1.f / D) + EPS);
        const float* mrow = MOD + ((size_t)li * 9 + row_mod_idx(row)) * 6144;
#pragma unroll
        for (int j = 0; j < 4; ++j) { const int c0 = (64 * j + lane) * 4; const float4 gg = *(const float4*)(g + c0), sh = *(const float4*)(mrow + sh_i * 1024 + c0), sc = *(const float4*)(mrow + sc_i * 1024 + c0);
            ushort4 o; o.x = f2bf(v[j].x * rs * gg.x * (1.f + sc.x) + sh.x); o.y = f2bf(v[j].y * rs * gg.y * (1.f + sc.y) + sh.y); o.z = f2bf(v[j].z * rs * gg.z * (1.f + sc.z) + sh.z); o.w = f2bf(v[j].w * rs * gg.w * (1.f + sc.w) + sh.w);
            *(ushort4*)(out + (size_t)row * D + c0) = o; }
    }
}
__device__ void ph_final(const P& p, int bid, int nb) {
    const int lane = threadIdx.x & 63, wave = threadIdx.x >> 6; const float* X = (const float*)(p.ws + WS_X);
    for (int row = bid * 8 + wave; row < ML; row += nb * 8) {
        const float4* xr = (const float4*)(X + (size_t)row * D); float4 v[4]; float ss = 0;
#pragma unroll
        for (int j = 0; j < 4; ++j) { v[j] = xr[64 * j + lane]; ss += v[j].x * v[j].x + v[j].y * v[j].y + v[j].z * v[j].z + v[j].w * v[j].w; }
        const float rs = rsqrtf(wave_sum(ss) * (1.f / D) + EPS);
#pragma unroll
        for (int j = 0; j < 4; ++j) { const int c0 = (64 * j + lane) * 4; const float4 gg = *(const float4*)(p.final_g + c0);
            float4 o; o.x = v[j].x * rs * gg.x; o.y = v[j].y * rs * gg.y; o.z = v[j].z * rs * gg.z; o.w = v[j].w * rs * gg.w; *(float4*)(p.out + (size_t)row * D + c0) = o; }
    }
}

template <class Epi>
__device__ void ngemm(const bf16_t* A, int lda, const float* W, int ldw, int M, int N, int K, int bid, int nb, unsigned char* lds, Epi epi) {
    float* As = (float*)lds;
    float* Ws = As + 16 * 132;
    const int tid = threadIdx.x, tx = tid & 15, ty = tid >> 4;
    const int ntn = N / 64, ntiles = (M / 128) * ntn;
    for (int t = bid; t < ntiles; t += nb) {
        const int tm = t / ntn, tn = t % ntn; const int row0 = tm * 128, col0 = tn * 64;
        float acc[4][4];
#pragma unroll
        for (int i = 0; i < 4; ++i)
#pragma unroll
            for (int j = 0; j < 4; ++j) acc[i][j] = 0.f;
        for (int k0 = 0; k0 < K; k0 += 16) {
            __syncthreads();
            { const int r = tid >> 2, kg = (tid & 3) * 4; const ushort4 a = *(const ushort4*)(A + (size_t)(row0 + r) * lda + k0 + kg);
              As[(kg + 0) * 132 + r] = bf2f(a.x); As[(kg + 1) * 132 + r] = bf2f(a.y); As[(kg + 2) * 132 + r] = bf2f(a.z); As[(kg + 3) * 132 + r] = bf2f(a.w); }
            { const int kk = tid >> 5, n = (tid & 31) * 2; const float2 w = *(const float2*)(W + (size_t)(k0 + kk) * ldw + col0 + n); Ws[kk * 64 + n] = w.x; Ws[kk * 64 + n + 1] = w.y; }
            __syncthreads();
#pragma unroll
            for (int kk = 0; kk < 16; ++kk) { const float4 a = *(const float4*)(As + kk * 132 + ty * 4); const float4 b = *(const float4*)(Ws + kk * 64 + tx * 4);
                const float av[4] = {a.x, a.y, a.z, a.w}, bv[4] = {b.x, b.y, b.z, b.w};
#pragma unroll
                for (int i = 0; i < 4; ++i)
#pragma unroll
                    for (int j = 0; j < 4; ++j) acc[i][j] += av[i] * bv[j]; }
        }
#pragma unroll
        for (int i = 0; i < 4; ++i)
#pragma unroll
            for (int j = 0; j < 4; ++j) epi(row0 + ty * 4 + i, col0 + tx * 4 + j, acc[i][j]);
    }
}

__device__ void ph_rope(const P& p, int bid, int nb) {
    bf16_t* PROJ = (bf16_t*)(p.ws + WS_PROJ); const float2* R = (const float2*)(p.ws + WS_ROPE);
    const long gtid = (long)bid * NTHREADS + threadIdx.x, gsz = (long)nb * NTHREADS;
    for (long i = gtid; i < (long)ML * 1024; i += gsz) {
        const int row = (int)(i >> 10), w = (int)(i & 1023), grp = w >> 5, j = w & 31, a = j >> 4, f = j & 15; const int t = row & 2047;
        bf16_t* base = PROJ + (size_t)row * DIN + C_Q + grp * 64 + a * 32 + f;
        const float x1 = bf2f(base[0]), x2 = bf2f(base[16]); const float2 cs = R[t * 32 + j];
        base[0] = f2bf(x1 * cs.x - x2 * cs.y); base[16] = f2bf(x2 * cs.x + x1 * cs.y);
    }
}

__device__ void ph_conv(const P& p, int li, int bid, int nb) {
    const bf16_t* PROJ = (const bf16_t*)(p.ws + WS_PROJ); float* UC = (float*)(p.ws + WS_UC);
    const float* cw = p.conv_w + li * 4 * 1024; const float* cb = p.conv_b + li * 1024;
    const long gtid = (long)bid * NTHREADS + threadIdx.x, gsz = (long)nb * NTHREADS;
    for (long i = gtid; i < (long)MT * 1024; i += gsz) {
        const int row = (int)(i >> 10), ch = (int)(i & 1023);
        int t, L, base; if (row < ML) { t = row & 2047; L = 2048; base = row - t; } else { t = (row - ML) & 255; L = 256; base = row - t; }
        float y = cb[ch];
#pragma unroll
        for (int k = 0; k < 4; ++k) { const int tt = t + k - 2; if (tt >= 0 && tt < L) y += cw[k * 1024 + ch] * bf2f(PROJ[(size_t)(base + tt) * DIN + C_U + ch]); }
        UC[i] = y;
    }
}

__device__ void ph_lru_naive(const P& p, int li, int bid, int nb, unsigned char* lds) {
    float* ucs = (float*)lds;
    float* gts = ucs + 4096;
    const float* UC = (const float*)(p.ws + WS_UC); float* HD = (float*)(p.ws + WS_HD);
    const int tid = threadIdx.x;
    for (int item = bid; item < 128; item += nb) {
        const int b = item >> 4, n = item & 15;
        for (int d = 0; d < 2; ++d) {
            const int g = tid >> 8, j = (tid >> 2) & 63, tq = tid & 3;
            float w[64];
            { const float* wp = p.lru_w + ((((size_t)(li * 2 + d) * 2 + g) * 16 + n) * 64) * 64 + j;
#pragma unroll
              for (int i = 0; i < 64; ++i) w[i] = wp[i * 64]; }
            const float bias = p.lru_b[((size_t)(li * 2 + d) * 2 + g) * 1024 + n * 64 + j];
            float h = 0.f, sp = 0.f;
            if (tid < 64) { const float lam = p.lru_lam[(size_t)(li * 2 + d) * 1024 + n * 64 + tid]; const float z = -lam; sp = z > 20.f ? z : log1pf(expf(z)); }
            for (int step = 0; step < 36; ++step) {
                int base;
                if (d == 0) base = step < 4 ? ML + b * 256 + step * 64 : b * 2048 + (step - 4) * 64;
                else base = step < 4 ? ML + b * 256 + (3 - step) * 64 : b * 2048 + (35 - step) * 64;
                __syncthreads();
                for (int i = tid; i < 4096; i += NTHREADS) ucs[i] = UC[(size_t)(base + (i >> 6)) * 1024 + n * 64 + (i & 63)];
                __syncthreads();
                for (int t = tq * 16; t < tq * 16 + 16; ++t) { float acc = bias;
#pragma unroll
                    for (int i = 0; i < 64; ++i) acc += ucs[t * 64 + i] * w[i];
                    gts[(g * 64 + t) * 64 + j] = sigmoidf_(acc); }
                __syncthreads();
                if (tid < 64) {
                    for (int tt = 0; tt < 64; ++tt) { const int t = d ? 63 - tt : tt;
                        const float rec = gts[t * 64 + tid], inp = gts[(64 + t) * 64 + tid], u = ucs[t * 64 + tid];
                        const float log_a = -8.f * rec * sp; const float a = expf(log_a); const float drive = sqrtf(-expm1f(2.f * log_a)) * (inp * u);
                        h = a * h + drive; HD[((size_t)d * MT + base + t) * 1024 + n * 64 + tid] = h; }
                }
            }
        }
    }
}
__device__ void ph_lru_combine(const P& p, int bid, int nb) {
    const bf16_t* PROJ = (const bf16_t*)(p.ws + WS_PROJ); const float* HD = (const float*)(p.ws + WS_HD); bf16_t* LA = (bf16_t*)(p.ws + WS_LA);
    const long gtid = (long)bid * NTHREADS + threadIdx.x, gsz = (long)nb * NTHREADS;
    for (long i = gtid; i < (long)MT * 1024; i += gsz) { const int row = (int)(i >> 10), ch = (int)(i & 1023);
        const float hs = HD[i] + HD[(size_t)MT * 1024 + i]; const float gt = bf2f(PROJ[(size_t)row * DIN + C_GL + ch]); LA[i] = f2bf(hs * gelu_tanh(gt)); }
}

__device__ void ph_attn_naive(const P& p, int li, bool do_ctx, int bid, int nb, unsigned char* lds) {
    float* Ks = (float*)lds;
    float* Vs = Ks + 32 * 64;
    const bf16_t* PROJ = (const bf16_t*)(p.ws + WS_PROJ); bf16_t* ATT = (bf16_t*)(p.ws + WS_ATT);
    const float lam = ((const float*)(p.ws + WS_LAM))[li]; const float linit = lambda_init_of(li);
    const int tid = threadIdx.x, r = tid >> 2, sl = tid & 3;
    const int nunits = 1024 + (do_ctx ? 128 : 0);
    for (int unit = bid; unit < nunits; unit += nb) {
        const bool is_ctx = unit >= 1024; const int u = is_ctx ? unit - 1024 : unit;
        int b, h, qb; if (!is_ctx) { b = u >> 7; h = (u >> 4) & 7; qb = u & 15; } else { b = u >> 4; h = (u >> 1) & 7; qb = u & 1; }
        const int qrow = is_ctx ? ML + b * 256 + qb * 128 + r : b * 2048 + qb * 128 + r; const int nkeys = is_ctx ? 256 : 2304;
        float o0[32], o[32];
        for (int m = 0; m < 2; ++m) {
            float q[64];
            { const bf16_t* qp = PROJ + (size_t)qrow * DIN + C_Q + h * 128 + m * 64;
#pragma unroll
              for (int dd = 0; dd < 64; ++dd) q[dd] = bf2f(qp[dd]) * 0.125f; }
            float mrun = -1e30f, l = 0.f;
#pragma unroll
            for (int e = 0; e < 32; ++e) o[e] = 0.f;
            for (int kt = 0; kt < nkeys / 32; ++kt) {
                __syncthreads();
                {
                  const int kr = tid >> 4, kc = (tid & 15) * 4; const int kk = kt * 32 + kr; const int krow = is_ctx ? ML + b * 256 + kk : (kk < 256 ? ML + b * 256 + kk : b * 2048 + kk - 256);
                  const ushort4 kv = *(const ushort4*)(PROJ + (size_t)krow * DIN + C_K + h * 128 + m * 64 + kc);
                  Ks[kr * 64 + kc] = bf2f(kv.x); Ks[kr * 64 + kc + 1] = bf2f(kv.y); Ks[kr * 64 + kc + 2] = bf2f(kv.z); Ks[kr * 64 + kc + 3] = bf2f(kv.w);
                  const int vc = (tid & 15) * 8; const ushort4 v0 = *(const ushort4*)(PROJ + (size_t)krow * DIN + C_V + h * 128 + vc), v1 = *(const ushort4*)(PROJ + (size_t)krow * DIN + C_V + h * 128 + vc + 4);
                  float* vd = Vs + kr * 128 + vc; vd[0] = bf2f(v0.x); vd[1] = bf2f(v0.y); vd[2] = bf2f(v0.z); vd[3] = bf2f(v0.w); vd[4] = bf2f(v1.x); vd[5] = bf2f(v1.y); vd[6] = bf2f(v1.z); vd[7] = bf2f(v1.w); }
                __syncthreads();
                for (int hf = 0; hf < 2; ++hf) {
                float s[16]; float tmax = -1e30f;
#pragma unroll
                for (int jj = 0; jj < 16; ++jj) { float a = 0.f;
#pragma unroll
                    for (int dd = 0; dd < 64; dd += 4) { const float4 k4 = *(const float4*)(Ks + (hf * 16 + jj) * 64 + dd); a += q[dd] * k4.x + q[dd + 1] * k4.y + q[dd + 2] * k4.z + q[dd + 3] * k4.w; }
                    s[jj] = a; tmax = fmaxf(tmax, a); }
                const float mnew = fmaxf(mrun, tmax); const float corr = __expf(mrun - mnew); l *= corr;
#pragma unroll
                for (int e = 0; e < 32; ++e) o[e] *= corr;
#pragma unroll
                for (int jj = 0; jj < 16; ++jj) { const float pj = __expf(s[jj] - mnew); l += pj;
#pragma unroll
                    for (int e = 0; e < 32; e += 4) { const float4 v4 = *(const float4*)(Vs + (hf * 16 + jj) * 128 + sl * 32 + e); o[e] += pj * v4.x; o[e + 1] += pj * v4.y; o[e + 2] += pj * v4.z; o[e + 3] += pj * v4.w; } }
                mrun = mnew;
                }
            }
            const float il = 1.f / l;
            if (m == 0) {
#pragma unroll
                for (int e = 0; e < 32; ++e) o0[e] = o[e] * il;
            } else {
#pragma unroll
                for (int e = 0; e < 32; ++e) o[e] = o0[e] - lam * (o[e] * il);
            }
        }
        float ss = 0.f;
#pragma unroll
        for (int e = 0; e < 32; ++e) ss += o[e] * o[e];
        ss += __shfl_xor(ss, 1); ss += __shfl_xor(ss, 2);
        const float rs = rsqrtf(ss * (1.f / 128.f) + EPS) * (1.f - linit);
        bf16_t* op = ATT + (size_t)qrow * D + h * 128 + sl * 32; const float* sg = p.subln_g + li * 128 + sl * 32;
#pragma unroll
        for (int e = 0; e < 32; ++e) op[e] = f2bf(o[e] * rs * sg[e]);
    }
}

__device__ __forceinline__ void wave_argmax(float& v, int& i) {
#pragma unroll
    for (int o = 1; o < 64; o <<= 1) { const float ov = __shfl_xor(v, o); const int oi = __shfl_xor(i, o); if (ov > v || (ov == v && oi < i)) { v = ov; i = oi; } }
}
__device__ void ph_peer_score_naive(const P& p, int li, int Mrows, int bid, int nb, unsigned char* lds) {
    float* qs = (float*)lds;
    float* sc = qs + 1024;
    float* topv = sc + 2048;
    int* topi = (int*)(topv + 256);
    const bf16_t* PQ = (const bf16_t*)(p.ws + WS_PQ); int* IDX = (int*)(p.ws + WS_IDX); float* G = (float*)(p.ws + WS_G);
    const float* keys = p.peer_keys + (size_t)li * 16 * 128 * 64;
    const int tid = threadIdx.x, lane = tid & 63, wave = tid >> 6;
    for (int tok = bid; tok < Mrows; tok += nb) {
        __syncthreads();
        qs[tid] = bf2f(PQ[(size_t)tok * D + tid]); qs[tid + 512] = bf2f(PQ[(size_t)tok * D + tid + 512]);
        __syncthreads();
#pragma unroll
        for (int k = 0; k < 4; ++k) { const int id = tid + 512 * k, hp = id >> 7; const float* kp = keys + (size_t)id * 64; const float* qp = qs + hp * 64; float a = 0.f;
            for (int dd = 0; dd < 64; dd += 4) { const float4 k4 = *(const float4*)(kp + dd); a += qp[dd] * k4.x + qp[dd + 1] * k4.y + qp[dd + 2] * k4.z + qp[dd + 3] * k4.w; }
            sc[id] = a; }
        __syncthreads();
        for (int li2 = 0; li2 < 2; ++li2) { const int list = wave * 2 + li2; float v0 = sc[list * 128 + lane], v1 = sc[list * 128 + 64 + lane];
            for (int r = 0; r < 16; ++r) { float v; int i; if (v0 >= v1) { v = v0; i = lane; } else { v = v1; i = lane + 64; }
                wave_argmax(v, i);
                if (i == lane) v0 = -3e38f; if (i == lane + 64) v1 = -3e38f;
                if (lane == 0) { topv[list * 16 + r] = v; topi[list * 16 + r] = i; } } }
        __syncthreads();
        { const int h = wave; float cv[4];
#pragma unroll
          for (int q4 = 0; q4 < 4; ++q4) { const int c = lane * 4 + q4; cv[q4] = topv[(2 * h) * 16 + (c >> 4)] + topv[(2 * h + 1) * 16 + (c & 15)]; }
          float mybest = 0.f; int myidx = 0; float best0 = 0.f;
          for (int r = 0; r < 16; ++r) { float v = cv[0]; int i = lane * 4;
#pragma unroll
              for (int q4 = 1; q4 < 4; ++q4) if (cv[q4] > v) { v = cv[q4]; i = lane * 4 + q4; }
              wave_argmax(v, i);
#pragma unroll
              for (int q4 = 0; q4 < 4; ++q4) if (i == lane * 4 + q4) cv[q4] = -3e38f;
              if (r == 0) best0 = v;
              if (lane == r) { mybest = v; myidx = topi[(2 * h) * 16 + (i >> 4)] * 128 + topi[(2 * h + 1) * 16 + (i & 15)]; } }
          float e = lane < 16 ? __expf(mybest - best0) : 0.f; const float ssum = wave_sum(e);
          if (lane < 16) { IDX[(size_t)tok * 128 + h * 16 + lane] = myidx; G[(size_t)tok * 128 + h * 16 + lane] = e / ssum; } }
    }
}
__device__ void ph_peer_expert_naive(const P& p, int li, int Mrows, int bid, int nb) {
    const bf16_t* HQ = (const bf16_t*)(p.ws + WS_HX); const int* IDX = (const int*)(p.ws + WS_IDX); const float* G = (const float*)(p.ws + WS_G);
    float* X = (float*)(p.ws + WS_X); const float* MOD = (const float*)(p.ws + WS_MOD);
    const float* U = p.peer_u + (size_t)li * 16384 * 1024; const float* V = p.peer_v + (size_t)li * 16384 * 1024;
    const int lane = threadIdx.x & 63, wave = threadIdx.x >> 6;
    for (int tok = bid * 8 + wave; tok < Mrows; tok += nb * 8) {
        float4 hv[4], y[4];
#pragma unroll
        for (int j = 0; j < 4; ++j) { const ushort4 t = *(const ushort4*)(HQ + (size_t)tok * D + (64 * j + lane) * 4); hv[j] = make_float4(bf2f(t.x), bf2f(t.y), bf2f(t.z), bf2f(t.w)); y[j] = make_float4(0.f, 0.f, 0.f, 0.f); }
        for (int e0 = 0; e0 < 128; e0 += 4) {
            float wgt[4]; int ids[4];
#pragma unroll
            for (int q = 0; q < 4; ++q) { ids[q] = IDX[(size_t)tok * 128 + e0 + q]; const float4* up = (const float4*)(U + (size_t)ids[q] * 1024); float a = 0.f;
#pragma unroll
                for (int j = 0; j < 4; ++j) { const float4 u4 = up[64 * j + lane]; a += u4.x * hv[j].x + u4.y * hv[j].y + u4.z * hv[j].z + u4.w * hv[j].w; }
                wgt[q] = a; }
#pragma unroll
            for (int q = 0; q < 4; ++q) { const float dot = wave_sum(wgt[q]); wgt[q] = gelu_tanh(dot) * G[(size_t)tok * 128 + e0 + q]; }
#pragma unroll
            for (int q = 0; q < 4; ++q) { const float4* vp = (const float4*)(V + (size_t)ids[q] * 1024);
#pragma unroll
                for (int j = 0; j < 4; ++j) { const float4 v4 = vp[64 * j + lane]; y[j].x += wgt[q] * v4.x; y[j].y += wgt[q] * v4.y; y[j].z += wgt[q] * v4.z; y[j].w += wgt[q] * v4.w; } }
        }
        const float* g2 = MOD + ((size_t)li * 9 + row_mod_idx(tok)) * 6144 + 5 * 1024;
#pragma unroll
        for (int j = 0; j < 4; ++j) { const int c0 = (64 * j + lane) * 4; float4* xp = (float4*)(X + (size_t)tok * D + c0); float4 xv = *xp; const float4 gg = *(const float4*)(g2 + c0);
            xv.x += gg.x * y[j].x; xv.y += gg.y * y[j].y; xv.z += gg.z * y[j].z; xv.w += gg.w * y[j].w; *xp = xv; }
    }
}

template <int PH>
__global__ void __launch_bounds__(NTHREADS) k_ph(P p, int li) {
    extern __shared__ __attribute__((aligned(16))) unsigned char lds[];
    const int bid = blockIdx.x, nb = gridDim.x;
    bf16_t* HX = (bf16_t*)(p.ws + WS_HX); bf16_t* PROJ = (bf16_t*)(p.ws + WS_PROJ); bf16_t* LA = (bf16_t*)(p.ws + WS_LA); bf16_t* ATT = (bf16_t*)(p.ws + WS_ATT);
    bf16_t* MIX = (bf16_t*)(p.ws + WS_MIX); bf16_t* PQ = (bf16_t*)(p.ws + WS_PQ); float* X = (float*)(p.ws + WS_X); const float* MOD = (const float*)(p.ws + WS_MOD);
    const bool do_ctx = li < DEPTH - 1; const int Mr = do_ctx ? MT : ML;
    if constexpr (PH == -2) ph_prologue(p, bid, nb, lds);
    if constexpr (PH == -1) ph_norm(p, bid, nb, p.norm1_g, 0, 0, 1, MT, HX);
    if constexpr (PH == 0) ngemm(HX, D, p.w_in + (size_t)li * D * DIN, DIN, MT, DIN, D, bid, nb, lds, [=](int r, int c, float v) { PROJ[(size_t)r * DIN + c] = f2bf(v); });
    if constexpr (PH == 1) ph_rope(p, bid, nb);
    if constexpr (PH == 2) ph_conv(p, li, bid, nb);
    if constexpr (PH == 3) ph_lru_naive(p, li, bid, nb, lds);
    if constexpr (PH == 4) ph_lru_combine(p, bid, nb);
    if constexpr (PH == 5) ph_attn_naive(p, li, do_ctx, bid, nb, lds);
    if constexpr (PH == 6) ngemm(LA, D, p.w_br_lru + (size_t)li * D * D, D, Mr, D, D, bid, nb, lds, [=](int r, int c, float v) { const float ga = bf2f(PROJ[(size_t)r * DIN + C_GA + c]); MIX[(size_t)r * D + c] = f2bf(sigmoidf_(ga) * v); });
    if constexpr (PH == 7) ngemm(ATT, D, p.w_br_attn + (size_t)li * D * D, D, Mr, D, D, bid, nb, lds, [=](int r, int c, float v) { const float gb = bf2f(PROJ[(size_t)r * DIN + C_GB + c]); MIX[(size_t)r * D + c] = f2bf(bf2f(MIX[(size_t)r * D + c]) + sigmoidf_(gb) * v); });
    if constexpr (PH == 8) ngemm(MIX, D, p.w_out + (size_t)li * D * D, D, Mr, D, D, bid, nb, lds, [=](int r, int c, float v) { const float g1 = MOD[((size_t)li * 9 + row_mod_idx(r)) * 6144 + 2 * 1024 + c]; X[(size_t)r * D + c] += g1 * v; });
    if constexpr (PH == 9) ph_norm(p, bid, nb, p.norm2_g + li * D, li, 3, 4, Mr, HX);
    if constexpr (PH == 10) ngemm(HX, D, p.peer_wq + (size_t)li * D * D, D, Mr, D, D, bid, nb, lds, [=](int r, int c, float v) { PQ[(size_t)r * D + c] = f2bf(v); });
    if constexpr (PH == 11) ph_peer_score_naive(p, li, Mr, bid, nb, lds);
    if constexpr (PH == 12) ph_peer_expert_naive(p, li, Mr, bid, nb);
    if constexpr (PH == 13) { if (li < DEPTH - 1) ph_norm(p, bid, nb, p.norm1_g + (li + 1) * D, li + 1, 0, 1, MT, HX); else ph_final(p, bid, nb); }
}

constexpr int LDS_BYTES = 65536;
template <int PH> static void launch_ph(const P& p, int li, int grid, hipStream_t stream) {
    static bool attr = false;
    if (!attr) { (void)hipFuncSetAttribute((const void*)k_ph<PH>, hipFuncAttributeMaxDynamicSharedMemorySize, LDS_BYTES); attr = true; }
    hipLaunchKernelGGL(k_ph<PH>, dim3(grid), dim3(NTHREADS), LDS_BYTES, stream, p, li);
}

extern "C" void kernel_launch(void* const* d_in, const int* in_sizes, int n_in, void* d_out, int out_size, void* d_ws, size_t ws_size, hipStream_t stream) {
    static int grid = 0;
    if (grid == 0) {
        if (n_in != 24 || ws_size < WS_END) { fprintf(stderr, "kernel_launch: n_in %d ws %zu need %zu\n", n_in, ws_size, (size_t)WS_END); grid = -1; return; }
        int dev = 0, cus = 0; (void)hipGetDevice(&dev); (void)hipDeviceGetAttribute(&cus, hipDeviceAttributeMultiprocessorCount, dev);
        grid = cus * 2;
    }
    if (grid < 0) return;
    P p{};
    const float** pp = (const float**)&p;
    for (int i = 0; i < 24; ++i) pp[i] = (const float*)d_in[i];
    p.out = (float*)d_out; p.ws = (unsigned char*)d_ws;
    launch_ph<-2>(p, 0, grid, stream); launch_ph<-1>(p, 0, grid, stream);
    for (int li = 0; li < DEPTH; ++li) {
        launch_ph<0>(p, li, grid, stream); launch_ph<1>(p, li, grid, stream); launch_ph<2>(p, li, grid, stream); launch_ph<3>(p, li, grid, stream);
        launch_ph<4>(p, li, grid, stream); launch_ph<5>(p, li, grid, stream); launch_ph<6>(p, li, grid, stream); launch_ph<7>(p, li, grid, stream);
        launch_ph<8>(p, li, grid, stream); launch_ph<9>(p, li, grid, stream); launch_ph<10>(p, li, grid, stream); launch_ph<11>(p, li, grid, stream);
        launch_ph<12>(p, li, grid, stream); launch_ph<13>(p, li, grid, stream);
    }
}
```

```cpp
#include <hip/hip_runtime.h>
#include <cstdio>
#include <cstdint>

#ifndef PROBE_CAT
#define PROBE_CAT 0
#endif
#ifndef PROBE_N
#define PROBE_N 1
#endif
#define PEER_DBG_SIMPLE_REDUCE 0
#define PEER_DBG_NAIVE_EPI 0
#ifndef OPT_LRU
#define OPT_LRU 1
#endif
constexpr int D = 1024, NBATCH = 8, SEQ = 2048, CTXL = 256, DEPTH = 4;
constexpr int ML = NBATCH * SEQ, MC = NBATCH * CTXL, MT = ML + MC;
constexpr int DIN = 7168;
constexpr int C_U = 0, C_GL = 1024, C_Q = 2048, C_K = 3072, C_V = 4096, C_GA = 5120, C_GB = 6144;
constexpr float EPS = 1e-6f;
constexpr int NTHREADS = 512, NWAVES = 8;

typedef unsigned short bf16_t;
__device__ __forceinline__ float bf2f(bf16_t v) { return __uint_as_float(((unsigned)v) << 16); }
__device__ __forceinline__ unsigned pk2(float lo, float hi) { unsigned r; asm("v_cvt_pk_bf16_f32 %0, %1, %2" : "=v"(r) : "v"(lo), "v"(hi)); return r; }
__device__ __forceinline__ bf16_t f2bf(float f) { return (bf16_t)(pk2(f, f) & 0xffffu); }
__device__ __forceinline__ float sigmoidf_(float x) { return 1.f / (1.f + __expf(-x)); }
__device__ __forceinline__ float gelu_tanh(float x) { const float u = 0.7978845608028654f * (x + 0.044715f * x * x * x); return 0.5f * x * (1.f + tanhf(u)); }
__device__ __forceinline__ float siluf_(float x) { return x / (1.f + expf(-x)); }

constexpr size_t MiB = 1u << 20;
constexpr size_t WS_CTL = 0, CTL_ZERO_BYTES = 1 * MiB;
constexpr size_t WS_X = 1 * MiB;
constexpr size_t WS_HX = WS_X + (size_t)MT * D * 4;
constexpr size_t WS_PROJ = WS_HX + (size_t)MT * D * 2;
constexpr size_t WS_LA = WS_PROJ + (size_t)MT * DIN * 2;
constexpr size_t WS_ATT = WS_LA + (size_t)MT * D * 2;
constexpr size_t WS_MIX = WS_ATT + (size_t)MT * D * 2;
constexpr size_t WS_IDX = WS_MIX + (size_t)MT * D * 2;
constexpr size_t WS_G = WS_IDX + (size_t)MT * 128 * 4;
constexpr size_t WS_MOD = WS_G + (size_t)MT * 128 * 4;
constexpr size_t WS_ROPE = WS_MOD + (size_t)4 * 9 * 6144 * 4;
constexpr size_t WS_LAM = WS_ROPE + (size_t)2048 * 32 * 2 * 4;
constexpr size_t WS_MODP = WS_LAM + 256;
constexpr size_t WS_WIN_T = WS_MODP + (size_t)8 * 4 * 9 * 6144 * 4;
constexpr size_t WS_WBL_T = WS_WIN_T + (size_t)4 * DIN * D * 2;
constexpr size_t WS_WBA_T = WS_WBL_T + (size_t)4 * D * D * 2;
constexpr size_t WS_WOUT_T = WS_WBA_T + (size_t)4 * D * D * 2;
constexpr size_t WS_WQ_T = WS_WOUT_T + (size_t)4 * D * D * 2;
constexpr size_t WS_STASH = WS_WQ_T + (size_t)4 * D * D * 2;
constexpr size_t WS_KEYS = WS_STASH + (size_t)256 * 8 * 64 * 64 * 4;
constexpr size_t WS_PU = WS_KEYS + (size_t)4 * 16 * 128 * 64 * 2;
constexpr size_t WS_PV = WS_PU + (size_t)16384 * 1024;
constexpr size_t WS_SU = WS_PV + (size_t)16384 * 1024;
constexpr size_t WS_SV = WS_SU + (size_t)16384 * 4;
constexpr size_t WS_HF = WS_SV + (size_t)16384 * 4;
constexpr size_t WS_UC = WS_HF;
constexpr size_t WS_HD = WS_UC + (size_t)MT * D * 4;
#if OPT_LRU
constexpr size_t WS_END = WS_HF + (size_t)MT * D * 4;
#else
constexpr size_t WS_END = WS_HD + (size_t)2 * MT * D * 4;
#endif
#define WS_PQ WS_LA

struct P {
    const float *x, *c, *ctx, *c_ctx, *mod_w, *mod_b, *norm1_g, *norm2_g, *w_in, *conv_w, *conv_b, *lru_w, *lru_b, *lru_lam, *diff_lam, *subln_g,
        *w_br_lru, *w_br_attn, *w_out, *peer_wq, *peer_keys, *peer_u, *peer_v, *final_g;
    float* out; unsigned char* ws; int lo, hi;
};

__device__ __forceinline__ int otid() { int t = threadIdx.x; asm volatile("" : "+v"(t)); return t; }
__device__ __forceinline__ int row_mod_idx(int row) { return row < ML ? (row >> 11) : 8; }
__device__ __forceinline__ float lambda_init_of(int li) { return 0.8f - 0.6f * expf(-0.3f * (float)li); }

namespace pg8 {
#define PG8_LAS __attribute__((address_space(3)))
typedef unsigned short bf16_t;
typedef short bf16x8 __attribute__((ext_vector_type(8)));
typedef float f32x4 __attribute__((ext_vector_type(4)));
typedef unsigned u32x4 __attribute__((ext_vector_type(4)));
constexpr int BM = 256, BK = 64, HALF = 128, HTB = HALF * BK * 2  , STAGE_BYTES = 8 * HTB, NXCD = 8, WGM = 8;

__host__ __device__ __forceinline__ int lds_byte(int r, int c) { const int st = (r >> 4) * 2 + (c >> 5), rr = r & 15, cc = c & 31, ob = rr * 64 + cc * 2; return st * 1024 + (ob ^ (((ob >> 9) & 1) << 5)); }
__host__ __device__ __forceinline__ void stage_rc(int b, int& R, int& C) { const int st = b / 1024, sb = b % 1024, swz = sb ^ (((sb >> 9) & 1) << 5); R = (st >> 1) * 16 + swz / 64; C = (st & 1) * 32 + (swz % 64) / 2; }
__host__ __device__ __forceinline__ int perm32(int rho) { const int n = rho >> 4, i = rho & 15; return 8 * (i >> 2) + 4 * n + (i & 3); }

struct Unit { int pm, pn; };
struct Gemm { const bf16_t* A; const bf16_t* Bt; int M, N, K; };

struct StaticOrder {
    int nM, nN, nwg, G, c;
    __host__ __device__ void init(int M, int N, int G_, int c_) { nM = M / BM; nN = N / BM; nwg = nM * nN; G = G_; c = c_; }
    __host__ __device__ bool next(int i, Unit& u) const {
        const long L = (long)i * G + c; if (L >= nwg) return false;
        int wgid = (int)L; { const int q = nwg / NXCD, r = nwg % NXCD, xcd = wgid % NXCD, off = wgid / NXCD; wgid = (xcd < r ? xcd * (q + 1) : r * (q + 1) + (xcd - r) * q) + off; }
        const int nig = WGM * nN, gid = wgid / nig, fm = gid * WGM, gsz = (nM - fm) < WGM ? (nM - fm) : WGM;
        u.pm = fm + ((wgid % nig) % gsz); u.pn = (wgid % nig) / gsz; return true;
    }
    __device__ __forceinline__ void a_ready(const Unit&) const {}
    __device__ __forceinline__ void done(const Unit&) const {}
};

__device__ __forceinline__ unsigned cvt_pk_bf16(float lo, float hi) { unsigned r; asm volatile("v_cvt_pk_bf16_f32 %0, %1, %2" : "=v"(r) : "v"(lo), "v"(hi)); return r; }
typedef float f32x2 __attribute__((ext_vector_type(2)));
__device__ __forceinline__ f32x2 gelu_pk(f32x2 v) {
    const f32x2 av = __builtin_elementwise_abs(v), d = av * 0.2316418882f + 1.0f;
    f32x2 t; t.x = __builtin_amdgcn_rcpf(d.x); t.y = __builtin_amdgcn_rcpf(d.y);
    f32x2 q = t * 0.5307027145f + (-0.7265760135f); q = q * t + 0.7107068705f; q = q * t + (-0.142248368f); q = q * t + 0.127414796f; q = q * t;
    const f32x2 s = (v * v) * (-0.72134752044f);
    f32x2 e; e.x = __builtin_amdgcn_exp2f(s.x); e.y = __builtin_amdgcn_exp2f(s.y);
    const f32x2 m = v * (q * e), r = v - m;
    f32x2 o; o.x = v.x < 0.f ? m.x : r.x; o.y = v.y < 0.f ? m.y : r.y; return o;
}

template <int ACT  > struct EpiBf16 {
    static constexpr bool PERM = true, AFTER_DRAIN = false; static_assert(ACT == 0 || ACT == 1, "EpiBf16: ACT is 0 (none) or 1 (gelu_pk)");
    bf16_t* O; int ldc; const float* bias; int split_cols; size_t split_stride; float scale0;
    __device__ __forceinline__ void operator()(const f32x4 (&acc)[2][2][4][2], const Unit& u, int wr, int wc, int fr, int fq) const {
        const int row0 = u.pm * BM + wr * 64 + fr; int colt = u.pn * BM; bf16_t* base = O;
        float sc = 1.f; if (split_cols) { const int t = colt / split_cols; base += (size_t)t * split_stride; colt -= t * split_cols; if (t == 0) sc = scale0; }
        const int col0 = colt + wc * 32 + 8 * fq, bcol0 = u.pn * BM + wc * 32 + 8 * fq;
        f32x4 bv[2][2];
#pragma unroll
        for (int bj = 0; bj < 2; ++bj)
#pragma unroll
            for (int n = 0; n < 2; ++n) bv[bj][n] = bias ? *(const f32x4*)(bias + bcol0 + bj * HALF + 4 * n) : (f32x4){0.f, 0.f, 0.f, 0.f};
#pragma unroll
        for (int ai = 0; ai < 2; ++ai)
#pragma unroll
            for (int m = 0; m < 4; ++m) { bf16_t* rowp = base + (size_t)(row0 + ai * HALF + m * 16) * ldc + col0;
#pragma unroll
                for (int bj = 0; bj < 2; ++bj) { f32x4 v0 = acc[ai][bj][m][0] + bv[bj][0], v1 = acc[ai][bj][m][1] + bv[bj][1];
                    if (ACT == 1) { f32x2 a = gelu_pk((f32x2){v0[0], v0[1]}), b = gelu_pk((f32x2){v0[2], v0[3]}), c = gelu_pk((f32x2){v1[0], v1[1]}), d = gelu_pk((f32x2){v1[2], v1[3]});
                        v0 = (f32x4){a.x, a.y, b.x, b.y}; v1 = (f32x4){c.x, c.y, d.x, d.y}; }
                    v0 = v0 * sc; v1 = v1 * sc; u32x4 w; w.x = cvt_pk_bf16(v0[0], v0[1]); w.y = cvt_pk_bf16(v0[2], v0[3]); w.z = cvt_pk_bf16(v1[0], v1[1]); w.w = cvt_pk_bf16(v1[2], v1[3]);
                    *(u32x4*)(rowp + bj * HALF) = w; } }
    }
};
__device__ __forceinline__ float bflo(unsigned w) { return __uint_as_float(w << 16); }
__device__ __forceinline__ float bfhi(unsigned w) { return __uint_as_float(w & 0xffff0000u); }
__device__ __forceinline__ float sigm(float x) { return 1.f / (1.f + __expf(-x)); }

struct EpiIn {
    static constexpr bool PERM = true, AFTER_DRAIN = false;
    bf16_t* O; const float* rope;
    __device__ __forceinline__ void operator()(const f32x4 (&acc)[2][2][4][2], const Unit& u, int wr, int wc, int fr, int fq) const {
        const int row0 = u.pm * BM + wr * 64 + fr, col0 = u.pn * BM + wc * 32 + 8 * fq;
        const bool dorope = (u.pn >= 8) && (u.pn < 16) && (u.pm < 64);
        const int i0 = ((wc & 1) << 4) + 4 * fq;
#pragma unroll
        for (int ai = 0; ai < 2; ++ai)
#pragma unroll
            for (int m = 0; m < 4; ++m) { const int row = row0 + ai * HALF + m * 16; bf16_t* rowp = O + (size_t)row * DIN + col0;
                f32x4 r0 = {1.f, 0.f, 1.f, 0.f}, r1 = {1.f, 0.f, 1.f, 0.f};
                if (dorope) { const f32x4* rp = (const f32x4*)(rope + ((size_t)(row & 2047) * 32 + i0) * 2); r0 = rp[0]; r1 = rp[1]; }
#pragma unroll
                for (int bj = 0; bj < 2; ++bj) { f32x4 v0 = acc[ai][bj][m][0], v1 = acc[ai][bj][m][1];
                    if (dorope) { f32x4 a, b;
                        a[0] = v0[0] * r0[0] - v0[1] * r0[1]; a[1] = v0[1] * r0[0] + v0[0] * r0[1]; a[2] = v0[2] * r0[2] - v0[3] * r0[3]; a[3] = v0[3] * r0[2] + v0[2] * r0[3];
                        b[0] = v1[0] * r1[0] - v1[1] * r1[1]; b[1] = v1[1] * r1[0] + v1[0] * r1[1]; b[2] = v1[2] * r1[2] - v1[3] * r1[3]; b[3] = v1[3] * r1[2] + v1[2] * r1[3];
                        v0 = a; v1 = b; }
                    u32x4 w; w.x = cvt_pk_bf16(v0[0], v0[1]); w.y = cvt_pk_bf16(v0[2], v0[3]); w.z = cvt_pk_bf16(v1[0], v1[1]); w.w = cvt_pk_bf16(v1[2], v1[3]);
                    *(u32x4*)(rowp + bj * HALF) = w; } }
    }
};
struct EpiPlain {
    static constexpr bool PERM = true, AFTER_DRAIN = false;
    bf16_t* O;
    __device__ __forceinline__ void operator()(const f32x4 (&acc)[2][2][4][2], const Unit& u, int wr, int wc, int fr, int fq) const {
        const int row0 = u.pm * BM + wr * 64 + fr, col0 = u.pn * BM + wc * 32 + 8 * fq;
#pragma unroll
        for (int ai = 0; ai < 2; ++ai)
#pragma unroll
            for (int m = 0; m < 4; ++m) { bf16_t* rowp = O + (size_t)(row0 + ai * HALF + m * 16) * D + col0;
#pragma unroll
                for (int bj = 0; bj < 2; ++bj) { const f32x4 v0 = acc[ai][bj][m][0], v1 = acc[ai][bj][m][1];
                    u32x4 w; w.x = cvt_pk_bf16(v0[0], v0[1]); w.y = cvt_pk_bf16(v0[2], v0[3]); w.z = cvt_pk_bf16(v1[0], v1[1]); w.w = cvt_pk_bf16(v1[2], v1[3]);
                    *(u32x4*)(rowp + bj * HALF) = w; } }
    }
};
template <bool ADD> struct EpiBr {
    static constexpr bool PERM = true, AFTER_DRAIN = false;
    const bf16_t* PROJ; bf16_t* MIX; int gcol;
    __device__ __forceinline__ void operator()(const f32x4 (&acc)[2][2][4][2], const Unit& u, int wr, int wc, int fr, int fq) const {
        const int row0 = u.pm * BM + wr * 64 + fr, col0 = u.pn * BM + wc * 32 + 8 * fq;
#pragma unroll
        for (int ai = 0; ai < 2; ++ai)
#pragma unroll
            for (int m = 0; m < 4; ++m) { const int row = row0 + ai * HALF + m * 16; bf16_t* rowp = MIX + (size_t)row * D + col0; const bf16_t* gp = PROJ + (size_t)row * DIN + gcol + col0;
#pragma unroll
                for (int bj = 0; bj < 2; ++bj) { const f32x4 v0 = acc[ai][bj][m][0], v1 = acc[ai][bj][m][1]; const u32x4 g = *(const u32x4*)(gp + bj * HALF);
                    float o[8] = {sigm(bflo(g.x)) * v0[0], sigm(bfhi(g.x)) * v0[1], sigm(bflo(g.y)) * v0[2], sigm(bfhi(g.y)) * v0[3], sigm(bflo(g.z)) * v1[0], sigm(bfhi(g.z)) * v1[1], sigm(bflo(g.w)) * v1[2], sigm(bfhi(g.w)) * v1[3]};
                    if (ADD) { const u32x4 q = *(const u32x4*)(rowp + bj * HALF); o[0] += bflo(q.x); o[1] += bfhi(q.x); o[2] += bflo(q.y); o[3] += bfhi(q.y); o[4] += bflo(q.z); o[5] += bfhi(q.z); o[6] += bflo(q.w); o[7] += bfhi(q.w); }
                    u32x4 w; w.x = cvt_pk_bf16(o[0], o[1]); w.y = cvt_pk_bf16(o[2], o[3]); w.z = cvt_pk_bf16(o[4], o[5]); w.w = cvt_pk_bf16(o[6], o[7]);
                    *(u32x4*)(rowp + bj * HALF) = w; } }
    }
};
struct EpiOut {
    static constexpr bool PERM = true, AFTER_DRAIN = false;
    const float* Xlat; const float* Xctx; float* Xo; const float* MODL;
    __device__ __forceinline__ void operator()(const f32x4 (&acc)[2][2][4][2], const Unit& u, int wr, int wc, int fr, int fq) const {
        const int row0 = u.pm * BM + wr * 64 + fr, col0 = u.pn * BM + wc * 32 + 8 * fq;
        const float* g1 = MODL + (size_t)(u.pm < 64 ? (u.pm >> 3) : 8) * 6144 + col0;
        f32x4 gv[2][2];
#pragma unroll
        for (int bj = 0; bj < 2; ++bj) { gv[bj][0] = *(const f32x4*)(g1 + bj * HALF); gv[bj][1] = *(const f32x4*)(g1 + bj * HALF + 4); }
#pragma unroll
        for (int ai = 0; ai < 2; ++ai)
#pragma unroll
            for (int m = 0; m < 4; ++m) { const size_t ro = (size_t)(row0 + ai * HALF + m * 16) * D + col0; const float* rowp = (u.pm < 64 ? Xlat : Xctx) + ro; float* rowo = Xo + ro;
#pragma unroll
                for (int bj = 0; bj < 2; ++bj) { const f32x4* xp = (const f32x4*)(rowp + bj * HALF); f32x4* xo = (f32x4*)(rowo + bj * HALF); f32x4 x0 = xp[0], x1 = xp[1];
                    x0 += gv[bj][0] * acc[ai][bj][m][0]; x1 += gv[bj][1] * acc[ai][bj][m][1]; xo[0] = x0; xo[1] = x1; } }
    }
};
template <class Epi, class Sched, bool ALIGN_EPI = false, bool SP2 = false>
__device__ __forceinline__ void gemm_phase(PG8_LAS unsigned char* lds, const Gemm g, const Sched& S, const Epi& E) {
    const int tid = otid(), wid = __builtin_amdgcn_readfirstlane(tid >> 6), lane = tid & 63, wr = wid >> 2, wc = wid & 3, fr = lane & 15, fq = lane >> 4;
    const int K = g.K, nt = K / BK;
    unsigned voffA[2], voffB[2];
#pragma unroll
    for (int i = 0; i < 2; ++i) { int R, C; stage_rc(tid * 16 + i * 8192, R, C); const int Rb = Epi::PERM ? ((R & ~31) + perm32(R & 31)) : R;
        voffA[i] = (unsigned)(R * K + C) * 2u; voffB[i] = (unsigned)(Rb * K + C) * 2u; }
    const size_t kstep = (size_t)(BK * 2);
    const size_t hstep = (size_t)HALF * K * 2;
    const size_t tstep = 2 * hstep;
    const unsigned ldsw = (unsigned)wid * 1024u;
    const int aoff = lds_byte(wr * 64 + fr, fq * 8), boff = lds_byte(wc * 32 + fr, fq * 8);
#define PG8_SA(b, h) (((b) * 2 + (h)) * HTB)
#define PG8_SB(b, h) ((4 + (b) * 2 + (h)) * HTB)
#define PG8_STAGE(bufoff, gbase, voff) do { _Pragma("unroll") for (int _i = 0; _i < 2; ++_i) \
        __builtin_amdgcn_global_load_lds((const unsigned*)((const char*)(gbase) + (voff)[_i]), (PG8_LAS unsigned*)(lds + (bufoff) + ldsw + _i * 8192), 16, 0, 0); } while (0)
#define PG8_LDA(dst, b, h) do { _Pragma("unroll") for (int m = 0; m < 4; ++m) _Pragma("unroll") for (int k = 0; k < 2; ++k) dst[m][k] = *(const PG8_LAS bf16x8*)(lds + PG8_SA(b, h) + aoff + m * 2048 + k * 1024); } while (0)
#define PG8_LDB(dst, b, h) do { _Pragma("unroll") for (int n = 0; n < 2; ++n) _Pragma("unroll") for (int k = 0; k < 2; ++k) dst[n][k] = *(const PG8_LAS bf16x8*)(lds + PG8_SB(b, h) + boff + n * 2048 + k * 1024); } while (0)
#define PG8_MMA(ai, bj, At, Bt) do { __builtin_amdgcn_s_setprio(1); _Pragma("unroll") for (int m = 0; m < 4; ++m) _Pragma("unroll") for (int n = 0; n < 2; ++n) _Pragma("unroll") for (int k = 0; k < 2; ++k) \
        acc[ai][bj][m][n] = __builtin_amdgcn_mfma_f32_16x16x32_bf16(Bt[n][k], At[m][k], acc[ai][bj][m][n], 0, 0, 0); __builtin_amdgcn_s_setprio(0); } while (0)
#define PG8_WAIT_V(n) asm volatile("s_waitcnt vmcnt(" #n ")" ::: "memory")
#define PG8_WAIT_L(n) asm volatile("s_waitcnt lgkmcnt(" #n ")" ::: "memory")
#define PG8_BAR __builtin_amdgcn_s_barrier()
#define PG8_SCHED __builtin_amdgcn_sched_barrier(0)
    Unit cur, nxt; int ui = 0;
    if (!S.next(0, cur)) return;
    f32x4 acc[2][2][4][2];
#pragma unroll
    for (int a = 0; a < 2; ++a)
#pragma unroll
        for (int b = 0; b < 2; ++b)
#pragma unroll
            for (int m = 0; m < 4; ++m)
#pragma unroll
                for (int n = 0; n < 2; ++n) acc[a][b][m][n] = (f32x4){0.f, 0.f, 0.f, 0.f};
    bf16x8 At[4][2], B0[2][2], B1[2][2];
    const char* cA = (const char*)g.A + (size_t)cur.pm * tstep; const char* cB = (const char*)g.Bt + (size_t)cur.pn * tstep;
    S.a_ready(cur);
    if constexpr (SP2) {
        PG8_STAGE(PG8_SB(0, 0), cB, voffB); PG8_STAGE(PG8_SB(0, 1), cB + hstep, voffB); PG8_STAGE(PG8_SA(0, 0), cA, voffA); PG8_STAGE(PG8_SA(0, 1), cA + hstep, voffA);
        if (wr == 1) PG8_BAR;
        PG8_WAIT_V(2); PG8_BAR;
        PG8_STAGE(PG8_SB(1, 0), cB + kstep, voffB); PG8_STAGE(PG8_SA(1, 0), cA + kstep, voffA); PG8_STAGE(PG8_SB(1, 1), cB + hstep + kstep, voffB);
        PG8_WAIT_V(6); PG8_BAR;
    } else {
        PG8_STAGE(PG8_SB(0, 0), cB, voffB); PG8_STAGE(PG8_SA(0, 0), cA, voffA); PG8_STAGE(PG8_SB(0, 1), cB + hstep, voffB); PG8_STAGE(PG8_SA(0, 1), cA + hstep, voffA);
        if (wr == 1) PG8_BAR;
        PG8_WAIT_V(4); PG8_BAR;
        PG8_STAGE(PG8_SB(1, 0), cB + kstep, voffB); PG8_STAGE(PG8_SA(1, 0), cA + kstep, voffA); PG8_STAGE(PG8_SB(1, 1), cB + hstep + kstep, voffB);
        PG8_WAIT_V(6); PG8_BAR;
    }
    for (;;) {
        const bool has_next = S.next(ui + 1, nxt);
        const char* nA = has_next ? (const char*)g.A + (size_t)nxt.pm * tstep : cA; const char* nB = has_next ? (const char*)g.Bt + (size_t)nxt.pn * tstep : cB;
        for (int t = 0; t < nt; t += 2) {
            const bool last = (t == nt - 2);
            const char* a1 = cA + (size_t)(t + 1) * kstep;
            const char* a2 = last ? nA : cA + (size_t)(t + 2) * kstep; const char* b2 = last ? nB : cB + (size_t)(t + 2) * kstep;
            const char* a3 = a2 + kstep; const char* b3 = b2 + kstep;
            if (last && has_next) S.a_ready(nxt);
            if constexpr (SP2) {
            PG8_LDB(B0, 0, 0); PG8_LDB(B1, 0, 1); PG8_SCHED; PG8_LDA(At, 0, 0); PG8_STAGE(PG8_SA(1, 1), a1 + hstep, voffA);
            PG8_WAIT_V(8); PG8_WAIT_L(0); PG8_BAR; PG8_MMA(0, 0, At, B0); PG8_MMA(0, 1, At, B1); PG8_BAR; PG8_SCHED;
            PG8_LDA(At, 0, 1); PG8_STAGE(PG8_SB(0, 0), b2, voffB); PG8_STAGE(PG8_SB(0, 1), b2 + hstep, voffB); PG8_STAGE(PG8_SA(0, 0), a2, voffA);
            PG8_WAIT_V(8); PG8_WAIT_L(0); PG8_BAR; PG8_MMA(1, 0, At, B0); PG8_MMA(1, 1, At, B1); PG8_BAR; PG8_SCHED;
            PG8_LDB(B0, 1, 0); PG8_LDB(B1, 1, 1); PG8_SCHED; PG8_LDA(At, 1, 0); PG8_STAGE(PG8_SA(0, 1), a2 + hstep, voffA);
            PG8_WAIT_V(8); PG8_WAIT_L(0); PG8_BAR; PG8_MMA(0, 0, At, B0); PG8_MMA(0, 1, At, B1); PG8_BAR; PG8_SCHED;
            PG8_LDA(At, 1, 1); PG8_STAGE(PG8_SB(1, 0), b3, voffB); PG8_STAGE(PG8_SB(1, 1), b3 + hstep, voffB); PG8_STAGE(PG8_SA(1, 0), a3, voffA);
            PG8_WAIT_V(8); PG8_WAIT_L(0); PG8_BAR; PG8_MMA(1, 0, At, B0); PG8_MMA(1, 1, At, B1); PG8_BAR; PG8_SCHED;
            } else {
            PG8_LDB(B0, 0, 0); PG8_SCHED; PG8_LDA(At, 0, 0); PG8_STAGE(PG8_SA(1, 1), a1 + hstep, voffA);
            PG8_WAIT_L(8); PG8_BAR; PG8_WAIT_L(0); PG8_MMA(0, 0, At, B0); PG8_BAR; PG8_SCHED;
            PG8_LDB(B1, 0, 1); PG8_STAGE(PG8_SB(0, 0), b2, voffB);
            PG8_BAR; PG8_WAIT_L(0); PG8_MMA(0, 1, At, B1); PG8_BAR;
            PG8_LDA(At, 0, 1); PG8_STAGE(PG8_SA(0, 0), a2, voffA);
            PG8_BAR; PG8_WAIT_L(0); PG8_MMA(1, 0, At, B0); PG8_BAR; PG8_SCHED;
            PG8_STAGE(PG8_SB(0, 1), b2 + hstep, voffB);
            PG8_WAIT_V(6); PG8_BAR; PG8_MMA(1, 1, At, B1); PG8_BAR;
            PG8_LDB(B0, 1, 0); PG8_SCHED; PG8_LDA(At, 1, 0); PG8_STAGE(PG8_SA(0, 1), a2 + hstep, voffA);
            PG8_WAIT_L(8); PG8_BAR; PG8_WAIT_L(0); PG8_MMA(0, 0, At, B0); PG8_BAR; PG8_SCHED;
            PG8_LDB(B1, 1, 1); PG8_STAGE(PG8_SB(1, 0), b3, voffB);
            PG8_BAR; PG8_WAIT_L(0); PG8_MMA(0, 1, At, B1); PG8_BAR;
            PG8_LDA(At, 1, 1); PG8_STAGE(PG8_SA(1, 0), a3, voffA);
            PG8_BAR; PG8_WAIT_L(0); PG8_MMA(1, 0, At, B0); PG8_BAR; PG8_SCHED;
            PG8_STAGE(PG8_SB(1, 1), b3 + hstep, voffB);
            PG8_WAIT_V(6); PG8_BAR; PG8_MMA(1, 1, At, B1); PG8_BAR;
            }
        }
        if constexpr (ALIGN_EPI) { if (wr == 0) PG8_BAR; }
        if constexpr (!Epi::AFTER_DRAIN) { E(acc, cur, wr, wc, fr, fq); S.done(cur); }
        if (!has_next) break;
#pragma unroll
        for (int a = 0; a < 2; ++a)
#pragma unroll
            for (int b = 0; b < 2; ++b)
#pragma unroll
                for (int m = 0; m < 4; ++m)
#pragma unroll
                    for (int n = 0; n < 2; ++n) acc[a][b][m][n] = (f32x4){0.f, 0.f, 0.f, 0.f};
        cur = nxt; cA = nA; cB = nB; ++ui;
        if constexpr (ALIGN_EPI) { if (wr == 1) PG8_BAR; }
    }
    PG8_WAIT_V(0);
    if constexpr (!ALIGN_EPI) { if (wr == 0) PG8_BAR; }
    PG8_BAR;
    if constexpr (Epi::AFTER_DRAIN) { E.fused(acc, cur, wr, wc, fr, fq, lds, wid, lane); S.done(cur); }
#undef PG8_SA
#undef PG8_SB
#undef PG8_STAGE
#undef PG8_LDA
#undef PG8_LDB
#undef PG8_MMA
#undef PG8_WAIT_V
#undef PG8_WAIT_L
#undef PG8_BAR
#undef PG8_SCHED
}
}

#define GAS __attribute__((address_space(1)))
#define LAS __attribute__((address_space(3)))
typedef unsigned v4u __attribute__((ext_vector_type(4)));
typedef GAS unsigned gu32;
#define RLX_AGENT __ATOMIC_RELAXED, __HIP_MEMORY_SCOPE_AGENT
#define LDS_WAIT() asm volatile("s_waitcnt lgkmcnt(0)" ::: "memory")
#define XB_TMO      128
#define XB_XCNT(j)  (256  + 64 * (j))
#define XB_XSUB(j)  (1280 + 64 * (j))
#define XB_XGEN(j)  (2304 + 64 * (j))
#define XB_TOP      3328
#define XB_TOPGEN   3392
#define XCD_BAR_WORDS 3456
#define XB_SPIN_CAP (1u << 18)

__device__ __forceinline__ unsigned xb_ld(unsigned* p)              { return __hip_atomic_load(p, __ATOMIC_RELAXED, __HIP_MEMORY_SCOPE_AGENT); }
__device__ __forceinline__ unsigned xb_add(unsigned* p, unsigned v) { return __hip_atomic_fetch_add(p, v, __ATOMIC_RELAXED, __HIP_MEMORY_SCOPE_AGENT); }
__device__ __forceinline__ unsigned xb_xcc_id() { return (unsigned)__builtin_amdgcn_s_getreg((3 << 11) | 20) & 0xFu; }
#define XB_SPIN(cond, bar) do { unsigned _sp = 0; while (cond) { __builtin_amdgcn_s_sleep(1); \
    if ((++_sp & 255u) == 0u) { if (xb_ld(&(bar)[XB_TMO])) break; if (_sp > XB_SPIN_CAP) { atomicAdd(&(bar)[XB_TMO], 1u); break; } } } } while (0)

struct XcdBarrier {
    unsigned* bar; unsigned x;
    volatile LAS unsigned* st;
};

__device__ __forceinline__ XcdBarrier xcd_barrier_post(unsigned* bar, volatile LAS unsigned* st) {
    XcdBarrier b; b.bar = bar; b.x = xb_xcc_id(); b.st = st;
    if (threadIdx.x == 0) (void)xb_add(&bar[XB_XCNT(b.x)], 1u);
    return b;
}
__device__ __forceinline__ void xcd_barrier_complete(unsigned* bar, unsigned x, unsigned& nloc, unsigned& nx) {
    const unsigned G = gridDim.x * gridDim.y * gridDim.z;
    unsigned sum, cnt, mine, sp = 0u;
    for (;;) {
        sum = 0u; cnt = 0u; mine = 0u;
#pragma unroll
        for (unsigned j = 0; j < 16; ++j) { const unsigned c = xb_ld(&bar[XB_XCNT(j)]); sum += c; cnt += (c > 0u) ? 1u : 0u; mine = (j == x) ? c : mine; }
        if (sum == G) break;
        __builtin_amdgcn_s_sleep(1);
        if ((++sp & 255u) == 0u) { if (xb_ld(&bar[XB_TMO])) break; if (sp > XB_SPIN_CAP) { atomicAdd(&bar[XB_TMO], 1u); break; } }
    }
    nloc = mine > 0u ? mine : 1u; nx = cnt > 0u ? cnt : 1u;
}

__device__ __forceinline__ void xcd_barrier(const XcdBarrier& b) {
    asm volatile("s_waitcnt vmcnt(0)" ::: "memory");
    __syncthreads();
    if (threadIdx.x == 0) {
        unsigned* bar = b.bar; asm volatile("" : "+s"(bar));
        __builtin_amdgcn_s_waitcnt(0);
        unsigned nloc = b.st[0], nx = b.st[1];
        if (nloc == 0u) { xcd_barrier_complete(bar, b.x, nloc, nx); b.st[0] = nloc; b.st[1] = nx; }
        const unsigned old = xb_add(&bar[XB_XSUB(b.x)], 1u);
        const unsigned gen = old / nloc;
        if (old + 1u == (gen + 1u) * nloc) {
            __builtin_amdgcn_fence(__ATOMIC_RELEASE, "agent");
            asm volatile("s_waitcnt vmcnt(0)" ::: "memory");
            const unsigned og = xb_add(&bar[XB_TOP], 1u);
            const unsigned tg = og / nx;
            if (og + 1u == (tg + 1u) * nx) xb_add(&bar[XB_TOPGEN], 1u);
            else XB_SPIN(xb_ld(&bar[XB_TOPGEN]) == tg, bar);
            __builtin_amdgcn_fence(__ATOMIC_ACQUIRE, "agent");
            xb_add(&bar[XB_XGEN(b.x)], 1u);
            asm volatile("s_waitcnt vmcnt(0)" ::: "memory");
        } else {
            XB_SPIN(xb_ld(&bar[XB_XGEN(b.x)]) == gen, bar);
            __builtin_amdgcn_fence(__ATOMIC_ACQUIRE, "agent");
            asm volatile("s_waitcnt vmcnt(0)" ::: "memory");
        }
    }
    __syncthreads();
}

template <int O> __device__ __forceinline__ float swz_xor(float v) { return __uint_as_float((unsigned)__builtin_amdgcn_ds_swizzle((int)__float_as_uint(v), (O << 10) | 0x1F)); }
template <int O> __device__ __forceinline__ int swz_xor_i(int v) { return __builtin_amdgcn_ds_swizzle(v, (O << 10) | 0x1F); }
__device__ __forceinline__ float wave_sum(float v) {
    v += swz_xor<1>(v); v += swz_xor<2>(v); v += swz_xor<4>(v); v += swz_xor<8>(v); v += swz_xor<16>(v);
    auto rr = __builtin_amdgcn_permlane32_swap(__float_as_uint(v), __float_as_uint(v), false, false);
    return __uint_as_float(rr[0]) + __uint_as_float(rr[1]);
}

__device__ __forceinline__ void ph_norm(const P& p, int bid, int nb, const float* g, int li, int sh_i, int sc_i, int Mrows, bf16_t* out, bool from_inputs) {
    const int lane = otid() & 63, wave = otid() >> 6; const float* X = (const float*)(p.ws + WS_X); const float* MOD = (const float*)(p.ws + WS_MOD);
    for (int row = bid * 8 + wave; row < Mrows; row += nb * 8) {
        const float4* xr = (const float4*)(from_inputs ? (row < ML ? p.x + (size_t)row * D : p.ctx + (size_t)(row - ML) * D) : X + (size_t)row * D); float4 v[4]; float ss = 0;
#pragma unroll
        for (int j = 0; j < 4; ++j) { v[j] = xr[64 * j + lane]; ss += v[j].x * v[j].x + v[j].y * v[j].y + v[j].z * v[j].z + v[j].w * v[j].w; }
        const float rs = rsqrtf(wave_sum(ss) * (1.f / D) + EPS);
        const float* mrow = MOD + ((size_t)li * 9 + row_mod_idx(row)) * 6144;
#pragma unroll
        for (int j = 0; j < 4; ++j) { const int c0 = (64 * j + lane) * 4; const float4 gg = *(const float4*)(g + c0), sh = *(const float4*)(mrow + sh_i * 1024 + c0), sc = *(const float4*)(mrow + sc_i * 1024 + c0);
            ushort4 o; o.x = f2bf(v[j].x * rs * gg.x * (1.f + sc.x) + sh.x); o.y = f2bf(v[j].y * rs * gg.y * (1.f + sc.y) + sh.y); o.z = f2bf(v[j].z * rs * gg.z * (1.f + sc.z) + sh.z); o.w = f2bf(v[j].w * rs * gg.w * (1.f + sc.w) + sh.w);
            *(ushort4*)(out + (size_t)row * D + c0) = o; }
    }
}
namespace att {
using bf16x8 = __attribute__((ext_vector_type(8))) short;
using s16x4  = __attribute__((ext_vector_type(4))) short;
using f32x16 = __attribute__((ext_vector_type(16))) float;
using u32x4  = __attribute__((ext_vector_type(4))) unsigned;
constexpr int QBLK = 32, KVBLK = 64;
constexpr float SCALE = 0.125f, THR = 8.f;
constexpr int SHM_V = KVBLK * 128 * 2, SHM_K = KVBLK * 64 * 2;
constexpr int OFF_V = 0, OFF_K = 2 * SHM_V, OFF_WS = OFF_K + 2 * SHM_K, OFF_OST = OFF_WS + 8 * 64 * 4, LDS_TOTAL = OFF_OST + 8 * 8192;
#define AT_KSWZ(row, colB) ((row) * 128 + ((colB) ^ ((((row) >> 1) & 7) << 4)))
#define AT_SBAR() __builtin_amdgcn_sched_barrier(0)
__device__ __forceinline__ int crow(int r, int hi) { return (r & 3) + 8 * (r >> 2) + 4 * hi; }
__device__ __forceinline__ unsigned cvtpk(float lo, float hi) { unsigned r; asm volatile("v_cvt_pk_bf16_f32 %0, %1, %2" : "=v"(r) : "v"(lo), "v"(hi)); return r; }

__device__ __forceinline__ void partialSM(f32x16& p0, f32x16& p1, float& m_reg, float& mn, float& alpha) {
  constexpr float C = SCALE * 1.4426950408889634f;
  float pmax = p0[0];
#pragma unroll
  for (int r = 1; r < 16; ++r) pmax = fmaxf(pmax, p0[r]);
#pragma unroll
  for (int r = 0; r < 16; ++r) pmax = fmaxf(pmax, p1[r]);
  { auto rr = __builtin_amdgcn_permlane32_swap(__float_as_uint(pmax), __float_as_uint(pmax), false, false);
    pmax = fmaxf(__uint_as_float(rr[0]), __uint_as_float(rr[1])); }
  if (__builtin_expect(__all(pmax - m_reg <= THR / SCALE), 1)) { mn = m_reg; alpha = 1.f; }
  else { mn = fmaxf(m_reg, pmax); alpha = __builtin_amdgcn_exp2f((m_reg - mn) * C); m_reg = mn; }
  const float mnC = -mn * C;
#pragma unroll
  for (int r = 0; r < 16; ++r) p0[r] = fmaf(p0[r], C, mnC);
#pragma unroll
  for (int r = 0; r < 16; ++r) p1[r] = fmaf(p1[r], C, mnC);
#pragma unroll
  for (int r = 0; r < 16; ++r) p0[r] = __builtin_amdgcn_exp2f(p0[r]);
}
__device__ __forceinline__ void finishSM(f32x16& p0, f32x16& p1, float alpha, float& l_reg, bf16x8& pa0, bf16x8& pa1, bf16x8& pa2, bf16x8& pa3) {
#pragma unroll
  for (int r = 0; r < 16; ++r) p1[r] = __builtin_amdgcn_exp2f(p1[r]);
  float ps = 0;
#pragma unroll
  for (int r = 0; r < 16; ++r) ps += p0[r];
#pragma unroll
  for (int r = 0; r < 16; ++r) ps += p1[r];
  { auto rr = __builtin_amdgcn_permlane32_swap(__float_as_uint(ps), __float_as_uint(ps), false, false);
    ps = __uint_as_float(rr[0]) + __uint_as_float(rr[1]); }
  l_reg = l_reg * alpha + ps;
#define AT_PK4(P, BASE, OUT) do { unsigned a0 = cvtpk(P[BASE + 0], P[BASE + 1]), a1 = cvtpk(P[BASE + 2], P[BASE + 3]);   \
    unsigned b0 = cvtpk(P[BASE + 4], P[BASE + 5]), b1 = cvtpk(P[BASE + 6], P[BASE + 7]);                              \
    auto r0 = __builtin_amdgcn_permlane32_swap(a0, b0, false, false); auto r1 = __builtin_amdgcn_permlane32_swap(a1, b1, false, false); \
    u32x4 w = {r0[0], r1[0], r0[1], r1[1]}; OUT = *reinterpret_cast<bf16x8*>(&w); } while (0)
  AT_PK4(p0, 0, pa0); AT_PK4(p0, 8, pa1); AT_PK4(p1, 0, pa2); AT_PK4(p1, 8, pa3);
#undef AT_PK4
}
__device__ __forceinline__ void qkt(f32x16& p0, f32x16& p1, const char* Ks, const bf16x8* qr, int r32, int hi) {
  p0 = f32x16{}; p1 = f32x16{};
#pragma unroll
  for (int d0 = 0; d0 < 4; ++d0) { const int cb = (d0 * 16 + hi * 8) * 2;
    const bf16x8 b0 = *reinterpret_cast<const bf16x8*>(Ks + AT_KSWZ(r32, cb));
    const bf16x8 b1 = *reinterpret_cast<const bf16x8*>(Ks + AT_KSWZ(32 + r32, cb));
    p0 = __builtin_amdgcn_mfma_f32_32x32x16_bf16(b0, qr[d0], p0, 0, 0, 0);
    p1 = __builtin_amdgcn_mfma_f32_32x32x16_bf16(b1, qr[d0], p1, 0, 0, 0); }
}
__device__ __forceinline__ int v_st(int k, int c) { const int kk = (k & ~0xC) | ((k & 4) << 1) | ((k & 8) >> 1); return ((kk >> 3) * 4 + (c >> 5)) * 512 + ((kk & 7) * 32 + (c & 31)) * 2; }
__device__ __forceinline__ int v_rd_base(int lane) { return ((lane & 3) << 3) | (((lane >> 2) & 3) << 6) | (((lane >> 4) & 1) << 5) | (((lane >> 5) & 1) << 8); }
constexpr int v_rd_off(int d0, int ks, int half) { return d0 * 512 + ks * 4096 + half * 2048; }
template <int OFF> __device__ __forceinline__ s16x4 tr_read(int vb) {
  s16x4 r; asm volatile("ds_read_b64_tr_b16 %0, %1 offset:%2" : "=&v"(r) : "v"(vb), "i"(OFF) : "memory"); return r;
}
template <int D0> __device__ __forceinline__ void pv_one(f32x16& od, int vb, bf16x8 pa0, bf16x8 pa1, bf16x8 pa2, bf16x8 pa3) {
  const s16x4 l0 = tr_read<v_rd_off(D0, 0, 0)>(vb), h0 = tr_read<v_rd_off(D0, 0, 1)>(vb), l1 = tr_read<v_rd_off(D0, 1, 0)>(vb), h1 = tr_read<v_rd_off(D0, 1, 1)>(vb);
  const s16x4 l2 = tr_read<v_rd_off(D0, 2, 0)>(vb), h2 = tr_read<v_rd_off(D0, 2, 1)>(vb), l3 = tr_read<v_rd_off(D0, 3, 0)>(vb), h3 = tr_read<v_rd_off(D0, 3, 1)>(vb);
  asm volatile("s_waitcnt lgkmcnt(0)" ::: "memory"); AT_SBAR();
#define AT_PK(L, H) (bf16x8){L[0], L[1], L[2], L[3], H[0], H[1], H[2], H[3]}
  od = __builtin_amdgcn_mfma_f32_32x32x16_bf16(pa0, AT_PK(l0, h0), od, 0, 0, 0);
  od = __builtin_amdgcn_mfma_f32_32x32x16_bf16(pa1, AT_PK(l1, h1), od, 0, 0, 0);
  od = __builtin_amdgcn_mfma_f32_32x32x16_bf16(pa2, AT_PK(l2, h2), od, 0, 0, 0);
  od = __builtin_amdgcn_mfma_f32_32x32x16_bf16(pa3, AT_PK(l3, h3), od, 0, 0, 0);
#undef AT_PK
}
__device__ __forceinline__ void pv_d0(f32x16* o, int vb, bf16x8 pa0, bf16x8 pa1, bf16x8 pa2, bf16x8 pa3) {
  pv_one<0>(o[0], vb, pa0, pa1, pa2, pa3); pv_one<1>(o[1], vb, pa0, pa1, pa2, pa3); pv_one<2>(o[2], vb, pa0, pa1, pa2, pa3); pv_one<3>(o[3], vb, pa0, pa1, pa2, pa3);
}

__device__ __forceinline__ void attn_unit(const bf16_t* __restrict__ PROJ, bf16_t* __restrict__ ATT, float* stash, int h, int qrow0, int NT, int ctx0, int lat0, bool is_ctx,
                                          float lam, float osc, const float* __restrict__ sg, char* lds) {
  const int tid = otid(), wid = tid >> 6, lane = tid & 63, r32 = lane & 31, hi = lane >> 5;
  char* V_lds = lds + OFF_V; char* K_lds = lds + OFF_K;
  float* wsf = (float*)(lds + OFF_WS) + wid * 64; float* li_l = wsf; float* al_l = wsf + 32;
  const int sr = tid >> 4, sc = (tid & 15) * 8, vst0 = v_st(sr, sc), vst1 = v_st(32 + sr, sc);
  const int kr = tid >> 3, kcb = (tid & 7) * 16, kst = AT_KSWZ(kr, kcb);
  const int vb0 = (int)(uintptr_t)V_lds + v_rd_base(lane);
#define AT_TROW(j) (is_ctx ? ctx0 + (j) * 64 : ((j) < 4 ? ctx0 + (j) * 64 : lat0 + ((j) - 4) * 64))
  f32x16 o[4];
  const int moff0 = wid * 64 * 64 + lane;
  for (int m = 0; m < 2; ++m) {
    __syncthreads();
    const unsigned voffV0 = (unsigned)((sr * DIN + C_V + h * 128 + sc) * 2), voffV1 = voffV0 + 32u * DIN * 2u, voffK = (unsigned)((kr * DIN + C_K + h * 128 + m * 64) * 2 + kcb);
    bf16x8 qr[4];
    { const bf16_t* Qw = PROJ + (size_t)(qrow0 + wid * QBLK + r32) * DIN + C_Q + h * 128 + m * 64 + hi * 8;
#pragma unroll
      for (int d0 = 0; d0 < 4; ++d0) qr[d0] = *reinterpret_cast<const bf16x8*>(Qw + d0 * 16); }
    float m_reg = -1e30f, l_reg = 0.f;
#pragma unroll
    for (int d = 0; d < 4; ++d) o[d] = f32x16{};
    struct { bf16x8 vs0, vs1, ks0; } sr_[2];
#define AT_SLOAD(i, j) do { size_t to_ = (size_t)(AT_TROW(j)) * (DIN * 2); asm volatile("" : "+s"(to_)); const char* tb_ = (const char*)PROJ + to_;     sr_[i].vs0 = *reinterpret_cast<const bf16x8*>(tb_ + voffV0); sr_[i].vs1 = *reinterpret_cast<const bf16x8*>(tb_ + voffV1); \
    sr_[i].ks0 = *reinterpret_cast<const bf16x8*>(tb_ + voffK); } while (0)
#define AT_SWRITE(b, i) do { *(bf16x8*)(V_lds + (b) * SHM_V + vst0) = sr_[i].vs0; *(bf16x8*)(V_lds + (b) * SHM_V + vst1) = sr_[i].vs1; *(bf16x8*)(K_lds + (b) * SHM_K + kst) = sr_[i].ks0; } while (0)
#define AT_SWAIT() asm volatile("s_waitcnt vmcnt(3)" ::: "memory")
#define AT_RESC(a) do { if (__any((a) < 1.f)) { if (hi == 0) al_l[r32] = (a); asm volatile("s_waitcnt lgkmcnt(0)" ::: "memory"); \
    _Pragma("unroll") for (int d = 0; d < 4; ++d) _Pragma("unroll") for (int r = 0; r < 16; ++r) o[d][r] *= al_l[crow(r, hi)]; } } while (0)
    f32x16 pA0, pA1, pB0, pB1; float mnA, mnB, alA, alB; bf16x8 pa0, pa1, pa2, pa3;
    constexpr int SE = 0, SO = 1;
    AT_SLOAD(SE, 0); asm volatile("s_waitcnt vmcnt(0)" ::: "memory"); AT_SWRITE(0, SE); __syncthreads();
    qkt(pA0, pA1, K_lds, qr, r32, hi); partialSM(pA0, pA1, m_reg, mnA, alA);
    AT_SLOAD(SO, 1); if (2 < NT) AT_SLOAD(SE, 2);
    AT_SWAIT(); AT_SWRITE(1, SO); __syncthreads();
    for (int j = 1; j + 1 < NT; j += 2) {
      AT_SBAR(); qkt(pB0, pB1, K_lds + SHM_K, qr, r32, hi);
      finishSM(pA0, pA1, alA, l_reg, pa0, pa1, pa2, pa3); AT_SBAR();
      AT_SLOAD(SO, j + 2); AT_SBAR();
      pv_d0(o, vb0, pa0, pa1, pa2, pa3); partialSM(pB0, pB1, m_reg, mnB, alB);
      __syncthreads(); AT_SWAIT(); AT_SWRITE(0, SE);
      AT_RESC(alB); __syncthreads();
      AT_SBAR(); qkt(pA0, pA1, K_lds, qr, r32, hi);
      finishSM(pB0, pB1, alB, l_reg, pa0, pa1, pa2, pa3); AT_SBAR();
      if (j + 3 < NT) AT_SLOAD(SE, j + 3);
      AT_SBAR();
      pv_d0(o, vb0 + SHM_V, pa0, pa1, pa2, pa3); partialSM(pA0, pA1, m_reg, mnA, alA);
      __syncthreads(); AT_SWAIT(); AT_SWRITE(1, SO);
      AT_RESC(alA); __syncthreads();
    }
    AT_SBAR(); qkt(pB0, pB1, K_lds + SHM_K, qr, r32, hi);
    finishSM(pA0, pA1, alA, l_reg, pa0, pa1, pa2, pa3); AT_SBAR();
    pv_d0(o, vb0, pa0, pa1, pa2, pa3); partialSM(pB0, pB1, m_reg, mnB, alB);
    __syncthreads(); AT_RESC(alB);
    finishSM(pB0, pB1, alB, l_reg, pa0, pa1, pa2, pa3); AT_SBAR();
    pv_d0(o, vb0 + SHM_V, pa0, pa1, pa2, pa3);
    if (hi == 0) li_l[r32] = l_reg;
    asm volatile("s_waitcnt lgkmcnt(0)" ::: "memory");
    float rli[16];
#pragma unroll
    for (int r = 0; r < 16; ++r) rli[r] = __builtin_amdgcn_rcpf(li_l[crow(r, hi)]);
    if (m == 0) {
#pragma unroll
      for (int d0 = 0; d0 < 4; ++d0) { int mo_ = moff0 + d0 * 1024; asm volatile("" : "+v"(mo_)); float* ms = stash + mo_;
#pragma unroll
        for (int r = 0; r < 16; ++r) ms[r * 64] = o[d0][r] * rli[r]; }
    } else {
#pragma unroll
      for (int d0 = 0; d0 < 4; ++d0) { int mo_ = moff0 + d0 * 1024; asm volatile("" : "+v"(mo_)); const float* ms = stash + mo_;
#pragma unroll
        for (int r = 0; r < 16; ++r) o[d0][r] = ms[r * 64] - lam * (o[d0][r] * rli[r]); }
    }
#undef AT_SLOAD
#undef AT_SWRITE
#undef AT_SWAIT
#undef AT_RESC
  }
  float rs[16];
#pragma unroll
  for (int r = 0; r < 16; ++r) { float s = o[0][r] * o[0][r] + o[1][r] * o[1][r] + o[2][r] * o[2][r] + o[3][r] * o[3][r];
    s += swz_xor<1>(s); s += swz_xor<2>(s); s += swz_xor<4>(s); s += swz_xor<8>(s); s += swz_xor<16>(s);
    rs[r] = rsqrtf(s * (1.f / 128.f) + EPS) * osc; }
  float sgv[4];
#pragma unroll
  for (int d0 = 0; d0 < 4; ++d0) sgv[d0] = sg[d0 * 32 + r32];
  bf16_t* stg = (bf16_t*)(lds + OFF_OST) + wid * 4096;
#pragma unroll
  for (int r = 0; r < 16; ++r) { const int orow = crow(r, hi);
#pragma unroll
    for (int d0 = 0; d0 < 4; ++d0) stg[orow * 128 + d0 * 32 + r32] = f2bf(o[d0][r] * rs[r] * sgv[d0]); }
  asm volatile("s_waitcnt lgkmcnt(0)" ::: "memory");
  bf16_t* Ow = ATT + (size_t)(qrow0 + wid * QBLK) * D + h * 128;
#pragma unroll
  for (int i = 0; i < 8; ++i) { const int row = i * 4 + (lane >> 4), ch = lane & 15; const u32x4 v = *(const u32x4*)(stg + row * 128 + ch * 8); *(u32x4*)(Ow + (size_t)row * D + ch * 8) = v; }
#undef AT_TROW
}
#undef AT_KSWZ
#undef AT_SBAR
}

__device__ __forceinline__ void ph_attn(const P& p, int li, bool do_ctx, int bid, int nb, unsigned char* lds) {
    const bf16_t* PROJ = (const bf16_t*)(p.ws + WS_PROJ); bf16_t* ATT = (bf16_t*)(p.ws + WS_ATT);
    const float lam = ((const float*)(p.ws + WS_LAM))[li]; const float osc = 1.f - lambda_init_of(li);
    const int vcu = (nb % 8 == 0) ? (bid % 8) * (nb / 8) + bid / 8 : bid;
    float* stash = (float*)(p.ws + WS_STASH) + (size_t)bid * (8 * 64 * 64);
    const int nlat = 512, nctx = do_ctx ? 64 : 0;
    for (int u = vcu; u < nlat; u += nb) { const int b = u >> 6, h = (u >> 3) & 7, qb = u & 7;
        att::attn_unit(PROJ, ATT, stash, h, b * 2048 + qb * 256, 36, ML + b * 256, b * 2048, false, lam, osc, p.subln_g + li * 128, (char*)lds); }
    { const int first = 0; const int span = nb - first;
      for (int v = bid - first; v >= 0 && v < nctx; v += span) { const int b = v >> 3, h = v & 7;
        att::attn_unit(PROJ, ATT, stash, h, ML + b * 256, 4, ML + b * 256, b * 2048, true, lam, osc, p.subln_g + li * 128, (char*)lds); } }
}
namespace lru {
using bf16x8 = __attribute__((ext_vector_type(8))) short;
using f32x16 = __attribute__((ext_vector_type(16))) float;
using u32x4  = __attribute__((ext_vector_type(4))) unsigned;
constexpr int T = 256;
constexpr int L_URAW = 0, L_UCF = 33280, L_UCB = L_UCF + 32768, L_GLT = L_UCB + 256 * 144, L_LAT = L_GLT + 16384, L_SUMS = L_LAT + 16384, L_BW = L_SUMS + 8192, L_END = L_BW + 8192;
__device__ __forceinline__ float fast_sigmoid(float x) { return __builtin_amdgcn_rcpf(1.f + __expf(-x)); }
__device__ __forceinline__ float one_minus_exp(float x, float a) {
    float pl = 1.f / 5040.f; pl = fmaf(pl, x, 1.f / 720.f); pl = fmaf(pl, x, 1.f / 120.f); pl = fmaf(pl, x, 1.f / 24.f); pl = fmaf(pl, x, 1.f / 6.f); pl = fmaf(pl, x, 0.5f); pl = fmaf(pl, x, 1.f);
    return x > -0.5f ? -x * pl : 1.f - a * a; }
__device__ __forceinline__ float fast_gelu(float x) { const float u = 0.7978845608028654f * (x + 0.044715f * x * x * x); return x * fast_sigmoid(2.f * u); }
}

__device__ __forceinline__ void ph_lru(const P& p, int li, int bid, int nb, unsigned char* lds) {
    using namespace lru;
    const bf16_t* PROJ = (const bf16_t*)(p.ws + WS_PROJ); float* HF = (float*)(p.ws + WS_HF); bf16_t* LA = (bf16_t*)(p.ws + WS_LA);
    const int tid = otid(), wave = tid >> 6, lane = tid & 63, r32 = lane & 31, hi = lane >> 5, tt = wave;
    const int c = r32;
    const int sub = tt * 2 + hi;
    float* UCF = (float*)(lds + L_UCF); float* SUMS = (float*)(lds + L_SUMS);
    for (int item = bid; item < 256; item += nb) {
        const int b = item >> 5, n = (item >> 1) & 15, hfi = item & 1; const int ch0 = n * 64, cb32 = ch0 + hfi * 32;
        int tid_i = tid; asm volatile("" : "+v"(tid_i));
        const int c2 = tid_i & 31, tq = tid_i >> 5;
        float cw0[4], cw1[4];
#pragma unroll
        for (int k = 0; k < 4; ++k) { cw0[k] = p.conv_w[(size_t)(li * 4 + k) * 1024 + ch0 + 2 * c2]; cw1[k] = p.conv_w[(size_t)(li * 4 + k) * 1024 + ch0 + 2 * c2 + 1]; }
        const float cb0 = p.conv_b[li * 1024 + ch0 + 2 * c2], cb1 = p.conv_b[li * 1024 + ch0 + 2 * c2 + 1];
        for (int d = 0; d < 2; ++d) {
            int c_w = c; asm volatile("" : "+v"(c_w));
            { const int g = wave >> 2, ks = wave & 3;
              const float* wp = p.lru_w + ((((size_t)(li * 2 + d) * 2 + g) * 16 + n) * 64) * 64 + hfi * 32 + c_w + (size_t)(ks * 16 + 8 * hi) * 64;
              float wf[8];
#pragma unroll
              for (int j = 0; j < 8; ++j) wf[j] = wp[(size_t)j * 64];
              asm volatile("s_waitcnt vmcnt(0)" ::: "memory");
              *(u32x4*)(lds + L_BW + ((g * 4 + ks) * 64 + lane) * 16) = (u32x4){pk2(wf[0], wf[1]), pk2(wf[2], wf[3]), pk2(wf[4], wf[5]), pk2(wf[6], wf[7])}; }
            const float bias0 = p.lru_b[((size_t)(li * 2 + d) * 2 + 0) * 1024 + cb32 + c_w], bias1 = p.lru_b[((size_t)(li * 2 + d) * 2 + 1) * 1024 + cb32 + c_w];
            float sp8; { const float lam = p.lru_lam[(size_t)(li * 2 + d) * 1024 + cb32 + c_w]; const float z = -lam; const float ez = __expf(z);
              const float spl = ez < 0.1f ? ez * (1.f - ez * (0.5f - ez * (0.33333333f - ez * (0.25f - ez * 0.2f)))) : (z > 20.f ? z : __logf(1.f + ez)); sp8 = -8.f * spl; }
            float state = 0.f;
            u32x4 st_u[5]; u32x4 st_g[2];
#define LRU_CHUNK_ROW0(step_, row0_, L_, t0_) { int cc_; if ((step_) < 1) { cc_ = 0; L_ = 256; row0_ = ML + b * 256; } else { cc_ = d == 0 ? (step_) - 1 : 8 - (step_); L_ = 2048; row0_ = b * 2048; } t0_ = cc_ * T; }
#define LRU_STAGE_LOAD(step_) { int row0_, L_, t0_; LRU_CHUNK_ROW0(step_, row0_, L_, t0_); int tid_ = tid; asm volatile("" : "+v"(tid_));   \
            _Pragma("unroll") for (int q_ = 0; q_ < 5; ++q_) { const int piece_ = tid_ + 512 * q_; const int i_ = piece_ >> 3, chk_ = piece_ & 7; const int tr_ = t0_ - 2 + i_; st_u[q_] = (u32x4){0u, 0u, 0u, 0u}; \
                if (piece_ < 259 * 8 && tr_ >= 0 && tr_ < L_) st_u[q_] = *(const u32x4*)(PROJ + (size_t)(row0_ + tr_) * DIN + C_U + ch0 + chk_ * 8); } \
            if (d == 1) { _Pragma("unroll") for (int q_ = 0; q_ < 2; ++q_) { const int piece_ = tid_ + 512 * q_; const int i_ = piece_ >> 2, chk_ = piece_ & 3; st_g[q_] = *(const u32x4*)(PROJ + (size_t)(row0_ + t0_ + i_) * DIN + C_GL + cb32 + chk_ * 8); } } }
            LRU_STAGE_LOAD(0);
            for (int step = 0; step < 9; ++step) {
                int row0, Lseq, t0; LRU_CHUNK_ROW0(step, row0, Lseq, t0);
                const int crow0 = row0 + t0;
                const int spos0 = (Lseq == 256 ? 0 : 256) + t0;
#pragma unroll
                for (int q = 0; q < 5; ++q) { const int piece = tid + 512 * q; if (piece < 259 * 8) *(u32x4*)(lds + L_URAW + piece * 16) = st_u[q]; }
                if (d == 1) {
#pragma unroll
                    for (int q = 0; q < 2; ++q) { const int piece = tid + 512 * q; *(u32x4*)(lds + L_GLT + piece * 16) = st_g[q]; } }
                __syncthreads();
                if (step + 1 < 9) LRU_STAGE_LOAD(step + 1);
                float hf[16];
                if (d == 1) { int sub_o = sub; asm volatile("" : "+v"(sub_o)); int ho_ = (item * 2304 + spos0 + 255 - sub_o * 16) * 32 + c; asm volatile("" : "+v"(ho_)); const float* hp = HF + ho_;
#pragma unroll
                    for (int r = 0; r < 16; ++r) hf[r] = hp[-r * 32]; }
#pragma unroll
                for (int hh = 0; hh < 2; ++hh) {
                    float x0[11], x1[11]; const int tb8 = tq * 16 + hh * 8;
#pragma unroll
                    for (int i = 0; i < 11; ++i) { const unsigned w = *(const unsigned*)(lds + L_URAW + (tb8 + i) * 128 + c2 * 4); x0[i] = __uint_as_float(w << 16); x1[i] = __uint_as_float(w & 0xffff0000u); }
                    const bool mine = (c2 >> 4) == hfi;
#pragma unroll
                    for (int e = 0; e < 8; ++e) { const int tk = tb8 + e, t = d ? 255 - tk : tk;
                        const float y0 = cb0 + cw0[0] * x0[e] + cw0[1] * x0[e + 1] + cw0[2] * x0[e + 2] + cw0[3] * x0[e + 3];
                        const float y1 = cb1 + cw1[0] * x1[e] + cw1[1] * x1[e + 1] + cw1[2] * x1[e + 2] + cw1[3] * x1[e + 3];
                        if (mine) *(float2*)(UCF + t * 32 + 2 * (c2 & 15)) = make_float2(y0, y1);
                        *(unsigned*)(lds + L_UCB + t * 144 + c2 * 4) = pk2(y0, y1); }
                    __builtin_amdgcn_sched_barrier(0);
                }
                __syncthreads();
                f32x16 acc0 = f32x16{}, acc1 = f32x16{};
                {
                    const int i = r32, hc = (i >> 2) & 1, rr = (i & 3) + 4 * (i >> 3), rho = (tt * 2 + hc) * 16 + rr;
                    const unsigned char* ap = lds + L_UCB + rho * 144 + hi * 16;
#pragma unroll
                    for (int ks = 0; ks < 4; ++ks) { const bf16x8 a = *(const bf16x8*)(ap + ks * 32);
                        const bf16x8 b0 = *(const bf16x8*)(lds + L_BW + (ks * 64 + lane) * 16), b1 = *(const bf16x8*)(lds + L_BW + ((4 + ks) * 64 + lane) * 16);
                        acc0 = __builtin_amdgcn_mfma_f32_32x32x16_bf16(a, b0, acc0, 0, 0, 0); acc1 = __builtin_amdgcn_mfma_f32_32x32x16_bf16(a, b1, acc1, 0, 0, 0); }
                }
                float hl[16], ap_[16]; float P = 1.f, h = 0.f;
                const float* ucp = UCF + (sub * 16) * 32 + c;
#pragma unroll
                for (int r = 0; r < 16; ++r) {
                    const float u = ucp[r * 32]; const float rec = fast_sigmoid(acc0[r] + bias0), inp = fast_sigmoid(acc1[r] + bias1);
                    const float la = sp8 * rec; const float a = __expf(la); const float m2 = one_minus_exp(2.f * la, a); const float drive = __builtin_amdgcn_sqrtf(m2) * (inp * u);
                    h = a * h + drive; P *= a; hl[r] = h; ap_[r] = P;
                    if ((r & 3) == 3) __builtin_amdgcn_sched_barrier(0); }
                float* sums = SUMS + (step & 1) * 1024;
                *(float2*)(sums + (sub * 32 + c) * 2) = make_float2(P, h);
                __syncthreads();
                float carry = state, mine = state;
#pragma unroll
                for (int s = 0; s < 16; ++s) { if (s == sub) mine = carry; const float2 ph = *(const float2*)(sums + (s * 32 + c) * 2); carry = ph.x * carry + ph.y; }
                state = carry;
                if (d == 0) {
                    int sub_o = sub; asm volatile("" : "+v"(sub_o)); int ho_ = (item * 2304 + spos0 + sub_o * 16) * 32 + c; asm volatile("" : "+v"(ho_)); float* hp = HF + ho_;
#pragma unroll
                    for (int r = 0; r < 16; ++r) hp[r * 32] = hl[r] + ap_[r] * mine;
                } else {
                    bf16_t* lat = (bf16_t*)(lds + L_LAT); const bf16_t* glt = (const bf16_t*)(lds + L_GLT);
                    const int tb = 255 - sub * 16;
#pragma unroll
                    for (int r = 0; r < 16; ++r) { const float hb = hl[r] + ap_[r] * mine; const float gl = bf2f(glt[(tb - r) * 32 + c]);
                        lat[(tb - r) * 32 + c] = f2bf((hf[r] + hb) * fast_gelu(gl)); }
                    __syncthreads();
                    int tid3 = tid; asm volatile("" : "+v"(tid3));
#pragma unroll
                    for (int q = 0; q < 2; ++q) { const int piece = tid3 + 512 * q; const int i = piece >> 2, chk = piece & 3;
                        *(u32x4*)(LA + (size_t)(crow0 + i) * D + cb32 + chk * 8) = *(const u32x4*)(lds + L_LAT + piece * 16); }
                }
            }
#undef LRU_STAGE_LOAD
#undef LRU_CHUNK_ROW0
            asm volatile("s_waitcnt vmcnt(0)" ::: "memory");
            __syncthreads();
            if (tid == 0) { __builtin_amdgcn_fence(__ATOMIC_ACQUIRE, "agent"); asm volatile("s_waitcnt vmcnt(0)" ::: "memory"); }
            __syncthreads();
        }
    }
}
namespace peer {
using bf16x8 = __attribute__((ext_vector_type(8))) short;
using f32x16 = __attribute__((ext_vector_type(16))) float;
using u32x4  = __attribute__((ext_vector_type(4))) unsigned;
typedef __bf16 bf16x2_t __attribute__((ext_vector_type(2)));
__device__ __forceinline__ unsigned sortable(float f) { const unsigned u = __float_as_uint(f); return (u & 0x80000000u) ? ~u : (u | 0x80000000u); }
__device__ __forceinline__ float unsortable(unsigned u) { return __uint_as_float((u & 0x80000000u) ? (u & 0x7fffffffu) : ~u); }
__device__ __forceinline__ unsigned umax_(unsigned a, unsigned b) { return a > b ? a : b; }
__device__ __forceinline__ unsigned umin_(unsigned a, unsigned b) { return a < b ? a : b; }
__device__ __forceinline__ void sort16_desc(unsigned (&v)[16]) {
#pragma unroll
    for (int kk = 1; kk <= 4; ++kk)
#pragma unroll
        for (int jj = 3; jj >= 0; --jj)
#pragma unroll
            for (int i = 0; i < 16; ++i) { const int k = 1 << kk, j = 1 << jj, l = i ^ j; if (jj >= kk) continue;
                if (l > i) { const unsigned mx = umax_(v[i], v[l]), mn = umin_(v[i], v[l]); if ((i & k) == 0) { v[i] = mx; v[l] = mn; } else { v[i] = mn; v[l] = mx; } } }
}
__device__ __forceinline__ void merge_top16(unsigned (&a)[16], const unsigned (&b)[16]) {
#pragma unroll
    for (int i = 0; i < 16; ++i) a[i] = umax_(a[i], b[15 - i]);
#pragma unroll
    for (int jj = 3; jj >= 0; --jj)
#pragma unroll
        for (int i = 0; i < 16; ++i) { const int j = 1 << jj, l = i ^ j; if (l > i) { const unsigned mx = umax_(a[i], a[l]), mn = umin_(a[i], a[l]); a[i] = mx; a[l] = mn; } }
}
__device__ __forceinline__ int crow(int r, int hi) { return (r & 3) + 8 * (r >> 2) + 4 * hi; }
__device__ __forceinline__ float dot2(unsigned a, unsigned b, float acc) { return __builtin_amdgcn_fdot2_f32_bf16(__builtin_bit_cast(bf16x2_t, a), __builtin_bit_cast(bf16x2_t, b), acc, false); }
__device__ __forceinline__ unsigned msel(unsigned a, unsigned b, unsigned m) { return a ^ ((a ^ b) & m); }
__device__ __forceinline__ unsigned pick16(const unsigned (&a)[16], int i) {
    const unsigned m0 = 0u - (unsigned)(i & 1), m1 = 0u - (unsigned)((i >> 1) & 1), m2 = 0u - (unsigned)((i >> 2) & 1), m3 = 0u - (unsigned)((i >> 3) & 1);
    unsigned t8[8], t4[4], t2[2];
#pragma unroll
    for (int k = 0; k < 8; ++k) t8[k] = msel(a[2 * k], a[2 * k + 1], m0);
#pragma unroll
    for (int k = 0; k < 4; ++k) t4[k] = msel(t8[2 * k], t8[2 * k + 1], m1);
#pragma unroll
    for (int k = 0; k < 2; ++k) t2[k] = msel(t4[2 * k], t4[2 * k + 1], m2);
    return msel(t2[0], t2[1], m3); }
__device__ __forceinline__ void score_list(const bf16_t* __restrict__ PQ, const bf16_t* __restrict__ KEYS, int tok, int hp, int r32, int hi, unsigned (&T)[16]) {
    const bf16_t* qp = PQ + (size_t)tok * D + hp * 64 + hi * 8; bf16x8 qf[4];
#pragma unroll
    for (int ks = 0; ks < 4; ++ks) qf[ks] = *reinterpret_cast<const bf16x8*>(qp + ks * 16);
    const bf16_t* kp = KEYS + ((size_t)hp * 128 + r32) * 64 + hi * 8;
#pragma unroll
    for (int kt = 0; kt < 4; ++kt) { f32x16 acc = f32x16{};
#pragma unroll
        for (int ks = 0; ks < 4; ++ks) { const bf16x8 a = *reinterpret_cast<const bf16x8*>(kp + (size_t)kt * 32 * 64 + ks * 16); acc = __builtin_amdgcn_mfma_f32_32x32x16_bf16(a, qf[ks], acc, 0, 0, 0); }
        unsigned v[16];
#pragma unroll
        for (int r = 0; r < 16; ++r) v[r] = (sortable(acc[r]) & ~127u) | (unsigned)(127 - (kt * 32 + crow(r, hi)));
        sort16_desc(v);
        if (kt == 0) {
#pragma unroll
            for (int r = 0; r < 16; ++r) T[r] = v[r];
        } else merge_top16(T, v);
    }
}
}

__device__ __forceinline__ void ph_peer_score(const P& p, int li, int Mrows, int bid, int nb) {
    using namespace peer;
    const bf16_t* PQ = (const bf16_t*)(p.ws + WS_PQ); const bf16_t* KEYS = (const bf16_t*)(p.ws + WS_KEYS) + (size_t)li * 16 * 128 * 64;
    int* IDX = (int*)(p.ws + WS_IDX); float* G = (float*)(p.ws + WS_G);
    const int tid = otid(), wave = tid >> 6, lane = tid & 63, r32 = lane & 31, hi = lane >> 5;
    const int gw = bid * NWAVES + wave, NGW = nb * NWAVES, ntask = (Mrows / 32) * 4;
    for (int task = gw; task < ntask; task += NGW) {
        const int tok = (task >> 2) * 32 + r32, hp2 = task & 3;
        for (int hh = 0; hh < 2; ++hh) { const int h = hp2 * 2 + hh;
            unsigned A0[16], B0[16];
            score_list(PQ, KEYS, tok, h * 2 + 0, r32, hi, A0); score_list(PQ, KEYS, tok, h * 2 + 1, r32, hi, B0);
            unsigned M[16], Y[16];
#pragma unroll
            for (int i = 0; i < 16; ++i) { auto rr = __builtin_amdgcn_permlane32_swap(A0[i], B0[i], false, false); M[i] = rr[0]; Y[i] = rr[1]; }
            merge_top16(M, Y);
            unsigned P0[16], P1[16];
#pragma unroll
            for (int i = 0; i < 16; ++i) { auto rr = __builtin_amdgcn_permlane32_swap(M[i], M[i], false, false); P0[i] = rr[0]; P1[i] = rr[1]; }
            float X[16], Yv[16];
#pragma unroll
            for (int i = 0; i < 16; ++i) { const float f0 = unsortable(P0[i]), f1 = unsortable(P1[i]); X[i] = hi ? f1 : f0; Yv[i] = hi ? f0 : f1; }
            unsigned C0[16], C1[16];
#pragma unroll
            for (int c = 0; c < 16; ++c) { const float s = X[0] + Yv[c]; const unsigned flat = hi ? (unsigned)(c * 16) : (unsigned)c; unsigned key = (sortable(s) & ~255u) | (255u - flat); if (c == 0 && hi) key = 0u; C0[c] = key; }
#define PEER_CAND(c, i, j) { const float s_ = X[i] + Yv[j]; const unsigned flat_ = hi ? (unsigned)((j) * 16 + (i)) : (unsigned)((i) * 16 + (j)); unsigned key_ = (sortable(s_) & ~255u) | (255u - flat_); if ((i) == (j) && hi) key_ = 0u; C1[c] = key_; }
            PEER_CAND(0, 1, 1) PEER_CAND(1, 1, 2) PEER_CAND(2, 1, 3) PEER_CAND(3, 1, 4) PEER_CAND(4, 1, 5) PEER_CAND(5, 1, 6) PEER_CAND(6, 1, 7) PEER_CAND(7, 2, 2) PEER_CAND(8, 2, 3) PEER_CAND(9, 2, 4) PEER_CAND(10, 3, 3)
#undef PEER_CAND
            C1[11] = 0u; C1[12] = 0u; C1[13] = 0u; C1[14] = 0u; C1[15] = 0u;
            sort16_desc(C0); sort16_desc(C1); merge_top16(C0, C1);
            unsigned F[16]; unsigned mxk;
            { unsigned Clo[16], Chi[16];
#pragma unroll
              for (int i = 0; i < 16; ++i) { auto rr = __builtin_amdgcn_permlane32_swap(C0[i], C0[i], false, false); Clo[i] = rr[0]; Chi[i] = rr[1]; }
#pragma unroll
              for (int i = 0; i < 16; ++i) F[i] = umax_(Clo[i], Chi[15 - i]);
              mxk = umax_(Clo[0], Chi[0]); }
            const float fmx = unsortable(mxk); float w[16]; float wsum = 0.f;
#pragma unroll
            for (int i = 0; i < 16; ++i) { w[i] = __expf(unsortable(F[i]) - fmx); wsum += w[i]; }
            const float inv = 1.f / wsum;
            int oi[8]; float og[8]; const unsigned him = 0u - (unsigned)hi;
#pragma unroll
            for (int k = 0; k < 8; ++k) { const unsigned e = msel(F[k], F[8 + k], him); const float wk = __uint_as_float(msel(__float_as_uint(w[k]), __float_as_uint(w[8 + k]), him));
                const int cf = 255 - (int)(e & 255u), i1 = cf >> 4, i2 = cf & 15;
                const int n1 = 127 - (int)(pick16(P0, i1) & 127u), n2 = 127 - (int)(pick16(P1, i2) & 127u);
                oi[k] = n1 * 128 + n2; og[k] = wk * inv; }
            int* ip = IDX + (size_t)tok * 128 + h * 16 + hi * 8; float* gp = G + (size_t)tok * 128 + h * 16 + hi * 8;
            *(int4*)ip = make_int4(oi[0], oi[1], oi[2], oi[3]); *(int4*)(ip + 4) = make_int4(oi[4], oi[5], oi[6], oi[7]);
            *(float4*)gp = make_float4(og[0], og[1], og[2], og[3]); *(float4*)(gp + 4) = make_float4(og[4], og[5], og[6], og[7]);
        }
    }
}

#ifndef FP6_INTERLEAVED
#define FP6_INTERLEAVED 1
#endif
namespace peer {
typedef float v16f __attribute__((ext_vector_type(16)));
typedef float v32f __attribute__((ext_vector_type(32)));
typedef unsigned v6u __attribute__((ext_vector_type(6)));
typedef unsigned v16u __attribute__((ext_vector_type(16)));
typedef unsigned u32x2 __attribute__((ext_vector_type(2)));
__host__ __device__ constexpr int fp6_src_of(int k) { return FP6_INTERLEAVED ? ((k & 1) * 16 + (k >> 1)) : k; }
}
__device__ __forceinline__ void ph_peer_tables(const P& p, int li, int bid, int nb) {
    using namespace peer;
    const int tid = otid(), lane = tid & 63, wave = tid >> 6, g = lane & 31, hb = lane >> 5;
    const int first = nb >= 128 ? 64 : 0;
    if (bid < first) return;
    const int gw = (bid - first) * NWAVES + wave, NGW = (nb - first) * NWAVES;
    for (int rp = gw; rp < 16384; rp += NGW) {
        const int rr = 2 * rp + hb, tab = rr >> 14, row = rr & 16383;
        const float4* src = (const float4*)((tab ? p.peer_v : p.peer_u) + ((size_t)li * 16384 + row) * 1024 + g * 32);
        unsigned char* dst = (unsigned char*)(p.ws + (tab ? WS_PV : WS_PU)) + (tab ? (size_t)row * 768 + g * 24 : (size_t)row * 512 + g * 16); float* sc = (float*)(p.ws + (tab ? WS_SV : WS_SU));
        float4 v[8]; float mx = 0.f;
#pragma unroll
        for (int j = 0; j < 8; ++j) { v[j] = src[j]; mx = fmaxf(fmaxf(mx, fmaxf(fabsf(v[j].x), fabsf(v[j].y))), fmaxf(fabsf(v[j].z), fabsf(v[j].w))); }
        mx = fmaxf(mx, swz_xor<1>(mx)); mx = fmaxf(mx, swz_xor<2>(mx)); mx = fmaxf(mx, swz_xor<4>(mx)); mx = fmaxf(mx, swz_xor<8>(mx)); mx = fmaxf(mx, swz_xor<16>(mx));
        const float top = tab ? 7.5f : 6.0f;
        const float inv = mx > 0.f ? top / mx : 0.f;
        v16f a, b;
#pragma unroll
        for (int j = 0; j < 4; ++j) { a[4 * j] = v[j].x * inv; a[4 * j + 1] = v[j].y * inv; a[4 * j + 2] = v[j].z * inv; a[4 * j + 3] = v[j].w * inv;
                                      b[4 * j] = v[4 + j].x * inv; b[4 * j + 1] = v[4 + j].y * inv; b[4 * j + 2] = v[4 + j].z * inv; b[4 * j + 3] = v[4 + j].w * inv; }
        if (tab) { const v6u w = __builtin_amdgcn_cvt_scalef32_2xpk16_fp6_f32(a, b, 1.0f);
            *(u32x2*)(dst) = (u32x2){w[0], w[1]}; *(u32x2*)(dst + 8) = (u32x2){w[2], w[3]}; *(u32x2*)(dst + 16) = (u32x2){w[4], w[5]}; }
        else { unsigned w4[4] = {0u, 0u, 0u, 0u};
#define FP4_ENC(W, SRC, I, SEL) W = __builtin_amdgcn_cvt_scalef32_pk_fp4_f32(W, SRC[2 * (I)], SRC[2 * (I) + 1], 1.0f, SEL);
            FP4_ENC(w4[0], a, 0, 0) FP4_ENC(w4[0], a, 1, 1) FP4_ENC(w4[0], a, 2, 2) FP4_ENC(w4[0], a, 3, 3) FP4_ENC(w4[1], a, 4, 0) FP4_ENC(w4[1], a, 5, 1) FP4_ENC(w4[1], a, 6, 2) FP4_ENC(w4[1], a, 7, 3)
            FP4_ENC(w4[2], b, 0, 0) FP4_ENC(w4[2], b, 1, 1) FP4_ENC(w4[2], b, 2, 2) FP4_ENC(w4[2], b, 3, 3) FP4_ENC(w4[3], b, 4, 0) FP4_ENC(w4[3], b, 5, 1) FP4_ENC(w4[3], b, 6, 2) FP4_ENC(w4[3], b, 7, 3)
#undef FP4_ENC
            *(u32x4*)dst = (u32x4){w4[0], w4[1], w4[2], w4[3]}; }
        if (g == 0) sc[row] = mx / top;
    }
}

__device__ __forceinline__ void ph_peer_expert(const P& p, int li, int Mrows, int bid, int nb, bool dry) {
    using namespace peer;
    typedef float f32x2 __attribute__((ext_vector_type(2)));
    const bf16_t* HQ = (const bf16_t*)(p.ws + WS_HX); const int* IDX = (const int*)(p.ws + WS_IDX); const float* G = (const float*)(p.ws + WS_G);
    const float* X = (const float*)(p.ws + WS_X); const float* MOD = (const float*)(p.ws + WS_MOD);
    float* Xw = dry ? (float*)(p.ws + WS_HF) : (float*)(p.ws + WS_X); bf16_t* HXo = dry ? (bf16_t*)(p.ws + WS_ATT) : (bf16_t*)(p.ws + WS_HX); float* OUTw = dry ? (float*)(p.ws + WS_HF) : p.out;
    const unsigned char* UT = (const unsigned char*)(p.ws + WS_PU); const unsigned char* VT = (const unsigned char*)(p.ws + WS_PV);
    const float* SU = (const float*)(p.ws + WS_SU); const float* SV = (const float*)(p.ws + WS_SV);
    const auto rsU = __builtin_amdgcn_make_buffer_rsrc((void*)UT, 0, 16384 * 512, 0x00020000); const auto rsV = __builtin_amdgcn_make_buffer_rsrc((void*)VT, 0, 16384 * 768, 0x00020000);
    const int tid = otid(), lane = tid & 63, wave = __builtin_amdgcn_readfirstlane(tid >> 6), g = lane & 31, hb = lane >> 5;
    const bool b4 = (lane >> 4) & 1, b3 = (lane >> 3) & 1;
    const int eL = 2 * (2 * (int)b4 + (int)b3) + hb;
    const unsigned goff = (unsigned)g * 24u;
    for (int tok = bid * NWAVES + wave; tok < Mrows; tok += nb * NWAVES) {
        f32x2 hv2[16];
        { int g_t = g; asm volatile("" : "+v"(g_t)); const u32x4* hsrc = (const u32x4*)(HQ + (size_t)tok * D + g_t * 32);
#pragma unroll
          for (int j = 0; j < 4; ++j) { const u32x4 hw = hsrc[j]; hv2[4 * j] = (f32x2){pg8::bflo(hw.x), pg8::bfhi(hw.x)}; hv2[4 * j + 1] = (f32x2){pg8::bflo(hw.y), pg8::bfhi(hw.y)};
              hv2[4 * j + 2] = (f32x2){pg8::bflo(hw.z), pg8::bfhi(hw.z)}; hv2[4 * j + 3] = (f32x2){pg8::bflo(hw.w), pg8::bfhi(hw.w)}; } }
        f32x2 y2[16];
#pragma unroll
        for (int k = 0; k < 16; ++k) y2[k] = (f32x2){0.f, 0.f};
        const int* ip = IDX + (size_t)tok * 128; const float* gp = G + (size_t)tok * 128;
        int idx_nx = ip[lane & 7]; u32x4 ud[4]; v6u vd[4]; const unsigned goff4 = (unsigned)g * 16u;
#define PEER_ISSUE(dst, RS, idxreg) { _Pragma("unroll") for (int j_ = 0; j_ < 4; ++j_) { const int e0_ = __builtin_amdgcn_readlane(idxreg, 2 * j_), e1_ = __builtin_amdgcn_readlane(idxreg, 2 * j_ + 1); \
            const unsigned vo_ = (unsigned)(hb ? e1_ : e0_) * 768u + goff; const u32x4 q4_ = __builtin_amdgcn_raw_buffer_load_b128(RS, vo_, 0, 0); const u32x2 q2_ = __builtin_amdgcn_raw_buffer_load_b64(RS, vo_ + 16u, 0, 0); \
            dst[j_] = (v6u){q4_.x, q4_.y, q4_.z, q4_.w, q2_.x, q2_.y}; } __builtin_amdgcn_sched_barrier(0); }
#define PEER_ISSUE_U(idxreg) { _Pragma("unroll") for (int j_ = 0; j_ < 4; ++j_) { const int e0_ = __builtin_amdgcn_readlane(idxreg, 2 * j_), e1_ = __builtin_amdgcn_readlane(idxreg, 2 * j_ + 1); \
            ud[j_] = __builtin_amdgcn_raw_buffer_load_b128(rsU, (unsigned)(hb ? e1_ : e0_) * 512u + goff4, 0, 0); } __builtin_amdgcn_sched_barrier(0); }
        PEER_ISSUE_U(idx_nx); PEER_ISSUE(vd, rsV, idx_nx);
        for (int hu = 0; hu < 16; ++hu) {
            const int idxL = ip[hu * 8 + eL]; const float gL = gp[hu * 8 + eL] * SV[idxL]; const float suL = SU[idxL];
            if (hu < 15) idx_nx = ip[(hu + 1) * 8 + (lane & 7)];
            float part[4];
#pragma unroll
            for (int j = 0; j < 4; ++j) { const unsigned uw[4] = {ud[j].x, ud[j].y, ud[j].z, ud[j].w}; f32x2 a0 = (f32x2){0.f, 0.f}, a1 = (f32x2){0.f, 0.f};
#define FP4_FMA(ACC, KK, SEL) ACC += hv2[KK] * __builtin_amdgcn_cvt_scalef32_pk_f32_fp4(uw[(KK) >> 2], 1.0f, SEL);
                FP4_FMA(a0, 0, 0) FP4_FMA(a1, 1, 1) FP4_FMA(a0, 2, 2) FP4_FMA(a1, 3, 3) FP4_FMA(a0, 4, 0) FP4_FMA(a1, 5, 1) FP4_FMA(a0, 6, 2) FP4_FMA(a1, 7, 3)
                FP4_FMA(a0, 8, 0) FP4_FMA(a1, 9, 1) FP4_FMA(a0, 10, 2) FP4_FMA(a1, 11, 3) FP4_FMA(a0, 12, 0) FP4_FMA(a1, 13, 1) FP4_FMA(a0, 14, 2) FP4_FMA(a1, 15, 3)
#undef FP4_FMA
                a0 += a1; part[j] = a0.x + a0.y; __builtin_amdgcn_sched_barrier(0); }
            if (hu < 15) PEER_ISSUE_U(idx_nx);
            float s2[2];
#pragma unroll
            for (int k = 0; k < 2; ++k) { const float keep = b4 ? part[k + 2] : part[k], send = b4 ? part[k] : part[k + 2]; s2[k] = keep + swz_xor<16>(send); }
            float s1; { const float keep = b3 ? s2[1] : s2[0], send = b3 ? s2[0] : s2[1]; s1 = keep + swz_xor<8>(send); }
            s1 += swz_xor<4>(s1); s1 += swz_xor<1>(s1); s1 += swz_xor<2>(s1);
            const float wL = lru::fast_gelu(s1 * suL) * gL;
#pragma unroll
            for (int j = 0; j < 4; ++j) {
                const int src0 = ((j >> 1) & 1) * 16 + (j & 1) * 8;
                const float w0 = __uint_as_float(__builtin_amdgcn_readlane(__float_as_uint(wL), src0)), w1 = __uint_as_float(__builtin_amdgcn_readlane(__float_as_uint(wL), src0 + 32));
                const float wk = hb ? w1 : w0;
                const v32f z = __builtin_amdgcn_cvt_scalef32_pk32_f32_fp6(vd[j], 1.0f); const f32x2 wk2 = (f32x2){wk, wk};
#pragma unroll
                for (int k = 0; k < 16; ++k) y2[k] += wk2 * (f32x2){z[2 * k], z[2 * k + 1]};
                __builtin_amdgcn_sched_barrier(0); }
            if (hu < 15) PEER_ISSUE(vd, rsV, idx_nx);
        }
#undef PEER_ISSUE
#undef PEER_ISSUE_U
        float ye[16];
        { float yt[32];
#pragma unroll
          for (int k = 0; k < 32; ++k) { const float yk = (k & 1) ? y2[k >> 1].y : y2[k >> 1].x; auto rr = __builtin_amdgcn_permlane32_swap(__float_as_uint(yk), __float_as_uint(yk), false, false); yt[k] = __uint_as_float(rr[0]) + __uint_as_float(rr[1]); }
          float yo[32];
#pragma unroll
          for (int k = 0; k < 32; ++k) yo[fp6_src_of(k)] = yt[k];
          const unsigned hm = 0u - (unsigned)hb;
#pragma unroll
          for (int e = 0; e < 16; ++e) ye[e] = __uint_as_float(msel(__float_as_uint(yo[e]), __float_as_uint(yo[16 + e]), hm)); }
        int lane_e = lane; asm volatile("" : "+v"(lane_e));
        const int ridx = row_mod_idx(tok); const float* g2 = MOD + ((size_t)li * 9 + ridx) * 6144 + 5 * 1024; const int c0 = (lane_e & 31) * 32 + (lane_e >> 5) * 16;
        float xn[16]; float ss = 0.f; const float* xp = X + (size_t)tok * D + c0; float* xw = Xw + (size_t)tok * D + c0;
#pragma unroll
        for (int q = 0; q < 4; ++q) { const float4 xv = *(const float4*)(xp + 4 * q), gg = *(const float4*)(g2 + c0 + 4 * q);
            xn[4 * q] = xv.x + gg.x * ye[4 * q]; xn[4 * q + 1] = xv.y + gg.y * ye[4 * q + 1]; xn[4 * q + 2] = xv.z + gg.z * ye[4 * q + 2]; xn[4 * q + 3] = xv.w + gg.w * ye[4 * q + 3];
            *(float4*)(xw + 4 * q) = make_float4(xn[4 * q], xn[4 * q + 1], xn[4 * q + 2], xn[4 * q + 3]);
            ss += xn[4 * q] * xn[4 * q] + xn[4 * q + 1] * xn[4 * q + 1] + xn[4 * q + 2] * xn[4 * q + 2] + xn[4 * q + 3] * xn[4 * q + 3]; }
        const float rs = rsqrtf(wave_sum(ss) * (1.f / D) + EPS);
        if (li < DEPTH - 1) {
            const float* gN = p.norm1_g + (li + 1) * D; const float* mrow = MOD + ((size_t)(li + 1) * 9 + ridx) * 6144; float o[16];
#pragma unroll
            for (int q = 0; q < 4; ++q) { const float4 gg = *(const float4*)(gN + c0 + 4 * q), sh = *(const float4*)(mrow + c0 + 4 * q), sc = *(const float4*)(mrow + 1024 + c0 + 4 * q);
                o[4 * q] = xn[4 * q] * rs * gg.x * (1.f + sc.x) + sh.x; o[4 * q + 1] = xn[4 * q + 1] * rs * gg.y * (1.f + sc.y) + sh.y;
                o[4 * q + 2] = xn[4 * q + 2] * rs * gg.z * (1.f + sc.z) + sh.z; o[4 * q + 3] = xn[4 * q + 3] * rs * gg.w * (1.f + sc.w) + sh.w; }
            *(u32x4*)(HXo + (size_t)tok * D + c0) = (u32x4){pk2(o[0], o[1]), pk2(o[2], o[3]), pk2(o[4], o[5]), pk2(o[6], o[7])};
            *(u32x4*)(HXo + (size_t)tok * D + c0 + 8) = (u32x4){pk2(o[8], o[9]), pk2(o[10], o[11]), pk2(o[12], o[13]), pk2(o[14], o[15])};
        } else {
            float* op = OUTw + (size_t)tok * D + c0;
#pragma unroll
            for (int q = 0; q < 4; ++q) { const float4 gg = *(const float4*)(p.final_g + c0 + 4 * q);
                *(float4*)(op + 4 * q) = make_float4(xn[4 * q] * rs * gg.x, xn[4 * q + 1] * rs * gg.y, xn[4 * q + 2] * rs * gg.z, xn[4 * q + 3] * rs * gg.w); }
        }
    }
}
template <bool ROPEPERM>
__device__ __forceinline__ void p0_transpose_item(const float* W, int K, int N, bf16_t* WT, LAS float* scr, int item, int lane) {
    const int nblk = N / 32, kb = item / nblk, nbk = item % nblk, k0 = 64 * kb, n0 = 32 * nbk;
#pragma unroll 8
    for (int i = 0; i < 32; ++i) { const int kk = 2 * i + (lane >> 5); scr[kk * 33 + (lane & 31)] = W[(size_t)(k0 + kk) * N + n0 + (lane & 31)]; }
    LDS_WAIT(); asm volatile("" ::: "memory");
    const int c = lane & 7;
#pragma unroll
    for (int j = 0; j < 4; ++j) { const int n = (lane >> 3) + 8 * j; const int ns = ROPEPERM ? ((n & 1) * 16 + (n >> 1)) : n; const LAS float* s = scr + (8 * c) * 33 + ns;
        v4u o; o.x = pk2(s[0 * 33], s[1 * 33]); o.y = pk2(s[2 * 33], s[3 * 33]); o.z = pk2(s[4 * 33], s[5 * 33]); o.w = pk2(s[6 * 33], s[7 * 33]);
        *(GAS v4u*)(WT + (size_t)(n0 + n) * K + k0 + 8 * c) = o; }
    LDS_WAIT(); asm volatile("" ::: "memory");
}

__device__ __forceinline__ void ph_prologue(const P& p, int bid, int nb, unsigned char* lds) {
    const int tid = otid(), lane = tid & 63, wave = tid >> 6; const long gtid = (long)bid * NTHREADS + tid, gsz = (long)nb * NTHREADS;
    float2* R = (float2*)(p.ws + WS_ROPE);
    for (long i = gtid; i < 2048 * 32; i += gsz) { const int t = (int)(i >> 5), j = (int)(i & 31), a = j >> 4, f = j & 15;
        const float pos = a == 0 ? (float)(t >> 6) : (float)(t & 63); const float inv = exp2f(-(float)f * (13.287712379549449f / 16.0f)); const float ang = pos * inv;
        R[i] = make_float2(__cosf(ang), __sinf(ang)); }
    if (gtid < 4) { const int li = (int)gtid; const float* lp = p.diff_lam + li * 4 * 64; float s0 = 0, s1 = 0; for (int d = 0; d < 64; ++d) { s0 += lp[d] * lp[64 + d]; s1 += lp[128 + d] * lp[192 + d]; }
        ((float*)(p.ws + WS_LAM))[li] = expf(s0) - expf(s1) + lambda_init_of(li); }
    { bf16_t* KB = (bf16_t*)(p.ws + WS_KEYS); for (long i = gtid; i < (long)4 * 16 * 128 * 64; i += gsz) KB[i] = f2bf(p.peer_keys[i]); }
    {
        float* s = (float*)lds;
        for (int i = tid; i < 9 * 1024; i += NTHREADS) { const int r = i >> 10, k = i & 1023; const float v = r < 8 ? p.c[r * 1024 + k] : p.c_ctx[k]; s[i] = siluf_(v); }
        __syncthreads();
        float* MODP = (float*)(p.ws + WS_MODP);
        for (int item = bid; item < 8 * 4 * 12; item += nb) {
            const int ks = item / 48, li = (item / 12) & 3, jb = item % 12; const int j = jb * 512 + tid; const float* W = p.mod_w + ((size_t)li * 1024 + ks * 128) * 6144 + j; const float* sk = s + ks * 128;
            float a0 = 0, a1 = 0, a2 = 0, a3 = 0, a4 = 0, a5 = 0, a6 = 0, a7 = 0, a8 = 0;
#pragma unroll 4
            for (int k = 0; k < 128; ++k) { const float w = W[(size_t)k * 6144];
                a0 += sk[k] * w; a1 += sk[1024 + k] * w; a2 += sk[2048 + k] * w; a3 += sk[3072 + k] * w; a4 += sk[4096 + k] * w; a5 += sk[5120 + k] * w; a6 += sk[6144 + k] * w; a7 += sk[7168 + k] * w; a8 += sk[8192 + k] * w; }
            float* o = MODP + ((size_t)(ks * 4 + li) * 9) * 6144 + j;
            o[0 * 6144] = a0; o[1 * 6144] = a1; o[2 * 6144] = a2; o[3 * 6144] = a3; o[4 * 6144] = a4; o[5 * 6144] = a5; o[6 * 6144] = a6; o[7 * 6144] = a7; o[8 * 6144] = a8;
        }
        __syncthreads();
    }
    {
        LAS float* scr = (LAS float*)((LAS unsigned char*)lds + wave * 16384);
        const int gw = bid * NWAVES + wave, NGW = nb * NWAVES;
        constexpr int I_IN = (D / 64) * (DIN / 32), I_SQ = (D / 64) * (D / 32);
        constexpr int PER_L = I_IN + 4 * I_SQ, NITEMS = DEPTH * PER_L;
        for (int it = gw; it < NITEMS; it += NGW) {
            const int li = it / PER_L; int r = it % PER_L;
            if (r < I_IN) { const int nbk = r % (DIN / 32); const bool perm = nbk >= (C_Q / 32) && nbk < (C_V / 32);
                const float* W = p.w_in + (size_t)li * D * DIN; bf16_t* WT = (bf16_t*)(p.ws + WS_WIN_T) + (size_t)li * DIN * D;
                if (perm) p0_transpose_item<true>(W, D, DIN, WT, scr, r, lane); else p0_transpose_item<false>(W, D, DIN, WT, scr, r, lane);
                continue; }
            r -= I_IN; const int which = r / I_SQ; r %= I_SQ;
            const float* W = (which == 0 ? p.w_br_lru : which == 1 ? p.w_br_attn : which == 2 ? p.w_out : p.peer_wq) + (size_t)li * D * D;
            bf16_t* WT = (bf16_t*)(p.ws + (which == 0 ? WS_WBL_T : which == 1 ? WS_WBA_T : which == 2 ? WS_WOUT_T : WS_WQ_T)) + (size_t)li * D * D;
            p0_transpose_item<false>(W, D, D, WT, scr, r, lane);
        }
    }
}
__device__ __forceinline__ void ph_modfin(const P& p, int bid, int nb) {
    const long gtid = (long)bid * NTHREADS + otid(), gsz = (long)nb * NTHREADS; const float* MODP = (const float*)(p.ws + WS_MODP); float* MOD = (float*)(p.ws + WS_MOD);
    for (long i = gtid; i < 4 * 9 * 6144; i += gsz) { const int j = (int)(i % 6144), li = (int)(i / (9 * 6144)); float a = p.mod_b[li * 6144 + j];
#pragma unroll
        for (int ks = 0; ks < 8; ++ks) a += MODP[(size_t)ks * 4 * 9 * 6144 + i];
        MOD[i] = a; }
}

constexpr int NPL = 8;
constexpr int NSTEPS = 3 + DEPTH * NPL;

__device__ __forceinline__ void run_step(const P& p, int s, int bid, int nb, unsigned char* lds) {
    bf16_t* HX = (bf16_t*)(p.ws + WS_HX); bf16_t* PROJ = (bf16_t*)(p.ws + WS_PROJ); bf16_t* LA = (bf16_t*)(p.ws + WS_LA); bf16_t* ATT = (bf16_t*)(p.ws + WS_ATT);
    bf16_t* MIX = (bf16_t*)(p.ws + WS_MIX); bf16_t* PQ = (bf16_t*)(p.ws + WS_PQ); float* X = (float*)(p.ws + WS_X); const float* MOD = (const float*)(p.ws + WS_MOD);
    PG8_LAS unsigned char* glds = (PG8_LAS unsigned char*)lds;
    if (s == 0) { ph_prologue(p, bid, nb, lds);
#if PROBE_CAT == 11
        for (int r2 = 0; r2 < PROBE_N; ++r2) { __syncthreads(); ph_prologue(p, bid, nb, lds); }
#endif
        return; }
    if (s == 1) { ph_modfin(p, bid, nb); return; }
    if (s == 2) { ph_norm(p, bid, nb, p.norm1_g, 0, 0, 1, MT, HX, true); return; }
    const int li = (s - 3) / NPL, ph = (s - 3) % NPL; const bool do_ctx = li < DEPTH - 1; const int Mr = do_ctx ? MT : ML;
    const int extra = (PROBE_CAT != 0 && ph + 1 == PROBE_CAT) ? PROBE_N : 0;
    for (int rep = 0; rep <= extra; ++rep) { const bool dry = rep < extra;
    float* Xo = dry ? (float*)(p.ws + WS_HF) : X;
    switch (ph) {
    case 0: {
        pg8::Gemm g{HX, (const bf16_t*)(p.ws + WS_WIN_T) + (size_t)li * DIN * D, MT, DIN, D}; pg8::StaticOrder S; S.init(MT, DIN, nb, bid);
        pg8::EpiIn E{PROJ, (const float*)(p.ws + WS_ROPE)};
        pg8::gemm_phase<pg8::EpiIn, pg8::StaticOrder, true, true>(glds, g, S, E);
    } break;
    case 1: ph_lru(p, li, bid, nb, lds);
        ph_peer_tables(p, li, bid, nb);
#if PROBE_CAT == 10
        for (int r2 = 0; r2 < PROBE_N; ++r2) ph_lru(p, li, bid, nb, lds);
#endif
        ph_attn(p, li, do_ctx, bid, nb, lds);
#if PROBE_CAT == 9
        for (int r2 = 0; r2 < PROBE_N; ++r2) ph_attn(p, li, do_ctx, bid, nb, lds);
#endif
        break;
    case 2: {
        { pg8::Gemm g{LA, (const bf16_t*)(p.ws + WS_WBL_T) + (size_t)li * D * D, Mr, D, D}; pg8::StaticOrder S; S.init(Mr, D, nb, bid);
          pg8::EpiBr<false> E{PROJ, MIX, C_GA}; pg8::gemm_phase<pg8::EpiBr<false>, pg8::StaticOrder, true, true>(glds, g, S, E); }
        { pg8::Gemm g{ATT, (const bf16_t*)(p.ws + WS_WBA_T) + (size_t)li * D * D, Mr, D, D}; pg8::StaticOrder S; S.init(Mr, D, nb, bid);
          pg8::EpiBr<true> E{PROJ, MIX, C_GB}; pg8::gemm_phase<pg8::EpiBr<true>, pg8::StaticOrder, true, true>(glds, g, S, E); }
    } break;
    case 3: {
        pg8::Gemm g{MIX, (const bf16_t*)(p.ws + WS_WOUT_T) + (size_t)li * D * D, Mr, D, D}; pg8::StaticOrder S; S.init(Mr, D, nb, bid);
        pg8::EpiOut E{li == 0 ? p.x : X, li == 0 ? p.ctx - (size_t)ML * D : X, Xo, MOD + (size_t)li * 9 * 6144 + 2 * 1024};   pg8::gemm_phase<pg8::EpiOut, pg8::StaticOrder, true, true>(glds, g, S, E);
    } break;
    case 4: ph_norm(p, bid, nb, p.norm2_g + li * D, li, 3, 4, Mr, HX, false); break;
    case 5: {
        pg8::Gemm g{HX, (const bf16_t*)(p.ws + WS_WQ_T) + (size_t)li * D * D, Mr, D, D}; pg8::StaticOrder S; S.init(Mr, D, nb, bid);
        pg8::EpiPlain E{PQ}; pg8::gemm_phase<pg8::EpiPlain, pg8::StaticOrder, true, true>(glds, g, S, E);
    } break;
    case 6: ph_peer_score(p, li, Mr, bid, nb); break;
    case 7: ph_peer_expert(p, li, Mr, bid, nb, dry); break;
    }
    }
}

constexpr int RING_BYTES = 155648, LDSCTL_OFF = RING_BYTES, MISC_OFF = LDSCTL_OFF + 320, LDS_BYTES = RING_BYTES + 1024;
constexpr int CW_BAR = 4096;
#ifndef N_LAUNCH_MODE
#define N_LAUNCH_MODE 1
#endif

__global__ void __launch_bounds__(NTHREADS, 2) mega(P p) {
    extern __shared__ __attribute__((aligned(16))) unsigned char lds[];
    const int tid = threadIdx.x;
    for (int u = tid; u < (LDS_BYTES - LDSCTL_OFF) / 4; u += NTHREADS) ((LAS unsigned*)((LAS unsigned char*)lds + LDSCTL_OFF))[u] = 0u;
    __syncthreads();
    volatile LAS unsigned* MISC = (volatile LAS unsigned*)((LAS unsigned char*)lds + MISC_OFF);
    XcdBarrier bar = xcd_barrier_post((unsigned*)(p.ws + WS_CTL) + CW_BAR, MISC + 8);
    const int bid = blockIdx.x, nb = gridDim.x;
    for (int s = p.lo; s < p.hi; ++s) {
        P q = p; int bido = bid, nbo = nb;
        asm volatile("" : "+s"(bido), "+s"(nbo));
        run_step(q, s, bido, nbo, lds);
        if (s + 1 < p.hi) xcd_barrier(bar);
#if PROBE_CAT == 12
        for (int r2 = 0; r2 < PROBE_N; ++r2) xcd_barrier(bar);
#endif
    }
}

extern "C" void kernel_launch(void* const* d_in, const int* in_sizes, int n_in, void* d_out, int out_size, void* d_ws, size_t ws_size, hipStream_t stream) {
    static int grid = 0;
    if (grid == 0) {
        if (n_in != 24 || ws_size < WS_END) { fprintf(stderr, "kernel_launch: n_in %d ws %zu need %zu\n", n_in, ws_size, (size_t)WS_END); grid = -1; return; }
        int dev = 0, cus = 0, per_cu = 0;
        if (hipGetDevice(&dev) != hipSuccess || hipDeviceGetAttribute(&cus, hipDeviceAttributeMultiprocessorCount, dev) != hipSuccess) { grid = -1; return; }
        if (hipFuncSetAttribute((const void*)mega, hipFuncAttributeMaxDynamicSharedMemorySize, LDS_BYTES) != hipSuccess) { fprintf(stderr, "kernel_launch: hipFuncSetAttribute failed\n"); grid = -1; return; }
        if (hipOccupancyMaxActiveBlocksPerMultiprocessor(&per_cu, (const void*)mega, NTHREADS, LDS_BYTES) != hipSuccess || per_cu < 1) { fprintf(stderr, "kernel_launch: occupancy query says %d\n", per_cu); per_cu = 1; }
        (void)hipGetLastError();
        grid = cus > 256 ? 256 : cus;
    }
    if (grid < 0) return;
    (void)hipMemsetAsync((char*)d_ws + WS_CTL, 0, CTL_ZERO_BYTES, stream);
    P p{};
    const float** pp = (const float**)&p;
    for (int i = 0; i < 24; ++i) pp[i] = (const float*)d_in[i];
    p.out = (float*)d_out; p.ws = (unsigned char*)d_ws;
#if N_LAUNCH_MODE == 1
    p.lo = 0; p.hi = NSTEPS; hipLaunchKernelGGL(mega, dim3(grid), dim3(NTHREADS), LDS_BYTES, stream, p);
#else
    for (int s = 0; s < NSTEPS; ++s) { p.lo = s; p.hi = s + 1; hipLaunchKernelGGL(mega, dim3(grid), dim3(NTHREADS), LDS_BYTES, stream, p); }
#endif
}
```

```cpp
#include <hip/hip_runtime.h>
#include <cstdio>
#include <cstdint>

#ifndef PROBE_CAT
#define PROBE_CAT 0
#endif
#ifndef PROBE_N
#define PROBE_N 1
#endif
#define PEER_DBG_SIMPLE_REDUCE 0
#define PEER_DBG_NAIVE_EPI 0
#ifndef OPT_LRU
#define OPT_LRU 1
#endif
constexpr int D = 1024, NBATCH = 8, SEQ = 2048, CTXL = 256, DEPTH = 4;
constexpr int ML = NBATCH * SEQ, MC = NBATCH * CTXL, MT = ML + MC;
constexpr int DIN = 7168;
constexpr int C_U = 0, C_GL = 1024, C_Q = 2048, C_K = 3072, C_V = 4096, C_GA = 5120, C_GB = 6144;
constexpr float EPS = 1e-6f;
constexpr int NTHREADS = 512, NWAVES = 8;

typedef unsigned short bf16_t;
__device__ __forceinline__ float bf2f(bf16_t v) { return __uint_as_float(((unsigned)v) << 16); }
__device__ __forceinline__ unsigned pk2(float lo, float hi) { unsigned r; asm("v_cvt_pk_bf16_f32 %0, %1, %2" : "=v"(r) : "v"(lo), "v"(hi)); return r; }
__device__ __forceinline__ bf16_t f2bf(float f) { return (bf16_t)(pk2(f, f) & 0xffffu); }
__device__ __forceinline__ float sigmoidf_(float x) { return 1.f / (1.f + __expf(-x)); }
__device__ __forceinline__ float gelu_tanh(float x) { const float u = 0.7978845608028654f * (x + 0.044715f * x * x * x); return 0.5f * x * (1.f + tanhf(u)); }
__device__ __forceinline__ float siluf_(float x) { return x / (1.f + expf(-x)); }

constexpr size_t MiB = 1u << 20;
constexpr size_t WS_CTL = 0, CTL_ZERO_BYTES = 1 * MiB;
constexpr size_t WS_X = 1 * MiB;
constexpr size_t WS_HX = WS_X + (size_t)MT * D * 4;
constexpr size_t WS_PROJ = WS_HX + (size_t)MT * D * 2;
constexpr size_t WS_LA = WS_PROJ + (size_t)MT * DIN * 2;
constexpr size_t WS_ATT = WS_LA + (size_t)MT * D * 2;
constexpr size_t WS_MIX = WS_ATT + (size_t)MT * D * 2;
constexpr size_t WS_IDX = WS_MIX + (size_t)MT * D * 2;
constexpr size_t WS_G = WS_IDX + (size_t)MT * 128 * 4;
constexpr size_t WS_MOD = WS_G + (size_t)MT * 128 * 4;
constexpr size_t WS_ROPE = WS_MOD + (size_t)4 * 9 * 6144 * 4;
constexpr size_t WS_LAM = WS_ROPE + (size_t)2048 * 32 * 2 * 4;
constexpr size_t WS_MODP = WS_LAM + 256;
constexpr size_t WS_WIN_T = WS_MODP + (size_t)8 * 4 * 9 * 6144 * 4;
constexpr size_t WS_WBL_T = WS_WIN_T + (size_t)4 * DIN * D * 2;
constexpr size_t WS_WBA_T = WS_WBL_T + (size_t)4 * D * D * 2;
constexpr size_t WS_WOUT_T = WS_WBA_T + (size_t)4 * D * D * 2;
constexpr size_t WS_WQ_T = WS_WOUT_T + (size_t)4 * D * D * 2;
constexpr size_t WS_STASH = WS_WQ_T + (size_t)4 * D * D * 2;
constexpr size_t WS_KEYS = WS_STASH + (size_t)256 * 8 * 64 * 64 * 4;
constexpr size_t WS_PU = WS_KEYS + (size_t)4 * 16 * 128 * 64 * 2;
constexpr size_t WS_PV = WS_PU + (size_t)16384 * 1024;
constexpr size_t WS_SU = WS_PV + (size_t)16384 * 1024;
constexpr size_t WS_SV = WS_SU + (size_t)16384 * 4;
constexpr size_t WS_HF = WS_SV + (size_t)16384 * 4;
constexpr size_t WS_UC = WS_HF;
constexpr size_t WS_HD = WS_UC + (size_t)MT * D * 4;
#if OPT_LRU
constexpr size_t WS_END = WS_HF + (size_t)MT * D * 4;
#else
constexpr size_t WS_END = WS_HD + (size_t)2 * MT * D * 4;
#endif
#define WS_PQ WS_LA

struct P {
    const float *x, *c, *ctx, *c_ctx, *mod_w, *mod_b, *norm1_g, *norm2_g, *w_in, *conv_w, *conv_b, *lru_w, *lru_b, *lru_lam, *diff_lam, *subln_g,
        *w_br_lru, *w_br_attn, *w_out, *peer_wq, *peer_keys, *peer_u, *peer_v, *final_g;
    float* out; unsigned char* ws; int lo, hi;
};

__device__ __forceinline__ int otid() { int t = threadIdx.x; asm volatile("" : "+v"(t)); return t; }
__device__ __forceinline__ int row_mod_idx(int row) { return row < ML ? (row >> 11) : 8; }
__device__ __forceinline__ float lambda_init_of(int li) { return 0.8f - 0.6f * expf(-0.3f * (float)li); }

namespace pg8 {
#define PG8_LAS __attribute__((address_space(3)))
typedef unsigned short bf16_t;
typedef short bf16x8 __attribute__((ext_vector_type(8)));
typedef float f32x4 __attribute__((ext_vector_type(4)));
typedef unsigned u32x4 __attribute__((ext_vector_type(4)));
constexpr int BM = 256, BK = 64, HALF = 128, HTB = HALF * BK * 2  , STAGE_BYTES = 8 * HTB, NXCD = 8, WGM = 8;

__host__ __device__ __forceinline__ int lds_byte(int r, int c) { const int st = (r >> 4) * 2 + (c >> 5), rr = r & 15, cc = c & 31, ob = rr * 64 + cc * 2; return st * 1024 + (ob ^ (((ob >> 9) & 1) << 5)); }
__host__ __device__ __forceinline__ void stage_rc(int b, int& R, int& C) { const int st = b / 1024, sb = b % 1024, swz = sb ^ (((sb >> 9) & 1) << 5); R = (st >> 1) * 16 + swz / 64; C = (st & 1) * 32 + (swz % 64) / 2; }
__host__ __device__ __forceinline__ int perm32(int rho) { const int n = rho >> 4, i = rho & 15; return 8 * (i >> 2) + 4 * n + (i & 3); }

struct Unit { int pm, pn; };
struct Gemm { const bf16_t* A; const bf16_t* Bt; int M, N, K; };

struct StaticOrder {
    int nM, nN, nwg, G, c;
    __host__ __device__ void init(int M, int N, int G_, int c_) { nM = M / BM; nN = N / BM; nwg = nM * nN; G = G_; c = c_; }
    __host__ __device__ bool next(int i, Unit& u) const {
        const long L = (long)i * G + c; if (L >= nwg) return false;
        int wgid = (int)L; { const int q = nwg / NXCD, r = nwg % NXCD, xcd = wgid % NXCD, off = wgid / NXCD; wgid = (xcd < r ? xcd * (q + 1) : r * (q + 1) + (xcd - r) * q) + off; }
        const int nig = WGM * nN, gid = wgid / nig, fm = gid * WGM, gsz = (nM - fm) < WGM ? (nM - fm) : WGM;
        u.pm = fm + ((wgid % nig) % gsz); u.pn = (wgid % nig) / gsz; return true;
    }
    __device__ __forceinline__ void a_ready(const Unit&) const {}
    __device__ __forceinline__ void done(const Unit&) const {}
};

__device__ __forceinline__ unsigned cvt_pk_bf16(float lo, float hi) { unsigned r; asm volatile("v_cvt_pk_bf16_f32 %0, %1, %2" : "=v"(r) : "v"(lo), "v"(hi)); return r; }
typedef float f32x2 __attribute__((ext_vector_type(2)));
__device__ __forceinline__ f32x2 gelu_pk(f32x2 v) {
    const f32x2 av = __builtin_elementwise_abs(v), d = av * 0.2316418882f + 1.0f;
    f32x2 t; t.x = __builtin_amdgcn_rcpf(d.x); t.y = __builtin_amdgcn_rcpf(d.y);
    f32x2 q = t * 0.5307027145f + (-0.7265760135f); q = q * t + 0.7107068705f; q = q * t + (-0.142248368f); q = q * t + 0.127414796f; q = q * t;
    const f32x2 s = (v * v) * (-0.72134752044f);
    f32x2 e; e.x = __builtin_amdgcn_exp2f(s.x); e.y = __builtin_amdgcn_exp2f(s.y);
    const f32x2 m = v * (q * e), r = v - m;
    f32x2 o; o.x = v.x < 0.f ? m.x : r.x; o.y = v.y < 0.f ? m.y : r.y; return o;
}

template <int ACT  > struct EpiBf16 {
    static constexpr bool PERM = true, AFTER_DRAIN = false; static_assert(ACT == 0 || ACT == 1, "EpiBf16: ACT is 0 (none) or 1 (gelu_pk)");
    bf16_t* O; int ldc; const float* bias; int split_cols; size_t split_stride; float scale0;
    __device__ __forceinline__ void operator()(const f32x4 (&acc)[2][2][4][2], const Unit& u, int wr, int wc, int fr, int fq) const {
        const int row0 = u.pm * BM + wr * 64 + fr; int colt = u.pn * BM; bf16_t* base = O;
        float sc = 1.f; if (split_cols) { const int t = colt / split_cols; base += (size_t)t * split_stride; colt -= t * split_cols; if (t == 0) sc = scale0; }
        const int col0 = colt + wc * 32 + 8 * fq, bcol0 = u.pn * BM + wc * 32 + 8 * fq;
        f32x4 bv[2][2];
#pragma unroll
        for (int bj = 0; bj < 2; ++bj)
#pragma unroll
            for (int n = 0; n < 2; ++n) bv[bj][n] = bias ? *(const f32x4*)(bias + bcol0 + bj * HALF + 4 * n) : (f32x4){0.f, 0.f, 0.f, 0.f};
#pragma unroll
        for (int ai = 0; ai < 2; ++ai)
#pragma unroll
            for (int m = 0; m < 4; ++m) { bf16_t* rowp = base + (size_t)(row0 + ai * HALF + m * 16) * ldc + col0;
#pragma unroll
                for (int bj = 0; bj < 2; ++bj) { f32x4 v0 = acc[ai][bj][m][0] + bv[bj][0], v1 = acc[ai][bj][m][1] + bv[bj][1];
                    if (ACT == 1) { f32x2 a = gelu_pk((f32x2){v0[0], v0[1]}), b = gelu_pk((f32x2){v0[2], v0[3]}), c = gelu_pk((f32x2){v1[0], v1[1]}), d = gelu_pk((f32x2){v1[2], v1[3]});
                        v0 = (f32x4){a.x, a.y, b.x, b.y}; v1 = (f32x4){c.x, c.y, d.x, d.y}; }
                    v0 = v0 * sc; v1 = v1 * sc; u32x4 w; w.x = cvt_pk_bf16(v0[0], v0[1]); w.y = cvt_pk_bf16(v0[2], v0[3]); w.z = cvt_pk_bf16(v1[0], v1[1]); w.w = cvt_pk_bf16(v1[2], v1[3]);
                    *(u32x4*)(rowp + bj * HALF) = w; } }
    }
};
__device__ __forceinline__ float bflo(unsigned w) { return __uint_as_float(w << 16); }
__device__ __forceinline__ float bfhi(unsigned w) { return __uint_as_float(w & 0xffff0000u); }
__device__ __forceinline__ float sigm(float x) { return 1.f / (1.f + __expf(-x)); }

struct EpiIn {
    static constexpr bool PERM = true, AFTER_DRAIN = false;
    bf16_t* O; const float* rope;
    __device__ __forceinline__ void operator()(const f32x4 (&acc)[2][2][4][2], const Unit& u, int wr, int wc, int fr, int fq) const {
        const int row0 = u.pm * BM + wr * 64 + fr, col0 = u.pn * BM + wc * 32 + 8 * fq;
        const bool dorope = (u.pn >= 8) && (u.pn < 16) && (u.pm < 64);
        const int i0 = ((wc & 1) << 4) + 4 * fq;
#pragma unroll
        for (int ai = 0; ai < 2; ++ai)
#pragma unroll
            for (int m = 0; m < 4; ++m) { const int row = row0 + ai * HALF + m * 16; bf16_t* rowp = O + (size_t)row * DIN + col0;
                f32x4 r0 = {1.f, 0.f, 1.f, 0.f}, r1 = {1.f, 0.f, 1.f, 0.f};
                if (dorope) { const f32x4* rp = (const f32x4*)(rope + ((size_t)(row & 2047) * 32 + i0) * 2); r0 = rp[0]; r1 = rp[1]; }
#pragma unroll
                for (int bj = 0; bj < 2; ++bj) { f32x4 v0 = acc[ai][bj][m][0], v1 = acc[ai][bj][m][1];
                    if (dorope) { f32x4 a, b;
                        a[0] = v0[0] * r0[0] - v0[1] * r0[1]; a[1] = v0[1] * r0[0] + v0[0] * r0[1]; a[2] = v0[2] * r0[2] - v0[3] * r0[3]; a[3] = v0[3] * r0[2] + v0[2] * r0[3];
                        b[0] = v1[0] * r1[0] - v1[1] * r1[1]; b[1] = v1[1] * r1[0] + v1[0] * r1[1]; b[2] = v1[2] * r1[2] - v1[3] * r1[3]; b[3] = v1[3] * r1[2] + v1[2] * r1[3];
                        v0 = a; v1 = b; }
                    u32x4 w; w.x = cvt_pk_bf16(v0[0], v0[1]); w.y = cvt_pk_bf16(v0[2], v0[3]); w.z = cvt_pk_bf16(v1[0], v1[1]); w.w = cvt_pk_bf16(v1[2], v1[3]);
                    *(u32x4*)(rowp + bj * HALF) = w; } }
    }
};
struct EpiPlain {
    static constexpr bool PERM = true, AFTER_DRAIN = false;
    bf16_t* O;
    __device__ __forceinline__ void operator()(const f32x4 (&acc)[2][2][4][2], const Unit& u, int wr, int wc, int fr, int fq) const {
        const int row0 = u.pm * BM + wr * 64 + fr, col0 = u.pn * BM + wc * 32 + 8 * fq;
#pragma unroll
        for (int ai = 0; ai < 2; ++ai)
#pragma unroll
            for (int m = 0; m < 4; ++m) { bf16_t* rowp = O + (size_t)(row0 + ai * HALF + m * 16) * D + col0;
#pragma unroll
                for (int bj = 0; bj < 2; ++bj) { const f32x4 v0 = acc[ai][bj][m][0], v1 = acc[ai][bj][m][1];
                    u32x4 w; w.x = cvt_pk_bf16(v0[0], v0[1]); w.y = cvt_pk_bf16(v0[2], v0[3]); w.z = cvt_pk_bf16(v1[0], v1[1]); w.w = cvt_pk_bf16(v1[2], v1[3]);
                    *(u32x4*)(rowp + bj * HALF) = w; } }
    }
};
template <bool ADD> struct EpiBr {
    static constexpr bool PERM = true, AFTER_DRAIN = false;
    const bf16_t* PROJ; bf16_t* MIX; int gcol;
    __device__ __forceinline__ void operator()(const f32x4 (&acc)[2][2][4][2], const Unit& u, int wr, int wc, int fr, int fq) const {
        const int row0 = u.pm * BM + wr * 64 + fr, col0 = u.pn * BM + wc * 32 + 8 * fq;
#pragma unroll
        for (int ai = 0; ai < 2; ++ai)
#pragma unroll
            for (int m = 0; m < 4; ++m) { const int row = row0 + ai * HALF + m * 16; bf16_t* rowp = MIX + (size_t)row * D + col0; const bf16_t* gp = PROJ + (size_t)row * DIN + gcol + col0;
#pragma unroll
                for (int bj = 0; bj < 2; ++bj) { const f32x4 v0 = acc[ai][bj][m][0], v1 = acc[ai][bj][m][1]; const u32x4 g = *(const u32x4*)(gp + bj * HALF);
                    float o[8] = {sigm(bflo(g.x)) * v0[0], sigm(bfhi(g.x)) * v0[1], sigm(bflo(g.y)) * v0[2], sigm(bfhi(g.y)) * v0[3], sigm(bflo(g.z)) * v1[0], sigm(bfhi(g.z)) * v1[1], sigm(bflo(g.w)) * v1[2], sigm(bfhi(g.w)) * v1[3]};
                    if (ADD) { const u32x4 q = *(const u32x4*)(rowp + bj * HALF); o[0] += bflo(q.x); o[1] += bfhi(q.x); o[2] += bflo(q.y); o[3] += bfhi(q.y); o[4] += bflo(q.z); o[5] += bfhi(q.z); o[6] += bflo(q.w); o[7] += bfhi(q.w); }
                    u32x4 w; w.x = cvt_pk_bf16(o[0], o[1]); w.y = cvt_pk_bf16(o[2], o[3]); w.z = cvt_pk_bf16(o[4], o[5]); w.w = cvt_pk_bf16(o[6], o[7]);
                    *(u32x4*)(rowp + bj * HALF) = w; } }
    }
};
struct EpiOut {
    static constexpr bool PERM = true, AFTER_DRAIN = false;
    const float* Xlat; const float* Xctx; float* Xo; const float* MODL;
    __device__ __forceinline__ void operator()(const f32x4 (&acc)[2][2][4][2], const Unit& u, int wr, int wc, int fr, int fq) const {
        const int row0 = u.pm * BM + wr * 64 + fr, col0 = u.pn * BM + wc * 32 + 8 * fq;
        const float* g1 = MODL + (size_t)(u.pm < 64 ? (u.pm >> 3) : 8) * 6144 + col0;
        f32x4 gv[2][2];
#pragma unroll
        for (int bj = 0; bj < 2; ++bj) { gv[bj][0] = *(const f32x4*)(g1 + bj * HALF); gv[bj][1] = *(const f32x4*)(g1 + bj * HALF + 4); }
#pragma unroll
        for (int ai = 0; ai < 2; ++ai)
#pragma unroll
            for (int m = 0; m < 4; ++m) { const size_t ro = (size_t)(row0 + ai * HALF + m * 16) * D + col0; const float* rowp = (u.pm < 64 ? Xlat : Xctx) + ro; float* rowo = Xo + ro;
#pragma unroll
                for (int bj = 0; bj < 2; ++bj) { const f32x4* xp = (const f32x4*)(rowp + bj * HALF); f32x4* xo = (f32x4*)(rowo + bj * HALF); f32x4 x0 = xp[0], x1 = xp[1];
                    x0 += gv[bj][0] * acc[ai][bj][m][0]; x1 += gv[bj][1] * acc[ai][bj][m][1]; xo[0] = x0; xo[1] = x1; } }
    }
};
template <class Epi, class Sched, bool ALIGN_EPI = false, bool SP2 = false>
__device__ __forceinline__ void gemm_phase(PG8_LAS unsigned char* lds, const Gemm g, const Sched& S, const Epi& E) {
    const int tid = otid(), wid = __builtin_amdgcn_readfirstlane(tid >> 6), lane = tid & 63, wr = wid >> 2, wc = wid & 3, fr = lane & 15, fq = lane >> 4;
    const int K = g.K, nt = K / BK;
    unsigned voffA[2], voffB[2];
#pragma unroll
    for (int i = 0; i < 2; ++i) { int R, C; stage_rc(tid * 16 + i * 8192, R, C); const int Rb = Epi::PERM ? ((R & ~31) + perm32(R & 31)) : R;
        voffA[i] = (unsigned)(R * K + C) * 2u; voffB[i] = (unsigned)(Rb * K + C) * 2u; }
    const size_t kstep = (size_t)(BK * 2);
    const size_t hstep = (size_t)HALF * K * 2;
    const size_t tstep = 2 * hstep;
    const unsigned ldsw = (unsigned)wid * 1024u;
    const int aoff = lds_byte(wr * 64 + fr, fq * 8), boff = lds_byte(wc * 32 + fr, fq * 8);
#define PG8_SA(b, h) (((b) * 2 + (h)) * HTB)
#define PG8_SB(b, h) ((4 + (b) * 2 + (h)) * HTB)
#define PG8_STAGE(bufoff, gbase, voff) do { _Pragma("unroll") for (int _i = 0; _i < 2; ++_i) \
        __builtin_amdgcn_global_load_lds((const unsigned*)((const char*)(gbase) + (voff)[_i]), (PG8_LAS unsigned*)(lds + (bufoff) + ldsw + _i * 8192), 16, 0, 0); } while (0)
#define PG8_LDA(dst, b, h) do { _Pragma("unroll") for (int m = 0; m < 4; ++m) _Pragma("unroll") for (int k = 0; k < 2; ++k) dst[m][k] = *(const PG8_LAS bf16x8*)(lds + PG8_SA(b, h) + aoff + m * 2048 + k * 1024); } while (0)
#define PG8_LDB(dst, b, h) do { _Pragma("unroll") for (int n = 0; n < 2; ++n) _Pragma("unroll") for (int k = 0; k < 2; ++k) dst[n][k] = *(const PG8_LAS bf16x8*)(lds + PG8_SB(b, h) + boff + n * 2048 + k * 1024); } while (0)
#define PG8_MMA(ai, bj, At, Bt) do { __builtin_amdgcn_s_setprio(1); _Pragma("unroll") for (int m = 0; m < 4; ++m) _Pragma("unroll") for (int n = 0; n < 2; ++n) _Pragma("unroll") for (int k = 0; k < 2; ++k) \
        acc[ai][bj][m][n] = __builtin_amdgcn_mfma_f32_16x16x32_bf16(Bt[n][k], At[m][k], acc[ai][bj][m][n], 0, 0, 0); __builtin_amdgcn_s_setprio(0); } while (0)
#define PG8_WAIT_V(n) asm volatile("s_waitcnt vmcnt(" #n ")" ::: "memory")
#define PG8_WAIT_L(n) asm volatile("s_waitcnt lgkmcnt(" #n ")" ::: "memory")
#define PG8_BAR __builtin_amdgcn_s_barrier()
#define PG8_SCHED __builtin_amdgcn_sched_barrier(0)
    Unit cur, nxt; int ui = 0;
    if (!S.next(0, cur)) return;
    f32x4 acc[2][2][4][2];
#pragma unroll
    for (int a = 0; a < 2; ++a)
#pragma unroll
        for (int b = 0; b < 2; ++b)
#pragma unroll
            for (int m = 0; m < 4; ++m)
#pragma unroll
                for (int n = 0; n < 2; ++n) acc[a][b][m][n] = (f32x4){0.f, 0.f, 0.f, 0.f};
    bf16x8 At[4][2], B0[2][2], B1[2][2];
    const char* cA = (const char*)g.A + (size_t)cur.pm * tstep; const char* cB = (const char*)g.Bt + (size_t)cur.pn * tstep;
    S.a_ready(cur);
    if constexpr (SP2) {
        PG8_STAGE(PG8_SB(0, 0), cB, voffB); PG8_STAGE(PG8_SB(0, 1), cB + hstep, voffB); PG8_STAGE(PG8_SA(0, 0), cA, voffA); PG8_STAGE(PG8_SA(0, 1), cA + hstep, voffA);
        if (wr == 1) PG8_BAR;
        PG8_WAIT_V(2); PG8_BAR;
        PG8_STAGE(PG8_SB(1, 0), cB + kstep, voffB); PG8_STAGE(PG8_SA(1, 0), cA + kstep, voffA); PG8_STAGE(PG8_SB(1, 1), cB + hstep + kstep, voffB);
        PG8_WAIT_V(6); PG8_BAR;
    } else {
        PG8_STAGE(PG8_SB(0, 0), cB, voffB); PG8_STAGE(PG8_SA(0, 0), cA, voffA); PG8_STAGE(PG8_SB(0, 1), cB + hstep, voffB); PG8_STAGE(PG8_SA(0, 1), cA + hstep, voffA);
        if (wr == 1) PG8_BAR;
        PG8_WAIT_V(4); PG8_BAR;
        PG8_STAGE(PG8_SB(1, 0), cB + kstep, voffB); PG8_STAGE(PG8_SA(1, 0), cA + kstep, voffA); PG8_STAGE(PG8_SB(1, 1), cB + hstep + kstep, voffB);
        PG8_WAIT_V(6); PG8_BAR;
    }
    for (;;) {
        const bool has_next = S.next(ui + 1, nxt);
        const char* nA = has_next ? (const char*)g.A + (size_t)nxt.pm * tstep : cA; const char* nB = has_next ? (const char*)g.Bt + (size_t)nxt.pn * tstep : cB;
        for (int t = 0; t < nt; t += 2) {
            const bool last = (t == nt - 2);
            const char* a1 = cA + (size_t)(t + 1) * kstep;
            const char* a2 = last ? nA : cA + (size_t)(t + 2) * kstep; const char* b2 = last ? nB : cB + (size_t)(t + 2) * kstep;
            const char* a3 = a2 + kstep; const char* b3 = b2 + kstep;
            if (last && has_next) S.a_ready(nxt);
            if constexpr (SP2) {
            PG8_LDB(B0, 0, 0); PG8_LDB(B1, 0, 1); PG8_SCHED; PG8_LDA(At, 0, 0); PG8_STAGE(PG8_SA(1, 1), a1 + hstep, voffA);
            PG8_WAIT_V(8); PG8_WAIT_L(0); PG8_BAR; PG8_MMA(0, 0, At, B0); PG8_MMA(0, 1, At, B1); PG8_BAR; PG8_SCHED;
            PG8_LDA(At, 0, 1); PG8_STAGE(PG8_SB(0, 0), b2, voffB); PG8_STAGE(PG8_SB(0, 1), b2 + hstep, voffB); PG8_STAGE(PG8_SA(0, 0), a2, voffA);
            PG8_WAIT_V(8); PG8_WAIT_L(0); PG8_BAR; PG8_MMA(1, 0, At, B0); PG8_MMA(1, 1, At, B1); PG8_BAR; PG8_SCHED;
            PG8_LDB(B0, 1, 0); PG8_LDB(B1, 1, 1); PG8_SCHED; PG8_LDA(At, 1, 0); PG8_STAGE(PG8_SA(0, 1), a2 + hstep, voffA);
            PG8_WAIT_V(8); PG8_WAIT_L(0); PG8_BAR; PG8_MMA(0, 0, At, B0); PG8_MMA(0, 1, At, B1); PG8_BAR; PG8_SCHED;
            PG8_LDA(At, 1, 1); PG8_STAGE(PG8_SB(1, 0), b3, voffB); PG8_STAGE(PG8_SB(1, 1), b3 + hstep, voffB); PG8_STAGE(PG8_SA(1, 0), a3, voffA);
            PG8_WAIT_V(8); PG8_WAIT_L(0); PG8_BAR; PG8_MMA(1, 0, At, B0); PG8_MMA(1, 1, At, B1); PG8_BAR; PG8_SCHED;
            } else {
            PG8_LDB(B0, 0, 0); PG8_SCHED; PG8_LDA(At, 0, 0); PG8_STAGE(PG8_SA(1, 1), a1 + hstep, voffA);
            PG8_WAIT_L(8); PG8_BAR; PG8_WAIT_L(0); PG8_MMA(0, 0, At, B0); PG8_BAR; PG8_SCHED;
            PG8_LDB(B1, 0, 1); PG8_STAGE(PG8_SB(0, 0), b2, voffB);
            PG8_BAR; PG8_WAIT_L(0); PG8_MMA(0, 1, At, B1); PG8_BAR;
            PG8_LDA(At, 0, 1); PG8_STAGE(PG8_SA(0, 0), a2, voffA);
            PG8_BAR; PG8_WAIT_L(0); PG8_MMA(1, 0, At, B0); PG8_BAR; PG8_SCHED;
            PG8_STAGE(PG8_SB(0, 1), b2 + hstep, voffB);
            PG8_WAIT_V(6); PG8_BAR; PG8_MMA(1, 1, At, B1); PG8_BAR;
            PG8_LDB(B0, 1, 0); PG8_SCHED; PG8_LDA(At, 1, 0); PG8_STAGE(PG8_SA(0, 1), a2 + hstep, voffA);
            PG8_WAIT_L(8); PG8_BAR; PG8_WAIT_L(0); PG8_MMA(0, 0, At, B0); PG8_BAR; PG8_SCHED;
            PG8_LDB(B1, 1, 1); PG8_STAGE(PG8_SB(1, 0), b3, voffB);
            PG8_BAR; PG8_WAIT_L(0); PG8_MMA(0, 1, At, B1); PG8_BAR;
            PG8_LDA(At, 1, 1); PG8_STAGE(PG8_SA(1, 0), a3, voffA);
            PG8_BAR; PG8_WAIT_L(0); PG8_MMA(1, 0, At, B0); PG8_BAR; PG8_SCHED;
            PG8_STAGE(PG8_SB(1, 1), b3 + hstep, voffB);
            PG8_WAIT_V(6); PG8_BAR; PG8_MMA(1, 1, At, B1); PG8_BAR;
            }
        }
        if constexpr (ALIGN_EPI) { if (wr == 0) PG8_BAR; }
        if constexpr (!Epi::AFTER_DRAIN) { E(acc, cur, wr, wc, fr, fq); S.done(cur); }
        if (!has_next) break;
#pragma unroll
        for (int a = 0; a < 2; ++a)
#pragma unroll
            for (int b = 0; b < 2; ++b)
#pragma unroll
                for (int m = 0; m < 4; ++m)
#pragma unroll
                    for (int n = 0; n < 2; ++n) acc[a][b][m][n] = (f32x4){0.f, 0.f, 0.f, 0.f};
        cur = nxt; cA = nA; cB = nB; ++ui;
        if constexpr (ALIGN_EPI) { if (wr == 1) PG8_BAR; }
    }
    PG8_WAIT_V(0);
    if constexpr (!ALIGN_EPI) { if (wr == 0) PG8_BAR; }
    PG8_BAR;
    if constexpr (Epi::AFTER_DRAIN) { E.fused(acc, cur, wr, wc, fr, fq, lds, wid, lane); S.done(cur); }
#undef PG8_SA
#undef PG8_SB
#undef PG8_STAGE
#undef PG8_LDA
#undef PG8_LDB
#undef PG8_MMA
#undef PG8_WAIT_V
#undef PG8_WAIT_L
#undef PG8_BAR
#undef PG8_SCHED
}
}

#define GAS __attribute__((address_space(1)))
#define LAS __attribute__((address_space(3)))
typedef unsigned v4u __attribute__((ext_vector_type(4)));
typedef GAS unsigned gu32;
#define RLX_AGENT __ATOMIC_RELAXED, __HIP_MEMORY_SCOPE_AGENT
#define LDS_WAIT() asm volatile("s_waitcnt lgkmcnt(0)" ::: "memory")
#define XB_TMO      128
#define XB_XCNT(j)  (256  + 64 * (j))
#define XB_XSUB(j)  (1280 + 64 * (j))
#define XB_XGEN(j)  (2304 + 64 * (j))
#define XB_TOP      3328
#define XB_TOPGEN   3392
#define XCD_BAR_WORDS 3456
#define XB_SPIN_CAP (1u << 18)

__device__ __forceinline__ unsigned xb_ld(unsigned* p)              { return __hip_atomic_load(p, __ATOMIC_RELAXED, __HIP_MEMORY_SCOPE_AGENT); }
__device__ __forceinline__ unsigned xb_add(unsigned* p, unsigned v) { return __hip_atomic_fetch_add(p, v, __ATOMIC_RELAXED, __HIP_MEMORY_SCOPE_AGENT); }
__device__ __forceinline__ unsigned xb_xcc_id() { return (unsigned)__builtin_amdgcn_s_getreg((3 << 11) | 20) & 0xFu; }
#define XB_SPIN(cond, bar) do { unsigned _sp = 0; while (cond) { __builtin_amdgcn_s_sleep(1); \
    if ((++_sp & 255u) == 0u) { if (xb_ld(&(bar)[XB_TMO])) break; if (_sp > XB_SPIN_CAP) { atomicAdd(&(bar)[XB_TMO], 1u); break; } } } } while (0)

struct XcdBarrier {
    unsigned* bar; unsigned x;
    volatile LAS unsigned* st;
};

__device__ __forceinline__ XcdBarrier xcd_barrier_post(unsigned* bar, volatile LAS unsigned* st) {
    XcdBarrier b; b.bar = bar; b.x = xb_xcc_id(); b.st = st;
    if (threadIdx.x == 0) (void)xb_add(&bar[XB_XCNT(b.x)], 1u);
    return b;
}
__device__ __forceinline__ void xcd_barrier_complete(unsigned* bar, unsigned x, unsigned& nloc, unsigned& nx) {
    const unsigned G = gridDim.x * gridDim.y * gridDim.z;
    unsigned sum, cnt, mine, sp = 0u;
    for (;;) {
        sum = 0u; cnt = 0u; mine = 0u;
#pragma unroll
        for (unsigned j = 0; j < 16; ++j) { const unsigned c = xb_ld(&bar[XB_XCNT(j)]); sum += c; cnt += (c > 0u) ? 1u : 0u; mine = (j == x) ? c : mine; }
        if (sum == G) break;
        __builtin_amdgcn_s_sleep(1);
        if ((++sp & 255u) == 0u) { if (xb_ld(&bar[XB_TMO])) break; if (sp > XB_SPIN_CAP) { atomicAdd(&bar[XB_TMO], 1u); break; } }
    }
    nloc = mine > 0u ? mine : 1u; nx = cnt > 0u ? cnt : 1u;
}

__device__ __forceinline__ void xcd_barrier(const XcdBarrier& b) {
    asm volatile("s_waitcnt vmcnt(0)" ::: "memory");
    __syncthreads();
    if (threadIdx.x == 0) {
        unsigned* bar = b.bar; asm volatile("" : "+s"(bar));
        __builtin_amdgcn_s_waitcnt(0);
        unsigned nloc = b.st[0], nx = b.st[1];
        if (nloc == 0u) { xcd_barrier_complete(bar, b.x, nloc, nx); b.st[0] = nloc; b.st[1] = nx; }
        const unsigned old = xb_add(&bar[XB_XSUB(b.x)], 1u);
        const unsigned gen = old / nloc;
        if (old + 1u == (gen + 1u) * nloc) {
            __builtin_amdgcn_fence(__ATOMIC_RELEASE, "agent");
            asm volatile("s_waitcnt vmcnt(0)" ::: "memory");
            const unsigned og = xb_add(&bar[XB_TOP], 1u);
            const unsigned tg = og / nx;
            if (og + 1u == (tg + 1u) * nx) xb_add(&bar[XB_TOPGEN], 1u);
            else XB_SPIN(xb_ld(&bar[XB_TOPGEN]) == tg, bar);
            __builtin_amdgcn_fence(__ATOMIC_ACQUIRE, "agent");
            xb_add(&bar[XB_XGEN(b.x)], 1u);
            asm volatile("s_waitcnt vmcnt(0)" ::: "memory");
        } else {
            XB_SPIN(xb_ld(&bar[XB_XGEN(b.x)]) == gen, bar);
            __builtin_amdgcn_fence(__ATOMIC_ACQUIRE, "agent");
            asm volatile("s_waitcnt vmcnt(0)" ::: "memory");
        }
    }
    __syncthreads();
}

template <int O> __device__ __forceinline__ float swz_xor(float v) { return __uint_as_float((unsigned)__builtin_amdgcn_ds_swizzle((int)__float_as_uint(v), (O << 10) | 0x1F)); }
template <int O> __device__ __forceinline__ int swz_xor_i(int v) { return __builtin_amdgcn_ds_swizzle(v, (O << 10) | 0x1F); }
__device__ __forceinline__ float wave_sum(float v) {
    v += swz_xor<1>(v); v += swz_xor<2>(v); v += swz_xor<4>(v); v += swz_xor<8>(v); v += swz_xor<16>(v);
    auto rr = __builtin_amdgcn_permlane32_swap(__float_as_uint(v), __float_as_uint(v), false, false);
    return __uint_as_float(rr[0]) + __uint_as_float(rr[1]);
}

__device__ __forceinline__ void ph_norm(const P& p, int bid, int nb, const float* g, int li, int sh_i, int sc_i, int Mrows, bf16_t* out, bool from_inputs) {
    const int lane = otid() & 63, wave = otid() >> 6; const float* X = (const float*)(p.ws + WS_X); const float* MOD = (const float*)(p.ws + WS_MOD);
    for (int row = bid * 8 + wave; row < Mrows; row += nb * 8) {
        const float4* xr = (const float4*)(from_inputs ? (row < ML ? p.x + (size_t)row * D : p.ctx + (size_t)(row - ML) * D) : X + (size_t)row * D); float4 v[4]; float ss = 0;
#pragma unroll
        for (int j = 0; j < 4; ++j) { v[j] = xr[64 * j + lane]; ss += v[j].x * v[j].x + v[j].y * v[j].y + v[j].z * v[j].z + v[j].w * v[j].w; }
        const float rs = rsqrtf(wave_sum(ss) * (1.f / D) + EPS);
        const float* mrow = MOD + ((size_t)li * 9 + row_mod_idx(row)) * 6144;
#pragma unroll
        for (int j = 0; j < 4; ++j) { const int c0 = (64 * j + lane) * 4; const float4 gg = *(const float4*)(g + c0), sh = *(const float4*)(mrow + sh_i * 1024 + c0), sc = *(const float4*)(mrow + sc_i * 1024 + c0);
            ushort4 o; o.x = f2bf(v[j].x * rs * gg.x * (1.f + sc.x) + sh.x); o.y = f2bf(v[j].y * rs * gg.y * (1.f + sc.y) + sh.y); o.z = f2bf(v[j].z * rs * gg.z * (1.f + sc.z) + sh.z); o.w = f2bf(v[j].w * rs * gg.w * (1.f + sc.w) + sh.w);
            *(ushort4*)(out + (size_t)row * D + c0) = o; }
    }
}
namespace att {
using bf16x8 = __attribute__((ext_vector_type(8))) short;
using s16x4  = __attribute__((ext_vector_type(4))) short;
using f32x16 = __attribute__((ext_vector_type(16))) float;
using u32x4  = __attribute__((ext_vector_type(4))) unsigned;
constexpr int QBLK = 32, KVBLK = 64;
constexpr float SCALE = 0.125f, THR = 8.f;
constexpr int SHM_V = KVBLK * 128 * 2, SHM_K = KVBLK * 64 * 2;
constexpr int OFF_V = 0, OFF_K = 2 * SHM_V, OFF_WS = OFF_K + 2 * SHM_K, OFF_OST = OFF_WS + 8 * 64 * 4, LDS_TOTAL = OFF_OST + 8 * 8192;
#define AT_KSWZ(row, colB) ((row) * 128 + ((colB) ^ ((((row) >> 1) & 7) << 4)))
#define AT_SBAR() __builtin_amdgcn_sched_barrier(0)
__device__ __forceinline__ int crow(int r, int hi) { return (r & 3) + 8 * (r >> 2) + 4 * hi; }
__device__ __forceinline__ unsigned cvtpk(float lo, float hi) { unsigned r; asm volatile("v_cvt_pk_bf16_f32 %0, %1, %2" : "=v"(r) : "v"(lo), "v"(hi)); return r; }

__device__ __forceinline__ void partialSM(f32x16& p0, f32x16& p1, float& m_reg, float& mn, float& alpha) {
  constexpr float C = SCALE * 1.4426950408889634f;
  float pmax = p0[0];
#pragma unroll
  for (int r = 1; r < 16; ++r) pmax = fmaxf(pmax, p0[r]);
#pragma unroll
  for (int r = 0; r < 16; ++r) pmax = fmaxf(pmax, p1[r]);
  { auto rr = __builtin_amdgcn_permlane32_swap(__float_as_uint(pmax), __float_as_uint(pmax), false, false);
    pmax = fmaxf(__uint_as_float(rr[0]), __uint_as_float(rr[1])); }
  if (__builtin_expect(__all(pmax - m_reg <= THR / SCALE), 1)) { mn = m_reg; alpha = 1.f; }
  else { mn = fmaxf(m_reg, pmax); alpha = __builtin_amdgcn_exp2f((m_reg - mn) * C); m_reg = mn; }
  const float mnC = -mn * C;
#pragma unroll
  for (int r = 0; r < 16; ++r) p0[r] = fmaf(p0[r], C, mnC);
#pragma unroll
  for (int r = 0; r < 16; ++r) p1[r] = fmaf(p1[r], C, mnC);
#pragma unroll
  for (int r = 0; r < 16; ++r) p0[r] = __builtin_amdgcn_exp2f(p0[r]);
}
__device__ __forceinline__ void finishSM(f32x16& p0, f32x16& p1, float alpha, float& l_reg, bf16x8& pa0, bf16x8& pa1, bf16x8& pa2, bf16x8& pa3) {
#pragma unroll
  for (int r = 0; r < 16; ++r) p1[r] = __builtin_amdgcn_exp2f(p1[r]);
  float ps = 0;
#pragma unroll
  for (int r = 0; r < 16; ++r) ps += p0[r];
#pragma unroll
  for (int r = 0; r < 16; ++r) ps += p1[r];
  { auto rr = __builtin_amdgcn_permlane32_swap(__float_as_uint(ps), __float_as_uint(ps), false, false);
    ps = __uint_as_float(rr[0]) + __uint_as_float(rr[1]); }
  l_reg = l_reg * alpha + ps;
#define AT_PK4(P, BASE, OUT) do { unsigned a0 = cvtpk(P[BASE + 0], P[BASE + 1]), a1 = cvtpk(P[BASE + 2], P[BASE + 3]);   \
    unsigned b0 = cvtpk(P[BASE + 4], P[BASE + 5]), b1 = cvtpk(P[BASE + 6], P[BASE + 7]);                              \
    auto r0 = __builtin_amdgcn_permlane32_swap(a0, b0, false, false); auto r1 = __builtin_amdgcn_permlane32_swap(a1, b1, false, false); \
    u32x4 w = {r0[0], r1[0], r0[1], r1[1]}; OUT = *reinterpret_cast<bf16x8*>(&w); } while (0)
  AT_PK4(p0, 0, pa0); AT_PK4(p0, 8, pa1); AT_PK4(p1, 0, pa2); AT_PK4(p1, 8, pa3);
#undef AT_PK4
}
__device__ __forceinline__ void qkt(f32x16& p0, f32x16& p1, const char* Ks, const bf16x8* qr, int r32, int hi) {
  p0 = f32x16{}; p1 = f32x16{};
#pragma unroll
  for (int d0 = 0; d0 < 4; ++d0) { const int cb = (d0 * 16 + hi * 8) * 2;
    const bf16x8 b0 = *reinterpret_cast<const bf16x8*>(Ks + AT_KSWZ(r32, cb));
    const bf16x8 b1 = *reinterpret_cast<const bf16x8*>(Ks + AT_KSWZ(32 + r32, cb));
    p0 = __builtin_amdgcn_mfma_f32_32x32x16_bf16(b0, qr[d0], p0, 0, 0, 0);
    p1 = __builtin_amdgcn_mfma_f32_32x32x16_bf16(b1, qr[d0], p1, 0, 0, 0); }
}
__device__ __forceinline__ int v_st(int k, int c) { const int kk = (k & ~0xC) | ((k & 4) << 1) | ((k & 8) >> 1); return ((kk >> 3) * 4 + (c >> 5)) * 512 + ((kk & 7) * 32 + (c & 31)) * 2; }
__device__ __forceinline__ int v_rd_base(int lane) { return ((lane & 3) << 3) | (((lane >> 2) & 3) << 6) | (((lane >> 4) & 1) << 5) | (((lane >> 5) & 1) << 8); }
constexpr int v_rd_off(int d0, int ks, int half) { return d0 * 512 + ks * 4096 + half * 2048; }
template <int OFF> __device__ __forceinline__ s16x4 tr_read(int vb) {
  s16x4 r; asm volatile("ds_read_b64_tr_b16 %0, %1 offset:%2" : "=&v"(r) : "v"(vb), "i"(OFF) : "memory"); return r;
}
template <int D0> __device__ __forceinline__ void pv_one(f32x16& od, int vb, bf16x8 pa0, bf16x8 pa1, bf16x8 pa2, bf16x8 pa3) {
  const s16x4 l0 = tr_read<v_rd_off(D0, 0, 0)>(vb), h0 = tr_read<v_rd_off(D0, 0, 1)>(vb), l1 = tr_read<v_rd_off(D0, 1, 0)>(vb), h1 = tr_read<v_rd_off(D0, 1, 1)>(vb);
  const s16x4 l2 = tr_read<v_rd_off(D0, 2, 0)>(vb), h2 = tr_read<v_rd_off(D0, 2, 1)>(vb), l3 = tr_read<v_rd_off(D0, 3, 0)>(vb), h3 = tr_read<v_rd_off(D0, 3, 1)>(vb);
  asm volatile("s_waitcnt lgkmcnt(0)" ::: "memory"); AT_SBAR();
#define AT_PK(L, H) (bf16x8){L[0], L[1], L[2], L[3], H[0], H[1], H[2], H[3]}
  od = __builtin_amdgcn_mfma_f32_32x32x16_bf16(pa0, AT_PK(l0, h0), od, 0, 0, 0);
  od = __builtin_amdgcn_mfma_f32_32x32x16_bf16(pa1, AT_PK(l1, h1), od, 0, 0, 0);
  od = __builtin_amdgcn_mfma_f32_32x32x16_bf16(pa2, AT_PK(l2, h2), od, 0, 0, 0);
  od = __builtin_amdgcn_mfma_f32_32x32x16_bf16(pa3, AT_PK(l3, h3), od, 0, 0, 0);
#undef AT_PK
}
__device__ __forceinline__ void pv_d0(f32x16* o, int vb, bf16x8 pa0, bf16x8 pa1, bf16x8 pa2, bf16x8 pa3) {
  pv_one<0>(o[0], vb, pa0, pa1, pa2, pa3); pv_one<1>(o[1], vb, pa0, pa1, pa2, pa3); pv_one<2>(o[2], vb, pa0, pa1, pa2, pa3); pv_one<3>(o[3], vb, pa0, pa1, pa2, pa3);
}

__device__ __forceinline__ void attn_unit(const bf16_t* __restrict__ PROJ, bf16_t* __restrict__ ATT, float* stash, int h, int qrow0, int NT, int ctx0, int lat0, bool is_ctx,
                                          float lam, float osc, const float* __restrict__ sg, char* lds) {
  const int tid = otid(), wid = tid >> 6, lane = tid & 63, r32 = lane & 31, hi = lane >> 5;
  char* V_lds = lds + OFF_V; char* K_lds = lds + OFF_K;
  float* wsf = (float*)(lds + OFF_WS) + wid * 64; float* li_l = wsf; float* al_l = wsf + 32;
  const int sr = tid >> 4, sc = (tid & 15) * 8, vst0 = v_st(sr, sc), vst1 = v_st(32 + sr, sc);
  const int kr = tid >> 3, kcb = (tid & 7) * 16, kst = AT_KSWZ(kr, kcb);
  const int vb0 = (int)(uintptr_t)V_lds + v_rd_base(lane);
#define AT_TROW(j) (is_ctx ? ctx0 + (j) * 64 : ((j) < 4 ? ctx0 + (j) * 64 : lat0 + ((j) - 4) * 64))
  f32x16 o[4];
  const int moff0 = wid * 64 * 64 + lane;
  for (int m = 0; m < 2; ++m) {
    __syncthreads();
    const unsigned voffV0 = (unsigned)((sr * DIN + C_V + h * 128 + sc) * 2), voffV1 = voffV0 + 32u * DIN * 2u, voffK = (unsigned)((kr * DIN + C_K + h * 128 + m * 64) * 2 + kcb);
    bf16x8 qr[4];
    { const bf16_t* Qw = PROJ + (size_t)(qrow0 + wid * QBLK + r32) * DIN + C_Q + h * 128 + m * 64 + hi * 8;
#pragma unroll
      for (int d0 = 0; d0 < 4; ++d0) qr[d0] = *reinterpret_cast<const bf16x8*>(Qw + d0 * 16); }
    float m_reg = -1e30f, l_reg = 0.f;
#pragma unroll
    for (int d = 0; d < 4; ++d) o[d] = f32x16{};
    struct { bf16x8 vs0, vs1, ks0; } sr_[2];
#define AT_SLOAD(i, j) do { size_t to_ = (size_t)(AT_TROW(j)) * (DIN * 2); asm volatile("" : "+s"(to_)); const char* tb_ = (const char*)PROJ + to_;     sr_[i].vs0 = *reinterpret_cast<const bf16x8*>(tb_ + voffV0); sr_[i].vs1 = *reinterpret_cast<const bf16x8*>(tb_ + voffV1); \
    sr_[i].ks0 = *reinterpret_cast<const bf16x8*>(tb_ + voffK); } while (0)
#define AT_SWRITE(b, i) do { *(bf16x8*)(V_lds + (b) * SHM_V + vst0) = sr_[i].vs0; *(bf16x8*)(V_lds + (b) * SHM_V + vst1) = sr_[i].vs1; *(bf16x8*)(K_lds + (b) * SHM_K + kst) = sr_[i].ks0; } while (0)
#define AT_SWAIT() asm volatile("s_waitcnt vmcnt(3)" ::: "memory")
#define AT_RESC(a) do { if (__any((a) < 1.f)) { if (hi == 0) al_l[r32] = (a); asm volatile("s_waitcnt lgkmcnt(0)" ::: "memory"); \
    _Pragma("unroll") for (int d = 0; d < 4; ++d) _Pragma("unroll") for (int r = 0; r < 16; ++r) o[d][r] *= al_l[crow(r, hi)]; } } while (0)
    f32x16 pA0, pA1, pB0, pB1; float mnA, mnB, alA, alB; bf16x8 pa0, pa1, pa2, pa3;
    constexpr int SE = 0, SO = 1;
    AT_SLOAD(SE, 0); asm volatile("s_waitcnt vmcnt(0)" ::: "memory"); AT_SWRITE(0, SE); __syncthreads();
    qkt(pA0, pA1, K_lds, qr, r32, hi); partialSM(pA0, pA1, m_reg, mnA, alA);
    AT_SLOAD(SO, 1); if (2 < NT) AT_SLOAD(SE, 2);
    AT_SWAIT(); AT_SWRITE(1, SO); __syncthreads();
    for (int j = 1; j + 1 < NT; j += 2) {
      AT_SBAR(); qkt(pB0, pB1, K_lds + SHM_K, qr, r32, hi);
      finishSM(pA0, pA1, alA, l_reg, pa0, pa1, pa2, pa3); AT_SBAR();
      AT_SLOAD(SO, j + 2); AT_SBAR();
      pv_d0(o, vb0, pa0, pa1, pa2, pa3); partialSM(pB0, pB1, m_reg, mnB, alB);
      __syncthreads(); AT_SWAIT(); AT_SWRITE(0, SE);
      AT_RESC(alB); __syncthreads();
      AT_SBAR(); qkt(pA0, pA1, K_lds, qr, r32, hi);
      finishSM(pB0, pB1, alB, l_reg, pa0, pa1, pa2, pa3); AT_SBAR();
      if (j + 3 < NT) AT_SLOAD(SE, j + 3);
      AT_SBAR();
      pv_d0(o, vb0 + SHM_V, pa0, pa1, pa2, pa3); partialSM(pA0, pA1, m_reg, mnA, alA);
      __syncthreads(); AT_SWAIT(); AT_SWRITE(1, SO);
      AT_RESC(alA); __syncthreads();
    }
    AT_SBAR(); qkt(pB0, pB1, K_lds + SHM_K, qr, r32, hi);
    finishSM(pA0, pA1, alA, l_reg, pa0, pa1, pa2, pa3); AT_SBAR();
    pv_d0(o, vb0, pa0, pa1, pa2, pa3); partialSM(pB0, pB1, m_reg, mnB, alB);
    __syncthreads(); AT_RESC(alB);
    finishSM(pB0, pB1, alB, l_reg, pa0, pa1, pa2, pa3); AT_SBAR();
    pv_d0(o, vb0 + SHM_V, pa0, pa1, pa2, pa3);
    if (hi == 0) li_l[r32] = l_reg;
    asm volatile("s_waitcnt lgkmcnt(0)" ::: "memory");
    float rli[16];
#pragma unroll
    for (int r = 0; r < 16; ++r) rli[r] = __builtin_amdgcn_rcpf(li_l[crow(r, hi)]);
    if (m == 0) {
#pragma unroll
      for (int d0 = 0; d0 < 4; ++d0) { int mo_ = moff0 + d0 * 1024; asm volatile("" : "+v"(mo_)); float* ms = stash + mo_;
#pragma unroll
        for (int r = 0; r < 16; ++r) ms[r * 64] = o[d0][r] * rli[r]; }
    } else {
#pragma unroll
      for (int d0 = 0; d0 < 4; ++d0) { int mo_ = moff0 + d0 * 1024; asm volatile("" : "+v"(mo_)); const float* ms = stash + mo_;
#pragma unroll
        for (int r = 0; r < 16; ++r) o[d0][r] = ms[r * 64] - lam * (o[d0][r] * rli[r]); }
    }
#undef AT_SLOAD
#undef AT_SWRITE
#undef AT_SWAIT
#undef AT_RESC
  }
  float rs[16];
#pragma unroll
  for (int r = 0; r < 16; ++r) { float s = o[0][r] * o[0][r] + o[1][r] * o[1][r] + o[2][r] * o[2][r] + o[3][r] * o[3][r];
    s += swz_xor<1>(s); s += swz_xor<2>(s); s += swz_xor<4>(s); s += swz_xor<8>(s); s += swz_xor<16>(s);
    rs[r] = rsqrtf(s * (1.f / 128.f) + EPS) * osc; }
  float sgv[4];
#pragma unroll
  for (int d0 = 0; d0 < 4; ++d0) sgv[d0] = sg[d0 * 32 + r32];
  bf16_t* stg = (bf16_t*)(lds + OFF_OST) + wid * 4096;
#pragma unroll
  for (int r = 0; r < 16; ++r) { const int orow = crow(r, hi);
#pragma unroll
    for (int d0 = 0; d0 < 4; ++d0) stg[orow * 128 + d0 * 32 + r32] = f2bf(o[d0][r] * rs[r] * sgv[d0]); }
  asm volatile("s_waitcnt lgkmcnt(0)" ::: "memory");
  bf16_t* Ow = ATT + (size_t)(qrow0 + wid * QBLK) * D + h * 128;
#pragma unroll
  for (int i = 0; i < 8; ++i) { const int row = i * 4 + (lane >> 4), ch = lane & 15; const u32x4 v = *(const u32x4*)(stg + row * 128 + ch * 8); *(u32x4*)(Ow + (size_t)row * D + ch * 8) = v; }
#undef AT_TROW
}
#undef AT_KSWZ
#undef AT_SBAR
}

__device__ __forceinline__ void ph_attn(const P& p, int li, bool do_ctx, int bid, int nb, unsigned char* lds) {
    const bf16_t* PROJ = (const bf16_t*)(p.ws + WS_PROJ); bf16_t* ATT = (bf16_t*)(p.ws + WS_ATT);
    const float lam = ((const float*)(p.ws + WS_LAM))[li]; const float osc = 1.f - lambda_init_of(li);
    const int vcu = (nb % 8 == 0) ? (bid % 8) * (nb / 8) + bid / 8 : bid;
    float* stash = (float*)(p.ws + WS_STASH) + (size_t)bid * (8 * 64 * 64);
    const int nlat = 512, nctx = do_ctx ? 64 : 0;
    for (int u = vcu; u < nlat; u += nb) { const int b = u >> 6, h = (u >> 3) & 7, qb = u & 7;
        att::attn_unit(PROJ, ATT, stash, h, b * 2048 + qb * 256, 36, ML + b * 256, b * 2048, false, lam, osc, p.subln_g + li * 128, (char*)lds); }
    { const int first = 0; const int span = nb - first;
      for (int v = bid - first; v >= 0 && v < nctx; v += span) { const int b = v >> 3, h = v & 7;
        att::attn_unit(PROJ, ATT, stash, h, ML + b * 256, 4, ML + b * 256, b * 2048, true, lam, osc, p.subln_g + li * 128, (char*)lds); } }
}
namespace lru {
using bf16x8 = __attribute__((ext_vector_type(8))) short;
using f32x16 = __attribute__((ext_vector_type(16))) float;
using u32x4  = __attribute__((ext_vector_type(4))) unsigned;
constexpr int T = 256;
constexpr int L_URAW = 0, L_UCF = 33280, L_UCB = L_UCF + 32768, L_GLT = L_UCB + 256 * 144, L_LAT = L_GLT + 16384, L_SUMS = L_LAT + 16384, L_BW = L_SUMS + 8192, L_END = L_BW + 8192;
__device__ __forceinline__ float fast_sigmoid(float x) { return __builtin_amdgcn_rcpf(1.f + __expf(-x)); }
__device__ __forceinline__ float one_minus_exp(float x, float a) {
    float pl = 1.f / 5040.f; pl = fmaf(pl, x, 1.f / 720.f); pl = fmaf(pl, x, 1.f / 120.f); pl = fmaf(pl, x, 1.f / 24.f); pl = fmaf(pl, x, 1.f / 6.f); pl = fmaf(pl, x, 0.5f); pl = fmaf(pl, x, 1.f);
    return x > -0.5f ? -x * pl : 1.f - a * a; }
__device__ __forceinline__ float fast_gelu(float x) { const float u = 0.7978845608028654f * (x + 0.044715f * x * x * x); return x * fast_sigmoid(2.f * u); }
}

__device__ __forceinline__ void ph_lru(const P& p, int li, int bid, int nb, unsigned char* lds) {
    using namespace lru;
    const bf16_t* PROJ = (const bf16_t*)(p.ws + WS_PROJ); float* HF = (float*)(p.ws + WS_HF); bf16_t* LA = (bf16_t*)(p.ws + WS_LA);
    const int tid = otid(), wave = tid >> 6, lane = tid & 63, r32 = lane & 31, hi = lane >> 5, tt = wave;
    const int c = r32;
    const int sub = tt * 2 + hi;
    float* UCF = (float*)(lds + L_UCF); float* SUMS = (float*)(lds + L_SUMS);
    for (int item = bid; item < 256; item += nb) {
        const int b = item >> 5, n = (item >> 1) & 15, hfi = item & 1; const int ch0 = n * 64, cb32 = ch0 + hfi * 32;
        int tid_i = tid; asm volatile("" : "+v"(tid_i));
        const int c2 = tid_i & 31, tq = tid_i >> 5;
        float cw0[4], cw1[4];
#pragma unroll
        for (int k = 0; k < 4; ++k) { cw0[k] = p.conv_w[(size_t)(li * 4 + k) * 1024 + ch0 + 2 * c2]; cw1[k] = p.conv_w[(size_t)(li * 4 + k) * 1024 + ch0 + 2 * c2 + 1]; }
        const float cb0 = p.conv_b[li * 1024 + ch0 + 2 * c2], cb1 = p.conv_b[li * 1024 + ch0 + 2 * c2 + 1];
        for (int d = 0; d < 2; ++d) {
            int c_w = c; asm volatile("" : "+v"(c_w));
            { const int g = wave >> 2, ks = wave & 3;
              const float* wp = p.lru_w + ((((size_t)(li * 2 + d) * 2 + g) * 16 + n) * 64) * 64 + hfi * 32 + c_w + (size_t)(ks * 16 + 8 * hi) * 64;
              float wf[8];
#pragma unroll
              for (int j = 0; j < 8; ++j) wf[j] = wp[(size_t)j * 64];
              asm volatile("s_waitcnt vmcnt(0)" ::: "memory");
              *(u32x4*)(lds + L_BW + ((g * 4 + ks) * 64 + lane) * 16) = (u32x4){pk2(wf[0], wf[1]), pk2(wf[2], wf[3]), pk2(wf[4], wf[5]), pk2(wf[6], wf[7])}; }
            const float bias0 = p.lru_b[((size_t)(li * 2 + d) * 2 + 0) * 1024 + cb32 + c_w], bias1 = p.lru_b[((size_t)(li * 2 + d) * 2 + 1) * 1024 + cb32 + c_w];
            float sp8; { const float lam = p.lru_lam[(size_t)(li * 2 + d) * 1024 + cb32 + c_w]; const float z = -lam; const float ez = __expf(z);
              const float spl = ez < 0.1f ? ez * (1.f - ez * (0.5f - ez * (0.33333333f - ez * (0.25f - ez * 0.2f)))) : (z > 20.f ? z : __logf(1.f + ez)); sp8 = -8.f * spl; }
            float state = 0.f;
            u32x4 st_u[5]; u32x4 st_g[2];
#define LRU_CHUNK_ROW0(step_, row0_, L_, t0_) { int cc_; if ((step_) < 1) { cc_ = 0; L_ = 256; row0_ = ML + b * 256; } else { cc_ = d == 0 ? (step_) - 1 : 8 - (step_); L_ = 2048; row0_ = b * 2048; } t0_ = cc_ * T; }
#define LRU_STAGE_LOAD(step_) { int row0_, L_, t0_; LRU_CHUNK_ROW0(step_, row0_, L_, t0_); int tid_ = tid; asm volatile("" : "+v"(tid_));   \
            _Pragma("unroll") for (int q_ = 0; q_ < 5; ++q_) { const int piece_ = tid_ + 512 * q_; const int i_ = piece_ >> 3, chk_ = piece_ & 7; const int tr_ = t0_ - 2 + i_; st_u[q_] = (u32x4){0u, 0u, 0u, 0u}; \
                if (piece_ < 259 * 8 && tr_ >= 0 && tr_ < L_) st_u[q_] = *(const u32x4*)(PROJ + (size_t)(row0_ + tr_) * DIN + C_U + ch0 + chk_ * 8); } \
            if (d == 1) { _Pragma("unroll") for (int q_ = 0; q_ < 2; ++q_) { const int piece_ = tid_ + 512 * q_; const int i_ = piece_ >> 2, chk_ = piece_ & 3; st_g[q_] = *(const u32x4*)(PROJ + (size_t)(row0_ + t0_ + i_) * DIN + C_GL + cb32 + chk_ * 8); } } }
            LRU_STAGE_LOAD(0);
            for (int step = 0; step < 9; ++step) {
                int row0, Lseq, t0; LRU_CHUNK_ROW0(step, row0, Lseq, t0);
                const int crow0 = row0 + t0;
                const int spos0 = (Lseq == 256 ? 0 : 256) + t0;
#pragma unroll
                for (int q = 0; q < 5; ++q) { const int piece = tid + 512 * q; if (piece < 259 * 8) *(u32x4*)(lds + L_URAW + piece * 16) = st_u[q]; }
                if (d == 1) {
#pragma unroll
                    for (int q = 0; q < 2; ++q) { const int piece = tid + 512 * q; *(u32x4*)(lds + L_GLT + piece * 16) = st_g[q]; } }
                __syncthreads();
                if (step + 1 < 9) LRU_STAGE_LOAD(step + 1);
                float hf[16];
                if (d == 1) { int sub_o = sub; asm volatile("" : "+v"(sub_o)); int ho_ = (item * 2304 + spos0 + 255 - sub_o * 16) * 32 + c; asm volatile("" : "+v"(ho_)); const float* hp = HF + ho_;
#pragma unroll
                    for (int r = 0; r < 16; ++r) hf[r] = hp[-r * 32]; }
#pragma unroll
                for (int hh = 0; hh < 2; ++hh) {
                    float x0[11], x1[11]; const int tb8 = tq * 16 + hh * 8;
#pragma unroll
                    for (int i = 0; i < 11; ++i) { const unsigned w = *(const unsigned*)(lds + L_URAW + (tb8 + i) * 128 + c2 * 4); x0[i] = __uint_as_float(w << 16); x1[i] = __uint_as_float(w & 0xffff0000u); }
                    const bool mine = (c2 >> 4) == hfi;
#pragma unroll
                    for (int e = 0; e < 8; ++e) { const int tk = tb8 + e, t = d ? 255 - tk : tk;
                        const float y0 = cb0 + cw0[0] * x0[e] + cw0[1] * x0[e + 1] + cw0[2] * x0[e + 2] + cw0[3] * x0[e + 3];
                        const float y1 = cb1 + cw1[0] * x1[e] + cw1[1] * x1[e + 1] + cw1[2] * x1[e + 2] + cw1[3] * x1[e + 3];
                        if (mine) *(float2*)(UCF + t * 32 + 2 * (c2 & 15)) = make_float2(y0, y1);
                        *(unsigned*)(lds + L_UCB + t * 144 + c2 * 4) = pk2(y0, y1); }
                    __builtin_amdgcn_sched_barrier(0);
                }
                __syncthreads();
                f32x16 acc0 = f32x16{}, acc1 = f32x16{};
                {
                    const int i = r32, hc = (i >> 2) & 1, rr = (i & 3) + 4 * (i >> 3), rho = (tt * 2 + hc) * 16 + rr;
                    const unsigned char* ap = lds + L_UCB + rho * 144 + hi * 16;
#pragma unroll
                    for (int ks = 0; ks < 4; ++ks) { const bf16x8 a = *(const bf16x8*)(ap + ks * 32);
                        const bf16x8 b0 = *(const bf16x8*)(lds + L_BW + (ks * 64 + lane) * 16), b1 = *(const bf16x8*)(lds + L_BW + ((4 + ks) * 64 + lane) * 16);
                        acc0 = __builtin_amdgcn_mfma_f32_32x32x16_bf16(a, b0, acc0, 0, 0, 0); acc1 = __builtin_amdgcn_mfma_f32_32x32x16_bf16(a, b1, acc1, 0, 0, 0); }
                }
                float hl[16], ap_[16]; float P = 1.f, h = 0.f;
                const float* ucp = UCF + (sub * 16) * 32 + c;
#pragma unroll
                for (int r = 0; r < 16; ++r) {
                    const float u = ucp[r * 32]; const float rec = fast_sigmoid(acc0[r] + bias0), inp = fast_sigmoid(acc1[r] + bias1);
                    const float la = sp8 * rec; const float a = __expf(la); const float m2 = one_minus_exp(2.f * la, a); const float drive = __builtin_amdgcn_sqrtf(m2) * (inp * u);
                    h = a * h + drive; P *= a; hl[r] = h; ap_[r] = P;
                    if ((r & 3) == 3) __builtin_amdgcn_sched_barrier(0); }
                float* sums = SUMS + (step & 1) * 1024;
                *(float2*)(sums + (sub * 32 + c) * 2) = make_float2(P, h);
                __syncthreads();
                float carry = state, mine = state;
#pragma unroll
                for (int s = 0; s < 16; ++s) { if (s == sub) mine = carry; const float2 ph = *(const float2*)(sums + (s * 32 + c) * 2); carry = ph.x * carry + ph.y; }
                state = carry;
                if (d == 0) {
                    int sub_o = sub; asm volatile("" : "+v"(sub_o)); int ho_ = (item * 2304 + spos0 + sub_o * 16) * 32 + c; asm volatile("" : "+v"(ho_)); float* hp = HF + ho_;
#pragma unroll
                    for (int r = 0; r < 16; ++r) hp[r * 32] = hl[r] + ap_[r] * mine;
                } else {
                    bf16_t* lat = (bf16_t*)(lds + L_LAT); const bf16_t* glt = (const bf16_t*)(lds + L_GLT);
                    const int tb = 255 - sub * 16;
#pragma unroll
                    for (int r = 0; r < 16; ++r) { const float hb = hl[r] + ap_[r] * mine; const float gl = bf2f(glt[(tb - r) * 32 + c]);
                        lat[(tb - r) * 32 + c] = f2bf((hf[r] + hb) * fast_gelu(gl)); }
                    __syncthreads();
                    int tid3 = tid; asm volatile("" : "+v"(tid3));
#pragma unroll
                    for (int q = 0; q < 2; ++q) { const int piece = tid3 + 512 * q; const int i = piece >> 2, chk = piece & 3;
                        *(u32x4*)(LA + (size_t)(crow0 + i) * D + cb32 + chk * 8) = *(const u32x4*)(lds + L_LAT + piece * 16); }
                }
            }
#undef LRU_STAGE_LOAD
#undef LRU_CHUNK_ROW0
            asm volatile("s_waitcnt vmcnt(0)" ::: "memory");
            __syncthreads();
            if (tid == 0) { __builtin_amdgcn_fence(__ATOMIC_ACQUIRE, "agent"); asm volatile("s_waitcnt vmcnt(0)" ::: "memory"); }
            __syncthreads();
        }
    }
}
namespace peer {
using bf16x8 = __attribute__((ext_vector_type(8))) short;
using f32x16 = __attribute__((ext_vector_type(16))) float;
using u32x4  = __attribute__((ext_vector_type(4))) unsigned;
typedef __bf16 bf16x2_t __attribute__((ext_vector_type(2)));
__device__ __forceinline__ unsigned sortable(float f) { const unsigned u = __float_as_uint(f); return (u & 0x80000000u) ? ~u : (u | 0x80000000u); }
__device__ __forceinline__ float unsortable(unsigned u) { return __uint_as_float((u & 0x80000000u) ? (u & 0x7fffffffu) : ~u); }
__device__ __forceinline__ unsigned umax_(unsigned a, unsigned b) { return a > b ? a : b; }
__device__ __forceinline__ unsigned umin_(unsigned a, unsigned b) { return a < b ? a : b; }
__device__ __forceinline__ void sort16_desc(unsigned (&v)[16]) {
#pragma unroll
    for (int kk = 1; kk <= 4; ++kk)
#pragma unroll
        for (int jj = 3; jj >= 0; --jj)
#pragma unroll
            for (int i = 0; i < 16; ++i) { const int k = 1 << kk, j = 1 << jj, l = i ^ j; if (jj >= kk) continue;
                if (l > i) { const unsigned mx = umax_(v[i], v[l]), mn = umin_(v[i], v[l]); if ((i & k) == 0) { v[i] = mx; v[l] = mn; } else { v[i] = mn; v[l] = mx; } } }
}
__device__ __forceinline__ void merge_top16(unsigned (&a)[16], const unsigned (&b)[16]) {
#pragma unroll
    for (int i = 0; i < 16; ++i) a[i] = umax_(a[i], b[15 - i]);
#pragma unroll
    for (int jj = 3; jj >= 0; --jj)
#pragma unroll
        for (int i = 0; i < 16; ++i) { const int j = 1 << jj, l = i ^ j; if (l > i) { const unsigned mx = umax_(a[i], a[l]), mn = umin_(a[i], a[l]); a[i] = mx; a[l] = mn; } }
}
__device__ __forceinline__ int crow(int r, int hi) { return (r & 3) + 8 * (r >> 2) + 4 * hi; }
__device__ __forceinline__ float dot2(unsigned a, unsigned b, float acc) { return __builtin_amdgcn_fdot2_f32_bf16(__builtin_bit_cast(bf16x2_t, a), __builtin_bit_cast(bf16x2_t, b), acc, false); }
__device__ __forceinline__ unsigned msel(unsigned a, unsigned b, unsigned m) { return a ^ ((a ^ b) & m); }
__device__ __forceinline__ unsigned pick16(const unsigned (&a)[16], int i) {
    const unsigned m0 = 0u - (unsigned)(i & 1), m1 = 0u - (unsigned)((i >> 1) & 1), m2 = 0u - (unsigned)((i >> 2) & 1), m3 = 0u - (unsigned)((i >> 3) & 1);
    unsigned t8[8], t4[4], t2[2];
#pragma unroll
    for (int k = 0; k < 8; ++k) t8[k] = msel(a[2 * k], a[2 * k + 1], m0);
#pragma unroll
    for (int k = 0; k < 4; ++k) t4[k] = msel(t8[2 * k], t8[2 * k + 1], m1);
#pragma unroll
    for (int k = 0; k < 2; ++k) t2[k] = msel(t4[2 * k], t4[2 * k + 1], m2);
    return msel(t2[0], t2[1], m3); }
__device__ __forceinline__ void score_list(const bf16_t* __restrict__ PQ, const bf16_t* __restrict__ KEYS, int tok, int hp, int r32, int hi, unsigned (&T)[16]) {
    const bf16_t* qp = PQ + (size_t)tok * D + hp * 64 + hi * 8; bf16x8 qf[4];
#pragma unroll
    for (int ks = 0; ks < 4; ++ks) qf[ks] = *reinterpret_cast<const bf16x8*>(qp + ks * 16);
    const bf16_t* kp = KEYS + ((size_t)hp * 128 + r32) * 64 + hi * 8;
#pragma unroll
    for (int kt = 0; kt < 4; ++kt) { f32x16 acc = f32x16{};
#pragma unroll
        for (int ks = 0; ks < 4; ++ks) { const bf16x8 a = *reinterpret_cast<const bf16x8*>(kp + (size_t)kt * 32 * 64 + ks * 16); acc = __builtin_amdgcn_mfma_f32_32x32x16_bf16(a, qf[ks], acc, 0, 0, 0); }
        unsigned v[16];
#pragma unroll
        for (int r = 0; r < 16; ++r) v[r] = (sortable(acc[r]) & ~127u) | (unsigned)(127 - (kt * 32 + crow(r, hi)));
        sort16_desc(v);
        if (kt == 0) {
#pragma unroll
            for (int r = 0; r < 16; ++r) T[r] = v[r];
        } else merge_top16(T, v);
    }
}
}

__device__ __forceinline__ void ph_peer_score(const P& p, int li, int Mrows, int bid, int nb) {
    using namespace peer;
    const bf16_t* PQ = (const bf16_t*)(p.ws + WS_PQ); const bf16_t* KEYS = (const bf16_t*)(p.ws + WS_KEYS) + (size_t)li * 16 * 128 * 64;
    int* IDX = (int*)(p.ws + WS_IDX); float* G = (float*)(p.ws + WS_G);
    const int tid = otid(), wave = tid >> 6, lane = tid & 63, r32 = lane & 31, hi = lane >> 5;
    const int gw = bid * NWAVES + wave, NGW = nb * NWAVES, ntask = (Mrows / 32) * 4;
    for (int task = gw; task < ntask; task += NGW) {
        const int tok = (task >> 2) * 32 + r32, hp2 = task & 3;
        for (int hh = 0; hh < 2; ++hh) { const int h = hp2 * 2 + hh;
            unsigned A0[16], B0[16];
            score_list(PQ, KEYS, tok, h * 2 + 0, r32, hi, A0); score_list(PQ, KEYS, tok, h * 2 + 1, r32, hi, B0);
            unsigned M[16], Y[16];
#pragma unroll
            for (int i = 0; i < 16; ++i) { auto rr = __builtin_amdgcn_permlane32_swap(A0[i], B0[i], false, false); M[i] = rr[0]; Y[i] = rr[1]; }
            merge_top16(M, Y);
            unsigned P0[16], P1[16];
#pragma unroll
            for (int i = 0; i < 16; ++i) { auto rr = __builtin_amdgcn_permlane32_swap(M[i], M[i], false, false); P0[i] = rr[0]; P1[i] = rr[1]; }
            float X[16], Yv[16];
#pragma unroll
            for (int i = 0; i < 16; ++i) { const float f0 = unsortable(P0[i]), f1 = unsortable(P1[i]); X[i] = hi ? f1 : f0; Yv[i] = hi ? f0 : f1; }
            unsigned C0[16], C1[16];
#pragma unroll
            for (int c = 0; c < 16; ++c) { const float s = X[0] + Yv[c]; const unsigned flat = hi ? (unsigned)(c * 16) : (unsigned)c; unsigned key = (sortable(s) & ~255u) | (255u - flat); if (c == 0 && hi) key = 0u; C0[c] = key; }
#define PEER_CAND(c, i, j) { const float s_ = X[i] + Yv[j]; const unsigned flat_ = hi ? (unsigned)((j) * 16 + (i)) : (unsigned)((i) * 16 + (j)); unsigned key_ = (sortable(s_) & ~255u) | (255u - flat_); if ((i) == (j) && hi) key_ = 0u; C1[c] = key_; }
            PEER_CAND(0, 1, 1) PEER_CAND(1, 1, 2) PEER_CAND(2, 1, 3) PEER_CAND(3, 1, 4) PEER_CAND(4, 1, 5) PEER_CAND(5, 1, 6) PEER_CAND(6, 1, 7) PEER_CAND(7, 2, 2) PEER_CAND(8, 2, 3) PEER_CAND(9, 2, 4) PEER_CAND(10, 3, 3)
#undef PEER_CAND
            C1[11] = 0u; C1[12] = 0u; C1[13] = 0u; C1[14] = 0u; C1[15] = 0u;
            sort16_desc(C0); sort16_desc(C1); merge_top16(C0, C1);
            unsigned F[16]; unsigned mxk;
            { unsigned Clo[16], Chi[16];
#pragma unroll
              for (int i = 0; i < 16; ++i) { auto rr = __builtin_amdgcn_permlane32_swap(C0[i], C0[i], false, false); Clo[i] = rr[0]; Chi[i] = rr[1]; }
#pragma unroll
              for (int i = 0; i < 16; ++i) F[i] = umax_(Clo[i], Chi[15 - i]);
              mxk = umax_(Clo[0], Chi[0]); }
            const float fmx = unsortable(mxk); float w[16]; float wsum = 0.f;
#pragma unroll
            for (int i = 0; i < 16; ++i) { w[i] = __expf(unsortable(F[i]) - fmx); wsum += w[i]; }
            const float inv = 1.f / wsum;
            int oi[8]; float og[8]; const unsigned him = 0u - (unsigned)hi;
#pragma unroll
            for (int k = 0; k < 8; ++k) { const unsigned e = msel(F[k], F[8 + k], him); const float wk = __uint_as_float(msel(__float_as_uint(w[k]), __float_as_uint(w[8 + k]), him));
                const int cf = 255 - (int)(e & 255u), i1 = cf >> 4, i2 = cf & 15;
                const int n1 = 127 - (int)(pick16(P0, i1) & 127u), n2 = 127 - (int)(pick16(P1, i2) & 127u);
                oi[k] = n1 * 128 + n2; og[k] = wk * inv; }
            int* ip = IDX + (size_t)tok * 128 + h * 16 + hi * 8; float* gp = G + (size_t)tok * 128 + h * 16 + hi * 8;
            *(int4*)ip = make_int4(oi[0], oi[1], oi[2], oi[3]); *(int4*)(ip + 4) = make_int4(oi[4], oi[5], oi[6], oi[7]);
            *(float4*)gp = make_float4(og[0], og[1], og[2], og[3]); *(float4*)(gp + 4) = make_float4(og[4], og[5], og[6], og[7]);
        }
    }
}

#ifndef FP6_INTERLEAVED
#define FP6_INTERLEAVED 1
#endif
namespace peer {
typedef float v16f __attribute__((ext_vector_type(16)));
typedef float v32f __attribute__((ext_vector_type(32)));
typedef unsigned v6u __attribute__((ext_vector_type(6)));
typedef unsigned v16u __attribute__((ext_vector_type(16)));
typedef unsigned u32x2 __attribute__((ext_vector_type(2)));
__host__ __device__ constexpr int fp6_src_of(int k) { return FP6_INTERLEAVED ? ((k & 1) * 16 + (k >> 1)) : k; }
}
__device__ __forceinline__ void ph_peer_tables(const P& p, int li, int bid, int nb) {
    using namespace peer;
    const int tid = otid(), lane = tid & 63, wave = tid >> 6, g = lane & 31, hb = lane >> 5;
    const int first = nb >= 128 ? 64 : 0;
    if (bid < first) return;
    const int gw = (bid - first) * NWAVES + wave, NGW = (nb - first) * NWAVES;
    for (int rp = gw; rp < 16384; rp += NGW) {
        const int rr = 2 * rp + hb, tab = rr >> 14, row = rr & 16383;
        const float4* src = (const float4*)((tab ? p.peer_v : p.peer_u) + ((size_t)li * 16384 + row) * 1024 + g * 32);
        unsigned char* dst = (unsigned char*)(p.ws + WS_PU) + (size_t)row * 1280 + (tab ? 512 + g * 24 : g * 16);        float* sc = (float*)(p.ws + (tab ? WS_SV : WS_SU));
        float4 v[8]; float mx = 0.f;
#pragma unroll
        for (int j = 0; j < 8; ++j) { v[j] = src[j]; mx = fmaxf(fmaxf(mx, fmaxf(fabsf(v[j].x), fabsf(v[j].y))), fmaxf(fabsf(v[j].z), fabsf(v[j].w))); }
        mx = fmaxf(mx, swz_xor<1>(mx)); mx = fmaxf(mx, swz_xor<2>(mx)); mx = fmaxf(mx, swz_xor<4>(mx)); mx = fmaxf(mx, swz_xor<8>(mx)); mx = fmaxf(mx, swz_xor<16>(mx));
        const float top = tab ? 7.5f : 6.0f;
        const float inv = mx > 0.f ? top / mx : 0.f;
        v16f a, b;
#pragma unroll
        for (int j = 0; j < 4; ++j) { a[4 * j] = v[j].x * inv; a[4 * j + 1] = v[j].y * inv; a[4 * j + 2] = v[j].z * inv; a[4 * j + 3] = v[j].w * inv;
                                      b[4 * j] = v[4 + j].x * inv; b[4 * j + 1] = v[4 + j].y * inv; b[4 * j + 2] = v[4 + j].z * inv; b[4 * j + 3] = v[4 + j].w * inv; }
        if (tab) { const v6u w = __builtin_amdgcn_cvt_scalef32_2xpk16_fp6_f32(a, b, 1.0f);
            *(u32x2*)(dst) = (u32x2){w[0], w[1]}; *(u32x2*)(dst + 8) = (u32x2){w[2], w[3]}; *(u32x2*)(dst + 16) = (u32x2){w[4], w[5]}; }
        else { unsigned w4[4] = {0u, 0u, 0u, 0u};
#define FP4_ENC(W, SRC, I, SEL) W = __builtin_amdgcn_cvt_scalef32_pk_fp4_f32(W, SRC[2 * (I)], SRC[2 * (I) + 1], 1.0f, SEL);
            FP4_ENC(w4[0], a, 0, 0) FP4_ENC(w4[0], a, 1, 1) FP4_ENC(w4[0], a, 2, 2) FP4_ENC(w4[0], a, 3, 3) FP4_ENC(w4[1], a, 4, 0) FP4_ENC(w4[1], a, 5, 1) FP4_ENC(w4[1], a, 6, 2) FP4_ENC(w4[1], a, 7, 3)
            FP4_ENC(w4[2], b, 0, 0) FP4_ENC(w4[2], b, 1, 1) FP4_ENC(w4[2], b, 2, 2) FP4_ENC(w4[2], b, 3, 3) FP4_ENC(w4[3], b, 4, 0) FP4_ENC(w4[3], b, 5, 1) FP4_ENC(w4[3], b, 6, 2) FP4_ENC(w4[3], b, 7, 3)
#undef FP4_ENC
            *(u32x4*)dst = (u32x4){w4[0], w4[1], w4[2], w4[3]}; }
        if (g == 0) sc[row] = mx / top;
    }
}

__device__ __forceinline__ void ph_peer_expert(const P& p, int li, int Mrows, int bid, int nb, bool dry) {
    using namespace peer;
    typedef float f32x2 __attribute__((ext_vector_type(2)));
    const bf16_t* HQ = (const bf16_t*)(p.ws + WS_HX); const int* IDX = (const int*)(p.ws + WS_IDX); const float* G = (const float*)(p.ws + WS_G);
    const float* X = (const float*)(p.ws + WS_X); const float* MOD = (const float*)(p.ws + WS_MOD);
    float* Xw = dry ? (float*)(p.ws + WS_HF) : (float*)(p.ws + WS_X); bf16_t* HXo = dry ? (bf16_t*)(p.ws + WS_ATT) : (bf16_t*)(p.ws + WS_HX); float* OUTw = dry ? (float*)(p.ws + WS_HF) : p.out;
    const unsigned char* UT = (const unsigned char*)(p.ws + WS_PU); const unsigned char* VT = UT;
    const float* SU = (const float*)(p.ws + WS_SU); const float* SV = (const float*)(p.ws + WS_SV);
    const auto rsU = __builtin_amdgcn_make_buffer_rsrc((void*)UT, 0, 16384 * 1280, 0x00020000); const auto rsV = rsU;
    const int tid = otid(), lane = tid & 63, wave = __builtin_amdgcn_readfirstlane(tid >> 6), g = lane & 31, hb = lane >> 5;
    const bool b4 = (lane >> 4) & 1, b3 = (lane >> 3) & 1;
    const int eL = 2 * (2 * (int)b4 + (int)b3) + hb;
    const unsigned goff = (unsigned)g * 24u;
    for (int tok = bid * NWAVES + wave; tok < Mrows; tok += nb * NWAVES) {
        f32x2 hv2[16];
        { int g_t = g; asm volatile("" : "+v"(g_t)); const u32x4* hsrc = (const u32x4*)(HQ + (size_t)tok * D + g_t * 32);
#pragma unroll
          for (int j = 0; j < 4; ++j) { const u32x4 hw = hsrc[j]; hv2[4 * j] = (f32x2){pg8::bflo(hw.x), pg8::bfhi(hw.x)}; hv2[4 * j + 1] = (f32x2){pg8::bflo(hw.y), pg8::bfhi(hw.y)};
              hv2[4 * j + 2] = (f32x2){pg8::bflo(hw.z), pg8::bfhi(hw.z)}; hv2[4 * j + 3] = (f32x2){pg8::bflo(hw.w), pg8::bfhi(hw.w)}; } }
        f32x2 y2[16];
#pragma unroll
        for (int k = 0; k < 16; ++k) y2[k] = (f32x2){0.f, 0.f};
        const int* ip = IDX + (size_t)tok * 128; const float* gp = G + (size_t)tok * 128;
        int idx_nx = ip[lane & 7]; u32x4 ud[4]; v6u vd[4]; const unsigned goff4 = (unsigned)g * 16u;
#define PEER_ISSUE(dst, RS, idxreg) { _Pragma("unroll") for (int j_ = 0; j_ < 4; ++j_) { const int e0_ = __builtin_amdgcn_readlane(idxreg, 2 * j_), e1_ = __builtin_amdgcn_readlane(idxreg, 2 * j_ + 1); \
            const unsigned vo_ = (unsigned)(hb ? e1_ : e0_) * 1280u + 512u + goff; const u32x4 q4_ = __builtin_amdgcn_raw_buffer_load_b128(RS, vo_, 0, 0); const u32x2 q2_ = __builtin_amdgcn_raw_buffer_load_b64(RS, vo_ + 16u, 0, 0); \
            dst[j_] = (v6u){q4_.x, q4_.y, q4_.z, q4_.w, q2_.x, q2_.y}; } __builtin_amdgcn_sched_barrier(0); }
#define PEER_ISSUE_U(idxreg) { _Pragma("unroll") for (int j_ = 0; j_ < 4; ++j_) { const int e0_ = __builtin_amdgcn_readlane(idxreg, 2 * j_), e1_ = __builtin_amdgcn_readlane(idxreg, 2 * j_ + 1); \
            ud[j_] = __builtin_amdgcn_raw_buffer_load_b128(rsU, (unsigned)(hb ? e1_ : e0_) * 1280u + goff4, 0, 0); } __builtin_amdgcn_sched_barrier(0); }
        PEER_ISSUE_U(idx_nx); PEER_ISSUE(vd, rsV, idx_nx);
        for (int hu = 0; hu < 16; ++hu) {
            const int idxL = ip[hu * 8 + eL]; const float gL = gp[hu * 8 + eL] * SV[idxL]; const float suL = SU[idxL];
            if (hu < 15) idx_nx = ip[(hu + 1) * 8 + (lane & 7)];
            float part[4];
#pragma unroll
            for (int j = 0; j < 4; ++j) { const unsigned uw[4] = {ud[j].x, ud[j].y, ud[j].z, ud[j].w}; f32x2 a0 = (f32x2){0.f, 0.f}, a1 = (f32x2){0.f, 0.f};
#define FP4_FMA(ACC, KK, SEL) ACC += hv2[KK] * __builtin_amdgcn_cvt_scalef32_pk_f32_fp4(uw[(KK) >> 2], 1.0f, SEL);
                FP4_FMA(a0, 0, 0) FP4_FMA(a1, 1, 1) FP4_FMA(a0, 2, 2) FP4_FMA(a1, 3, 3) FP4_FMA(a0, 4, 0) FP4_FMA(a1, 5, 1) FP4_FMA(a0, 6, 2) FP4_FMA(a1, 7, 3)
                FP4_FMA(a0, 8, 0) FP4_FMA(a1, 9, 1) FP4_FMA(a0, 10, 2) FP4_FMA(a1, 11, 3) FP4_FMA(a0, 12, 0) FP4_FMA(a1, 13, 1) FP4_FMA(a0, 14, 2) FP4_FMA(a1, 15, 3)
#undef FP4_FMA
                a0 += a1; part[j] = a0.x + a0.y; __builtin_amdgcn_sched_barrier(0); }
            if (hu < 15) PEER_ISSUE_U(idx_nx);
            float s2[2];
#pragma unroll
            for (int k = 0; k < 2; ++k) { const float keep = b4 ? part[k + 2] : part[k], send = b4 ? part[k] : part[k + 2]; s2[k] = keep + swz_xor<16>(send); }
            float s1; { const float keep = b3 ? s2[1] : s2[0], send = b3 ? s2[0] : s2[1]; s1 = keep + swz_xor<8>(send); }
            s1 += swz_xor<4>(s1); s1 += swz_xor<1>(s1); s1 += swz_xor<2>(s1);
            const float wL = lru::fast_gelu(s1 * suL) * gL;
#pragma unroll
            for (int j = 0; j < 4; ++j) {
                const int src0 = ((j >> 1) & 1) * 16 + (j & 1) * 8;
                const float w0 = __uint_as_float(__builtin_amdgcn_readlane(__float_as_uint(wL), src0)), w1 = __uint_as_float(__builtin_amdgcn_readlane(__float_as_uint(wL), src0 + 32));
                const float wk = hb ? w1 : w0;
                const v32f z = __builtin_amdgcn_cvt_scalef32_pk32_f32_fp6(vd[j], 1.0f); const f32x2 wk2 = (f32x2){wk, wk};
#pragma unroll
                for (int k = 0; k < 16; ++k) y2[k] += wk2 * (f32x2){z[2 * k], z[2 * k + 1]};
                __builtin_amdgcn_sched_barrier(0); }
            if (hu < 15) PEER_ISSUE(vd, rsV, idx_nx);
        }
#undef PEER_ISSUE
#undef PEER_ISSUE_U
        float ye[16];
        { float yt[32];
#pragma unroll
          for (int k = 0; k < 32; ++k) { const float yk = (k & 1) ? y2[k >> 1].y : y2[k >> 1].x; auto rr = __builtin_amdgcn_permlane32_swap(__float_as_uint(yk), __float_as_uint(yk), false, false); yt[k] = __uint_as_float(rr[0]) + __uint_as_float(rr[1]); }
          float yo[32];
#pragma unroll
          for (int k = 0; k < 32; ++k) yo[fp6_src_of(k)] = yt[k];
          const unsigned hm = 0u - (unsigned)hb;
#pragma unroll
          for (int e = 0; e < 16; ++e) ye[e] = __uint_as_float(msel(__float_as_uint(yo[e]), __float_as_uint(yo[16 + e]), hm)); }
        int lane_e = lane; asm volatile("" : "+v"(lane_e));
        const int ridx = row_mod_idx(tok); const float* g2 = MOD + ((size_t)li * 9 + ridx) * 6144 + 5 * 1024; const int c0 = (lane_e & 31) * 32 + (lane_e >> 5) * 16;
        float xn[16]; float ss = 0.f; const float* xp = X + (size_t)tok * D + c0; float* xw = Xw + (size_t)tok * D + c0;
#pragma unroll
        for (int q = 0; q < 4; ++q) { const float4 xv = *(const float4*)(xp + 4 * q), gg = *(const float4*)(g2 + c0 + 4 * q);
            xn[4 * q] = xv.x + gg.x * ye[4 * q]; xn[4 * q + 1] = xv.y + gg.y * ye[4 * q + 1]; xn[4 * q + 2] = xv.z + gg.z * ye[4 * q + 2]; xn[4 * q + 3] = xv.w + gg.w * ye[4 * q + 3];
            *(float4*)(xw + 4 * q) = make_float4(xn[4 * q], xn[4 * q + 1], xn[4 * q + 2], xn[4 * q + 3]);
            ss += xn[4 * q] * xn[4 * q] + xn[4 * q + 1] * xn[4 * q + 1] + xn[4 * q + 2] * xn[4 * q + 2] + xn[4 * q + 3] * xn[4 * q + 3]; }
        const float rs = rsqrtf(wave_sum(ss) * (1.f / D) + EPS);
        if (li < DEPTH - 1) {
            const float* gN = p.norm1_g + (li + 1) * D; const float* mrow = MOD + ((size_t)(li + 1) * 9 + ridx) * 6144; float o[16];
#pragma unroll
            for (int q = 0; q < 4; ++q) { const float4 gg = *(const float4*)(gN + c0 + 4 * q), sh = *(const float4*)(mrow + c0 + 4 * q), sc = *(const float4*)(mrow + 1024 + c0 + 4 * q);
                o[4 * q] = xn[4 * q] * rs * gg.x * (1.f + sc.x) + sh.x; o[4 * q + 1] = xn[4 * q + 1] * rs * gg.y * (1.f + sc.y) + sh.y;
                o[4 * q + 2] = xn[4 * q + 2] * rs * gg.z * (1.f + sc.z) + sh.z; o[4 * q + 3] = xn[4 * q + 3] * rs * gg.w * (1.f + sc.w) + sh.w; }
            *(u32x4*)(HXo + (size_t)tok * D + c0) = (u32x4){pk2(o[0], o[1]), pk2(o[2], o[3]), pk2(o[4], o[5]), pk2(o[6], o[7])};
            *(u32x4*)(HXo + (size_t)tok * D + c0 + 8) = (u32x4){pk2(o[8], o[9]), pk2(o[10], o[11]), pk2(o[12], o[13]), pk2(o[14], o[15])};
        } else {
            float* op = OUTw + (size_t)tok * D + c0;
#pragma unroll
            for (int q = 0; q < 4; ++q) { const float4 gg = *(const float4*)(p.final_g + c0 + 4 * q);
                *(float4*)(op + 4 * q) = make_float4(xn[4 * q] * rs * gg.x, xn[4 * q + 1] * rs * gg.y, xn[4 * q + 2] * rs * gg.z, xn[4 * q + 3] * rs * gg.w); }
        }
    }
}
template <bool ROPEPERM>
__device__ __forceinline__ void p0_transpose_item(const float* W, int K, int N, bf16_t* WT, LAS float* scr, int item, int lane) {
    const int nblk = N / 32, kb = item / nblk, nbk = item % nblk, k0 = 64 * kb, n0 = 32 * nbk;
#pragma unroll 8
    for (int i = 0; i < 32; ++i) { const int kk = 2 * i + (lane >> 5); scr[kk * 33 + (lane & 31)] = W[(size_t)(k0 + kk) * N + n0 + (lane & 31)]; }
    LDS_WAIT(); asm volatile("" ::: "memory");
    const int c = lane & 7;
#pragma unroll
    for (int j = 0; j < 4; ++j) { const int n = (lane >> 3) + 8 * j; const int ns = ROPEPERM ? ((n & 1) * 16 + (n >> 1)) : n; const LAS float* s = scr + (8 * c) * 33 + ns;
        v4u o; o.x = pk2(s[0 * 33], s[1 * 33]); o.y = pk2(s[2 * 33], s[3 * 33]); o.z = pk2(s[4 * 33], s[5 * 33]); o.w = pk2(s[6 * 33], s[7 * 33]);
        *(GAS v4u*)(WT + (size_t)(n0 + n) * K + k0 + 8 * c) = o; }
    LDS_WAIT(); asm volatile("" ::: "memory");
}

__device__ __forceinline__ void ph_prologue(const P& p, int bid, int nb, unsigned char* lds) {
    const int tid = otid(), lane = tid & 63, wave = tid >> 6; const long gtid = (long)bid * NTHREADS + tid, gsz = (long)nb * NTHREADS;
    float2* R = (float2*)(p.ws + WS_ROPE);
    for (long i = gtid; i < 2048 * 32; i += gsz) { const int t = (int)(i >> 5), j = (int)(i & 31), a = j >> 4, f = j & 15;
        const float pos = a == 0 ? (float)(t >> 6) : (float)(t & 63); const float inv = exp2f(-(float)f * (13.287712379549449f / 16.0f)); const float ang = pos * inv;
        R[i] = make_float2(__cosf(ang), __sinf(ang)); }
    if (gtid < 4) { const int li = (int)gtid; const float* lp = p.diff_lam + li * 4 * 64; float s0 = 0, s1 = 0; for (int d = 0; d < 64; ++d) { s0 += lp[d] * lp[64 + d]; s1 += lp[128 + d] * lp[192 + d]; }
        ((float*)(p.ws + WS_LAM))[li] = expf(s0) - expf(s1) + lambda_init_of(li); }
    { bf16_t* KB = (bf16_t*)(p.ws + WS_KEYS); for (long i = gtid; i < (long)4 * 16 * 128 * 64; i += gsz) KB[i] = f2bf(p.peer_keys[i]); }
    {
        float* s = (float*)lds;
        for (int i = tid; i < 9 * 1024; i += NTHREADS) { const int r = i >> 10, k = i & 1023; const float v = r < 8 ? p.c[r * 1024 + k] : p.c_ctx[k]; s[i] = siluf_(v); }
        __syncthreads();
        float* MODP = (float*)(p.ws + WS_MODP);
        for (int item = bid; item < 8 * 4 * 12; item += nb) {
            const int ks = item / 48, li = (item / 12) & 3, jb = item % 12; const int j = jb * 512 + tid; const float* W = p.mod_w + ((size_t)li * 1024 + ks * 128) * 6144 + j; const float* sk = s + ks * 128;
            float a0 = 0, a1 = 0, a2 = 0, a3 = 0, a4 = 0, a5 = 0, a6 = 0, a7 = 0, a8 = 0;
#pragma unroll 4
            for (int k = 0; k < 128; ++k) { const float w = W[(size_t)k * 6144];
                a0 += sk[k] * w; a1 += sk[1024 + k] * w; a2 += sk[2048 + k] * w; a3 += sk[3072 + k] * w; a4 += sk[4096 + k] * w; a5 += sk[5120 + k] * w; a6 += sk[6144 + k] * w; a7 += sk[7168 + k] * w; a8 += sk[8192 + k] * w; }
            float* o = MODP + ((size_t)(ks * 4 + li) * 9) * 6144 + j;
            o[0 * 6144] = a0; o[1 * 6144] = a1; o[2 * 6144] = a2; o[3 * 6144] = a3; o[4 * 6144] = a4; o[5 * 6144] = a5; o[6 * 6144] = a6; o[7 * 6144] = a7; o[8 * 6144] = a8;
        }
        __syncthreads();
    }
    {
        LAS float* scr = (LAS float*)((LAS unsigned char*)lds + wave * 16384);
        const int gw = bid * NWAVES + wave, NGW = nb * NWAVES;
        constexpr int I_IN = (D / 64) * (DIN / 32), I_SQ = (D / 64) * (D / 32);
        constexpr int PER_L = I_IN + 4 * I_SQ, NITEMS = DEPTH * PER_L;
        for (int it = gw; it < NITEMS; it += NGW) {
            const int li = it / PER_L; int r = it % PER_L;
            if (r < I_IN) { const int nbk = r % (DIN / 32); const bool perm = nbk >= (C_Q / 32) && nbk < (C_V / 32);
                const float* W = p.w_in + (size_t)li * D * DIN; bf16_t* WT = (bf16_t*)(p.ws + WS_WIN_T) + (size_t)li * DIN * D;
                if (perm) p0_transpose_item<true>(W, D, DIN, WT, scr, r, lane); else p0_transpose_item<false>(W, D, DIN, WT, scr, r, lane);
                continue; }
            r -= I_IN; const int which = r / I_SQ; r %= I_SQ;
            const float* W = (which == 0 ? p.w_br_lru : which == 1 ? p.w_br_attn : which == 2 ? p.w_out : p.peer_wq) + (size_t)li * D * D;
            bf16_t* WT = (bf16_t*)(p.ws + (which == 0 ? WS_WBL_T : which == 1 ? WS_WBA_T : which == 2 ? WS_WOUT_T : WS_WQ_T)) + (size_t)li * D * D;
            p0_transpose_item<false>(W, D, D, WT, scr, r, lane);
        }
    }
}
__device__ __forceinline__ void ph_modfin(const P& p, int bid, int nb) {
    const long gtid = (long)bid * NTHREADS + otid(), gsz = (long)nb * NTHREADS; const float* MODP = (const float*)(p.ws + WS_MODP); float* MOD = (float*)(p.ws + WS_MOD);
    for (long i = gtid; i < 4 * 9 * 6144; i += gsz) { const int j = (int)(i % 6144), li = (int)(i / (9 * 6144)); float a = p.mod_b[li * 6144 + j];
#pragma unroll
        for (int ks = 0; ks < 8; ++ks) a += MODP[(size_t)ks * 4 * 9 * 6144 + i];
        MOD[i] = a; }
}

constexpr int NPL = 8;
constexpr int NSTEPS = 3 + DEPTH * NPL;

__device__ __forceinline__ void run_step(const P& p, int s, int bid, int nb, unsigned char* lds) {
    bf16_t* HX = (bf16_t*)(p.ws + WS_HX); bf16_t* PROJ = (bf16_t*)(p.ws + WS_PROJ); bf16_t* LA = (bf16_t*)(p.ws + WS_LA); bf16_t* ATT = (bf16_t*)(p.ws + WS_ATT);
    bf16_t* MIX = (bf16_t*)(p.ws + WS_MIX); bf16_t* PQ = (bf16_t*)(p.ws + WS_PQ); float* X = (float*)(p.ws + WS_X); const float* MOD = (const float*)(p.ws + WS_MOD);
    PG8_LAS unsigned char* glds = (PG8_LAS unsigned char*)lds;
    if (s == 0) { ph_prologue(p, bid, nb, lds);
#if PROBE_CAT == 11
        for (int r2 = 0; r2 < PROBE_N; ++r2) { __syncthreads(); ph_prologue(p, bid, nb, lds); }
#endif
        return; }
    if (s == 1) { ph_modfin(p, bid, nb); return; }
    if (s == 2) { ph_norm(p, bid, nb, p.norm1_g, 0, 0, 1, MT, HX, true); return; }
    const int li = (s - 3) / NPL, ph = (s - 3) % NPL; const bool do_ctx = li < DEPTH - 1; const int Mr = do_ctx ? MT : ML;
    const int extra = (PROBE_CAT != 0 && ph + 1 == PROBE_CAT) ? PROBE_N : 0;
    for (int rep = 0; rep <= extra; ++rep) { const bool dry = rep < extra;
    float* Xo = dry ? (float*)(p.ws + WS_HF) : X;
    switch (ph) {
    case 0: {
        pg8::Gemm g{HX, (const bf16_t*)(p.ws + WS_WIN_T) + (size_t)li * DIN * D, MT, DIN, D}; pg8::StaticOrder S; S.init(MT, DIN, nb, bid);
        pg8::EpiIn E{PROJ, (const float*)(p.ws + WS_ROPE)};
        pg8::gemm_phase<pg8::EpiIn, pg8::StaticOrder, true, true>(glds, g, S, E);
    } break;
    case 1: ph_lru(p, li, bid, nb, lds);
        ph_peer_tables(p, li, bid, nb);
#if PROBE_CAT == 10
        for (int r2 = 0; r2 < PROBE_N; ++r2) ph_lru(p, li, bid, nb, lds);
#endif
        ph_attn(p, li, do_ctx, bid, nb, lds);
#if PROBE_CAT == 9
        for (int r2 = 0; r2 < PROBE_N; ++r2) ph_attn(p, li, do_ctx, bid, nb, lds);
#endif
        break;
    case 2: {
        { pg8::Gemm g{LA, (const bf16_t*)(p.ws + WS_WBL_T) + (size_t)li * D * D, Mr, D, D}; pg8::StaticOrder S; S.init(Mr, D, nb, bid);
          pg8::EpiBr<false> E{PROJ, MIX, C_GA}; pg8::gemm_phase<pg8::EpiBr<false>, pg8::StaticOrder, true, true>(glds, g, S, E); }
        { pg8::Gemm g{ATT, (const bf16_t*)(p.ws + WS_WBA_T) + (size_t)li * D * D, Mr, D, D}; pg8::StaticOrder S; S.init(Mr, D, nb, bid);
          pg8::EpiBr<true> E{PROJ, MIX, C_GB}; pg8::gemm_phase<pg8::EpiBr<true>, pg8::StaticOrder, true, true>(glds, g, S, E); }
    } break;
    case 3: {
        pg8::Gemm g{MIX, (const bf16_t*)(p.ws + WS_WOUT_T) + (size_t)li * D * D, Mr, D, D}; pg8::StaticOrder S; S.init(Mr, D, nb, bid);
        pg8::EpiOut E{li == 0 ? p.x : X, li == 0 ? p.ctx - (size_t)ML * D : X, Xo, MOD + (size_t)li * 9 * 6144 + 2 * 1024};   pg8::gemm_phase<pg8::EpiOut, pg8::StaticOrder, true, true>(glds, g, S, E);
    } break;
    case 4: ph_norm(p, bid, nb, p.norm2_g + li * D, li, 3, 4, Mr, HX, false); break;
    case 5: {
        pg8::Gemm g{HX, (const bf16_t*)(p.ws + WS_WQ_T) + (size_t)li * D * D, Mr, D, D}; pg8::StaticOrder S; S.init(Mr, D, nb, bid);
        pg8::EpiPlain E{PQ}; pg8::gemm_phase<pg8::EpiPlain, pg8::StaticOrder, true, true>(glds, g, S, E);
    } break;
    case 6: ph_peer_score(p, li, Mr, bid, nb); break;
    case 7: ph_peer_expert(p, li, Mr, bid, nb, dry); break;
    }
    }
}

constexpr int RING_BYTES = 155648, LDSCTL_OFF = RING_BYTES, MISC_OFF = LDSCTL_OFF + 320, LDS_BYTES = RING_BYTES + 1024;
constexpr int CW_BAR = 4096;
#ifndef N_LAUNCH_MODE
#define N_LAUNCH_MODE 1
#endif

__global__ void __launch_bounds__(NTHREADS, 2) mega(P p) {
    extern __shared__ __attribute__((aligned(16))) unsigned char lds[];
    const int tid = threadIdx.x;
    for (int u = tid; u < (LDS_BYTES - LDSCTL_OFF) / 4; u += NTHREADS) ((LAS unsigned*)((LAS unsigned char*)lds + LDSCTL_OFF))[u] = 0u;
    __syncthreads();
    volatile LAS unsigned* MISC = (volatile LAS unsigned*)((LAS unsigned char*)lds + MISC_OFF);
    XcdBarrier bar = xcd_barrier_post((unsigned*)(p.ws + WS_CTL) + CW_BAR, MISC + 8);
    const int bid = blockIdx.x, nb = gridDim.x;
    for (int s = p.lo; s < p.hi; ++s) {
        P q = p; int bido = bid, nbo = nb;
        asm volatile("" : "+s"(bido), "+s"(nbo));
        run_step(q, s, bido, nbo, lds);
        if (s + 1 < p.hi) xcd_barrier(bar);
#if PROBE_CAT == 12
        for (int r2 = 0; r2 < PROBE_N; ++r2) xcd_barrier(bar);
#endif
    }
}

extern "C" void kernel_launch(void* const* d_in, const int* in_sizes, int n_in, void* d_out, int out_size, void* d_ws, size_t ws_size, hipStream_t stream) {
    static int grid = 0;
    if (grid == 0) {
        if (n_in != 24 || ws_size < WS_END) { fprintf(stderr, "kernel_launch: n_in %d ws %zu need %zu\n", n_in, ws_size, (size_t)WS_END); grid = -1; return; }
        int dev = 0, cus = 0, per_cu = 0;
        if (hipGetDevice(&dev) != hipSuccess || hipDeviceGetAttribute(&cus, hipDeviceAttributeMultiprocessorCount, dev) != hipSuccess) { grid = -1; return; }
        if (hipFuncSetAttribute((const void*)mega, hipFuncAttributeMaxDynamicSharedMemorySize, LDS_BYTES) != hipSuccess) { fprintf(stderr, "kernel_launch: hipFuncSetAttribute failed\n"); grid = -1; return; }
        if (hipOccupancyMaxActiveBlocksPerMultiprocessor(&per_cu, (const void*)mega, NTHREADS, LDS_BYTES) != hipSuccess || per_cu < 1) { fprintf(stderr, "kernel_launch: occupancy query says %d\n", per_cu); per_cu = 1; }
        (void)hipGetLastError();
        grid = cus > 256 ? 256 : cus;
    }
    if (grid < 0) return;
    (void)hipMemsetAsync((char*)d_ws + WS_CTL, 0, CTL_ZERO_BYTES, stream);
    P p{};
    const float** pp = (const float**)&p;
    for (int i = 0; i < 24; ++i) pp[i] = (const float*)d_in[i];
    p.out = (float*)d_out; p.ws = (unsigned char*)d_ws;
#if N_LAUNCH_MODE == 1
    p.lo = 0; p.hi = NSTEPS; hipLaunchKernelGGL(mega, dim3(grid), dim3(NTHREADS), LDS_BYTES, stream, p);
#else
    for (int s = 0; s < NSTEPS; ++s) { p.lo = s; p.hi = s + 1; hipLaunchKernelGGL(mega, dim3(grid), dim3(NTHREADS), LDS_BYTES, stream, p); }
#endif
}
```

```cpp
#include <hip/hip_runtime.h>
#include <cstdio>
#include <cstdint>

#ifndef PROBE_CAT
#define PROBE_CAT 0
#endif
#ifndef PROBE_N
#define PROBE_N 1
#endif
#define PEER_DBG_SIMPLE_REDUCE 0
#define PEER_DBG_NAIVE_EPI 0
#ifndef OPT_LRU
#define OPT_LRU 1
#endif
constexpr int D = 1024, NBATCH = 8, SEQ = 2048, CTXL = 256, DEPTH = 4;
constexpr int ML = NBATCH * SEQ, MC = NBATCH * CTXL, MT = ML + MC;
constexpr int DIN = 7168;
constexpr int C_U = 0, C_GL = 1024, C_Q = 2048, C_K = 3072, C_V = 4096, C_GA = 5120, C_GB = 6144;
constexpr float EPS = 1e-6f;
constexpr int NTHREADS = 512, NWAVES = 8;

typedef unsigned short bf16_t;
__device__ __forceinline__ float bf2f(bf16_t v) { return __uint_as_float(((unsigned)v) << 16); }
__device__ __forceinline__ unsigned pk2(float lo, float hi) { unsigned r; asm("v_cvt_pk_bf16_f32 %0, %1, %2" : "=v"(r) : "v"(lo), "v"(hi)); return r; }
__device__ __forceinline__ bf16_t f2bf(float f) { return (bf16_t)(pk2(f, f) & 0xffffu); }
__device__ __forceinline__ float sigmoidf_(float x) { return 1.f / (1.f + __expf(-x)); }
__device__ __forceinline__ float gelu_tanh(float x) { const float u = 0.7978845608028654f * (x + 0.044715f * x * x * x); return 0.5f * x * (1.f + tanhf(u)); }
__device__ __forceinline__ float siluf_(float x) { return x / (1.f + expf(-x)); }

constexpr size_t MiB = 1u << 20;
constexpr size_t WS_CTL = 0, CTL_ZERO_BYTES = 1 * MiB;
constexpr size_t WS_X = 1 * MiB;
constexpr size_t WS_HX = WS_X + (size_t)MT * D * 4;
constexpr size_t WS_PROJ = WS_HX + (size_t)MT * D * 2;
constexpr size_t WS_LA = WS_PROJ + (size_t)MT * DIN * 2;
constexpr size_t WS_ATT = WS_LA + (size_t)MT * D * 2;
constexpr size_t WS_MIX = WS_ATT + (size_t)MT * D * 2;
constexpr size_t WS_IDX = WS_MIX + (size_t)MT * D * 2;
constexpr size_t WS_G = WS_IDX + (size_t)MT * 128 * 4;
constexpr size_t WS_MOD = WS_G + (size_t)MT * 128 * 4;
constexpr size_t WS_ROPE = WS_MOD + (size_t)4 * 9 * 6144 * 4;
constexpr size_t WS_LAM = WS_ROPE + (size_t)2048 * 32 * 2 * 4;
constexpr size_t WS_MODP = WS_LAM + 256;
constexpr size_t WS_WIN_T = WS_MODP + (size_t)8 * 4 * 9 * 6144 * 4;
constexpr size_t WS_WBL_T = WS_WIN_T + (size_t)4 * DIN * D * 2;
constexpr size_t WS_WBA_T = WS_WBL_T + (size_t)4 * D * D * 2;
constexpr size_t WS_WOUT_T = WS_WBA_T + (size_t)4 * D * D * 2;
constexpr size_t WS_WQ_T = WS_WOUT_T + (size_t)4 * D * D * 2;
constexpr size_t WS_STASH = WS_WQ_T + (size_t)4 * D * D * 2;
constexpr size_t WS_KEYS = WS_STASH + (size_t)256 * 8 * 64 * 64 * 4;
constexpr size_t WS_PU = WS_KEYS + (size_t)4 * 16 * 128 * 64 * 2;
constexpr size_t WS_PV = WS_PU + (size_t)16384 * 1024;
constexpr size_t WS_SU = WS_PV + (size_t)16384 * 1024;
constexpr size_t WS_SV = WS_SU + (size_t)16384 * 4;
constexpr size_t WS_HF = WS_SV + (size_t)16384 * 4;
constexpr size_t WS_UC = WS_HF;
constexpr size_t WS_HD = WS_UC + (size_t)MT * D * 4;
#if OPT_LRU
constexpr size_t WS_END = WS_HF + (size_t)MT * D * 4;
#else
constexpr size_t WS_END = WS_HD + (size_t)2 * MT * D * 4;
#endif
#define WS_PQ WS_LA

struct P {
    const float *x, *c, *ctx, *c_ctx, *mod_w, *mod_b, *norm1_g, *norm2_g, *w_in, *conv_w, *conv_b, *lru_w, *lru_b, *lru_lam, *diff_lam, *subln_g,
        *w_br_lru, *w_br_attn, *w_out, *peer_wq, *peer_keys, *peer_u, *peer_v, *final_g;
    float* out; unsigned char* ws; int lo, hi;
};

__device__ __forceinline__ int otid() { int t = threadIdx.x; asm volatile("" : "+v"(t)); return t; }
__device__ __forceinline__ int row_mod_idx(int row) { return row < ML ? (row >> 11) : 8; }
__device__ __forceinline__ float lambda_init_of(int li) { return 0.8f - 0.6f * expf(-0.3f * (float)li); }

namespace pg8 {
#define PG8_LAS __attribute__((address_space(3)))
typedef unsigned short bf16_t;
typedef short bf16x8 __attribute__((ext_vector_type(8)));
typedef float f32x4 __attribute__((ext_vector_type(4)));
typedef unsigned u32x4 __attribute__((ext_vector_type(4)));
constexpr int BM = 256, BK = 64, HALF = 128, HTB = HALF * BK * 2  , STAGE_BYTES = 8 * HTB, NXCD = 8, WGM = 8;

__host__ __device__ __forceinline__ int lds_byte(int r, int c) { const int st = (r >> 4) * 2 + (c >> 5), rr = r & 15, cc = c & 31, ob = rr * 64 + cc * 2; return st * 1024 + (ob ^ (((ob >> 9) & 1) << 5)); }
__host__ __device__ __forceinline__ void stage_rc(int b, int& R, int& C) { const int st = b / 1024, sb = b % 1024, swz = sb ^ (((sb >> 9) & 1) << 5); R = (st >> 1) * 16 + swz / 64; C = (st & 1) * 32 + (swz % 64) / 2; }
__host__ __device__ __forceinline__ int perm32(int rho) { const int n = rho >> 4, i = rho & 15; return 8 * (i >> 2) + 4 * n + (i & 3); }

struct Unit { int pm, pn; };
struct Gemm { const bf16_t* A; const bf16_t* Bt; int M, N, K; };

struct StaticOrder {
    int nM, nN, nwg, G, c;
    __host__ __device__ void init(int M, int N, int G_, int c_) { nM = M / BM; nN = N / BM; nwg = nM * nN; G = G_; c = c_; }
    __host__ __device__ bool next(int i, Unit& u) const {
        const long L = (long)i * G + c; if (L >= nwg) return false;
        int wgid = (int)L; { const int q = nwg / NXCD, r = nwg % NXCD, xcd = wgid % NXCD, off = wgid / NXCD; wgid = (xcd < r ? xcd * (q + 1) : r * (q + 1) + (xcd - r) * q) + off; }
        const int nig = WGM * nN, gid = wgid / nig, fm = gid * WGM, gsz = (nM - fm) < WGM ? (nM - fm) : WGM;
        u.pm = fm + ((wgid % nig) % gsz); u.pn = (wgid % nig) / gsz; return true;
    }
    __device__ __forceinline__ void a_ready(const Unit&) const {}
    __device__ __forceinline__ void done(const Unit&) const {}
};

__device__ __forceinline__ unsigned cvt_pk_bf16(float lo, float hi) { unsigned r; asm volatile("v_cvt_pk_bf16_f32 %0, %1, %2" : "=v"(r) : "v"(lo), "v"(hi)); return r; }
typedef float f32x2 __attribute__((ext_vector_type(2)));
__device__ __forceinline__ f32x2 gelu_pk(f32x2 v) {
    const f32x2 av = __builtin_elementwise_abs(v), d = av * 0.2316418882f + 1.0f;
    f32x2 t; t.x = __builtin_amdgcn_rcpf(d.x); t.y = __builtin_amdgcn_rcpf(d.y);
    f32x2 q = t * 0.5307027145f + (-0.7265760135f); q = q * t + 0.7107068705f; q = q * t + (-0.142248368f); q = q * t + 0.127414796f; q = q * t;
    const f32x2 s = (v * v) * (-0.72134752044f);
    f32x2 e; e.x = __builtin_amdgcn_exp2f(s.x); e.y = __builtin_amdgcn_exp2f(s.y);
    const f32x2 m = v * (q * e), r = v - m;
    f32x2 o; o.x = v.x < 0.f ? m.x : r.x; o.y = v.y < 0.f ? m.y : r.y; return o;
}

template <int ACT  > struct EpiBf16 {
    static constexpr bool PERM = true, AFTER_DRAIN = false; static_assert(ACT == 0 || ACT == 1, "EpiBf16: ACT is 0 (none) or 1 (gelu_pk)");
    bf16_t* O; int ldc; const float* bias; int split_cols; size_t split_stride; float scale0;
    __device__ __forceinline__ void operator()(const f32x4 (&acc)[2][2][4][2], const Unit& u, int wr, int wc, int fr, int fq) const {
        const int row0 = u.pm * BM + wr * 64 + fr; int colt = u.pn * BM; bf16_t* base = O;
        float sc = 1.f; if (split_cols) { const int t = colt / split_cols; base += (size_t)t * split_stride; colt -= t * split_cols; if (t == 0) sc = scale0; }
        const int col0 = colt + wc * 32 + 8 * fq, bcol0 = u.pn * BM + wc * 32 + 8 * fq;
        f32x4 bv[2][2];
#pragma unroll
        for (int bj = 0; bj < 2; ++bj)
#pragma unroll
            for (int n = 0; n < 2; ++n) bv[bj][n] = bias ? *(const f32x4*)(bias + bcol0 + bj * HALF + 4 * n) : (f32x4){0.f, 0.f, 0.f, 0.f};
#pragma unroll
        for (int ai = 0; ai < 2; ++ai)
#pragma unroll
            for (int m = 0; m < 4; ++m) { bf16_t* rowp = base + (size_t)(row0 + ai * HALF + m * 16) * ldc + col0;
#pragma unroll
                for (int bj = 0; bj < 2; ++bj) { f32x4 v0 = acc[ai][bj][m][0] + bv[bj][0], v1 = acc[ai][bj][m][1] + bv[bj][1];
                    if (ACT == 1) { f32x2 a = gelu_pk((f32x2){v0[0], v0[1]}), b = gelu_pk((f32x2){v0[2], v0[3]}), c = gelu_pk((f32x2){v1[0], v1[1]}), d = gelu_pk((f32x2){v1[2], v1[3]});
                        v0 = (f32x4){a.x, a.y, b.x, b.y}; v1 = (f32x4){c.x, c.y, d.x, d.y}; }
                    v0 = v0 * sc; v1 = v1 * sc; u32x4 w; w.x = cvt_pk_bf16(v0[0], v0[1]); w.y = cvt_pk_bf16(v0[2], v0[3]); w.z = cvt_pk_bf16(v1[0], v1[1]); w.w = cvt_pk_bf16(v1[2], v1[3]);
                    *(u32x4*)(rowp + bj * HALF) = w; } }
    }
};
__device__ __forceinline__ float bflo(unsigned w) { return __uint_as_float(w << 16); }
__device__ __forceinline__ float bfhi(unsigned w) { return __uint_as_float(w & 0xffff0000u); }
__device__ __forceinline__ float sigm(float x) { return 1.f / (1.f + __expf(-x)); }

struct EpiIn {
    static constexpr bool PERM = true, AFTER_DRAIN = false;
    bf16_t* O; const float* rope;
    __device__ __forceinline__ void operator()(const f32x4 (&acc)[2][2][4][2], const Unit& u, int wr, int wc, int fr, int fq) const {
        const int row0 = u.pm * BM + wr * 64 + fr, col0 = u.pn * BM + wc * 32 + 8 * fq;
        const bool dorope = (u.pn >= 8) && (u.pn < 16) && (u.pm < 64);
        const int i0 = ((wc & 1) << 4) + 4 * fq;
#pragma unroll
        for (int ai = 0; ai < 2; ++ai)
#pragma unroll
            for (int m = 0; m < 4; ++m) { const int row = row0 + ai * HALF + m * 16; bf16_t* rowp = O + (size_t)row * DIN + col0;
                f32x4 r0 = {1.f, 0.f, 1.f, 0.f}, r1 = {1.f, 0.f, 1.f, 0.f};
                if (dorope) { const f32x4* rp = (const f32x4*)(rope + ((size_t)(row & 2047) * 32 + i0) * 2); r0 = rp[0]; r1 = rp[1]; }
#pragma unroll
                for (int bj = 0; bj < 2; ++bj) { f32x4 v0 = acc[ai][bj][m][0], v1 = acc[ai][bj][m][1];
                    if (dorope) { f32x4 a, b;
                        a[0] = v0[0] * r0[0] - v0[1] * r0[1]; a[1] = v0[1] * r0[0] + v0[0] * r0[1]; a[2] = v0[2] * r0[2] - v0[3] * r0[3]; a[3] = v0[3] * r0[2] + v0[2] * r0[3];
                        b[0] = v1[0] * r1[0] - v1[1] * r1[1]; b[1] = v1[1] * r1[0] + v1[0] * r1[1]; b[2] = v1[2] * r1[2] - v1[3] * r1[3]; b[3] = v1[3] * r1[2] + v1[2] * r1[3];
                        v0 = a; v1 = b; }
                    u32x4 w; w.x = cvt_pk_bf16(v0[0], v0[1]); w.y = cvt_pk_bf16(v0[2], v0[3]); w.z = cvt_pk_bf16(v1[0], v1[1]); w.w = cvt_pk_bf16(v1[2], v1[3]);
                    *(u32x4*)(rowp + bj * HALF) = w; } }
    }
};
struct EpiPlain {
    static constexpr bool PERM = true, AFTER_DRAIN = false;
    bf16_t* O;
    __device__ __forceinline__ void operator()(const f32x4 (&acc)[2][2][4][2], const Unit& u, int wr, int wc, int fr, int fq) const {
        const int row0 = u.pm * BM + wr * 64 + fr, col0 = u.pn * BM + wc * 32 + 8 * fq;
#pragma unroll
        for (int ai = 0; ai < 2; ++ai)
#pragma unroll
            for (int m = 0; m < 4; ++m) { bf16_t* rowp = O + (size_t)(row0 + ai * HALF + m * 16) * D + col0;
#pragma unroll
                for (int bj = 0; bj < 2; ++bj) { const f32x4 v0 = acc[ai][bj][m][0], v1 = acc[ai][bj][m][1];
                    u32x4 w; w.x = cvt_pk_bf16(v0[0], v0[1]); w.y = cvt_pk_bf16(v0[2], v0[3]); w.z = cvt_pk_bf16(v1[0], v1[1]); w.w = cvt_pk_bf16(v1[2], v1[3]);
                    *(u32x4*)(rowp + bj * HALF) = w; } }
    }
};
template <bool ADD> struct EpiBr {
    static constexpr bool PERM = true, AFTER_DRAIN = false;
    const bf16_t* PROJ; bf16_t* MIX; int gcol;
    __device__ __forceinline__ void operator()(const f32x4 (&acc)[2][2][4][2], const Unit& u, int wr, int wc, int fr, int fq) const {
        const int row0 = u.pm * BM + wr * 64 + fr, col0 = u.pn * BM + wc * 32 + 8 * fq;
#pragma unroll
        for (int ai = 0; ai < 2; ++ai)
#pragma unroll
            for (int m = 0; m < 4; ++m) { const int row = row0 + ai * HALF + m * 16; bf16_t* rowp = MIX + (size_t)row * D + col0; const bf16_t* gp = PROJ + (size_t)row * DIN + gcol + col0;
#pragma unroll
                for (int bj = 0; bj < 2; ++bj) { const f32x4 v0 = acc[ai][bj][m][0], v1 = acc[ai][bj][m][1]; const u32x4 g = *(const u32x4*)(gp + bj * HALF);
                    float o[8] = {sigm(bflo(g.x)) * v0[0], sigm(bfhi(g.x)) * v0[1], sigm(bflo(g.y)) * v0[2], sigm(bfhi(g.y)) * v0[3], sigm(bflo(g.z)) * v1[0], sigm(bfhi(g.z)) * v1[1], sigm(bflo(g.w)) * v1[2], sigm(bfhi(g.w)) * v1[3]};
                    if (ADD) { const u32x4 q = *(const u32x4*)(rowp + bj * HALF); o[0] += bflo(q.x); o[1] += bfhi(q.x); o[2] += bflo(q.y); o[3] += bfhi(q.y); o[4] += bflo(q.z); o[5] += bfhi(q.z); o[6] += bflo(q.w); o[7] += bfhi(q.w); }
                    u32x4 w; w.x = cvt_pk_bf16(o[0], o[1]); w.y = cvt_pk_bf16(o[2], o[3]); w.z = cvt_pk_bf16(o[4], o[5]); w.w = cvt_pk_bf16(o[6], o[7]);
                    *(u32x4*)(rowp + bj * HALF) = w; } }
    }
};
struct EpiOut {
    static constexpr bool PERM = true, AFTER_DRAIN = false;
    const float* Xlat; const float* Xctx; float* Xo; const float* MODL;
    __device__ __forceinline__ void operator()(const f32x4 (&acc)[2][2][4][2], const Unit& u, int wr, int wc, int fr, int fq) const {
        const int row0 = u.pm * BM + wr * 64 + fr, col0 = u.pn * BM + wc * 32 + 8 * fq;
        const float* g1 = MODL + (size_t)(u.pm < 64 ? (u.pm >> 3) : 8) * 6144 + col0;
        f32x4 gv[2][2];
#pragma unroll
        for (int bj = 0; bj < 2; ++bj) { gv[bj][0] = *(const f32x4*)(g1 + bj * HALF); gv[bj][1] = *(const f32x4*)(g1 + bj * HALF + 4); }
#pragma unroll
        for (int ai = 0; ai < 2; ++ai)
#pragma unroll
            for (int m = 0; m < 4; ++m) { const size_t ro = (size_t)(row0 + ai * HALF + m * 16) * D + col0; const float* rowp = (u.pm < 64 ? Xlat : Xctx) + ro; float* rowo = Xo + ro;
#pragma unroll
                for (int bj = 0; bj < 2; ++bj) { const f32x4* xp = (const f32x4*)(rowp + bj * HALF); f32x4* xo = (f32x4*)(rowo + bj * HALF); f32x4 x0 = xp[0], x1 = xp[1];
                    x0 += gv[bj][0] * acc[ai][bj][m][0]; x1 += gv[bj][1] * acc[ai][bj][m][1]; xo[0] = x0; xo[1] = x1; } }
    }
};
template <class Epi, class Sched, bool ALIGN_EPI = false, bool SP2 = false>
__device__ __forceinline__ void gemm_phase(PG8_LAS unsigned char* lds, const Gemm g, const Sched& S, const Epi& E) {
    const int tid = otid(), wid = __builtin_amdgcn_readfirstlane(tid >> 6), lane = tid & 63, wr = wid >> 2, wc = wid & 3, fr = lane & 15, fq = lane >> 4;
    const int K = g.K, nt = K / BK;
    unsigned voffA[2], voffB[2];
#pragma unroll
    for (int i = 0; i < 2; ++i) { int R, C; stage_rc(tid * 16 + i * 8192, R, C); const int Rb = Epi::PERM ? ((R & ~31) + perm32(R & 31)) : R;
        voffA[i] = (unsigned)(R * K + C) * 2u; voffB[i] = (unsigned)(Rb * K + C) * 2u; }
    const size_t kstep = (size_t)(BK * 2);
    const size_t hstep = (size_t)HALF * K * 2;
    const size_t tstep = 2 * hstep;
    const unsigned ldsw = (unsigned)wid * 1024u;
    const int aoff = lds_byte(wr * 64 + fr, fq * 8), boff = lds_byte(wc * 32 + fr, fq * 8);
#define PG8_SA(b, h) (((b) * 2 + (h)) * HTB)
#define PG8_SB(b, h) ((4 + (b) * 2 + (h)) * HTB)
#define PG8_STAGE(bufoff, gbase, voff) do { _Pragma("unroll") for (int _i = 0; _i < 2; ++_i) \
        __builtin_amdgcn_global_load_lds((const unsigned*)((const char*)(gbase) + (voff)[_i]), (PG8_LAS unsigned*)(lds + (bufoff) + ldsw + _i * 8192), 16, 0, 0); } while (0)
#define PG8_LDA(dst, b, h) do { _Pragma("unroll") for (int m = 0; m < 4; ++m) _Pragma("unroll") for (int k = 0; k < 2; ++k) dst[m][k] = *(const PG8_LAS bf16x8*)(lds + PG8_SA(b, h) + aoff + m * 2048 + k * 1024); } while (0)
#define PG8_LDB(dst, b, h) do { _Pragma("unroll") for (int n = 0; n < 2; ++n) _Pragma("unroll") for (int k = 0; k < 2; ++k) dst[n][k] = *(const PG8_LAS bf16x8*)(lds + PG8_SB(b, h) + boff + n * 2048 + k * 1024); } while (0)
#define PG8_MMA(ai, bj, At, Bt) do { __builtin_amdgcn_s_setprio(1); _Pragma("unroll") for (int m = 0; m < 4; ++m) _Pragma("unroll") for (int n = 0; n < 2; ++n) _Pragma("unroll") for (int k = 0; k < 2; ++k) \
        acc[ai][bj][m][n] = __builtin_amdgcn_mfma_f32_16x16x32_bf16(Bt[n][k], At[m][k], acc[ai][bj][m][n], 0, 0, 0); __builtin_amdgcn_s_setprio(0); } while (0)
#define PG8_WAIT_V(n) asm volatile("s_waitcnt vmcnt(" #n ")" ::: "memory")
#define PG8_WAIT_L(n) asm volatile("s_waitcnt lgkmcnt(" #n ")" ::: "memory")
#define PG8_BAR __builtin_amdgcn_s_barrier()
#define PG8_SCHED __builtin_amdgcn_sched_barrier(0)
    Unit cur, nxt; int ui = 0;
    if (!S.next(0, cur)) return;
    f32x4 acc[2][2][4][2];
#pragma unroll
    for (int a = 0; a < 2; ++a)
#pragma unroll
        for (int b = 0; b < 2; ++b)
#pragma unroll
            for (int m = 0; m < 4; ++m)
#pragma unroll
                for (int n = 0; n < 2; ++n) acc[a][b][m][n] = (f32x4){0.f, 0.f, 0.f, 0.f};
    bf16x8 At[4][2], B0[2][2], B1[2][2];
    const char* cA = (const char*)g.A + (size_t)cur.pm * tstep; const char* cB = (const char*)g.Bt + (size_t)cur.pn * tstep;
    S.a_ready(cur);
    if constexpr (SP2) {
        PG8_STAGE(PG8_SB(0, 0), cB, voffB); PG8_STAGE(PG8_SB(0, 1), cB + hstep, voffB); PG8_STAGE(PG8_SA(0, 0), cA, voffA); PG8_STAGE(PG8_SA(0, 1), cA + hstep, voffA);
        if (wr == 1) PG8_BAR;
        PG8_WAIT_V(2); PG8_BAR;
        PG8_STAGE(PG8_SB(1, 0), cB + kstep, voffB); PG8_STAGE(PG8_SA(1, 0), cA + kstep, voffA); PG8_STAGE(PG8_SB(1, 1), cB + hstep + kstep, voffB);
        PG8_WAIT_V(6); PG8_BAR;
    } else {
        PG8_STAGE(PG8_SB(0, 0), cB, voffB); PG8_STAGE(PG8_SA(0, 0), cA, voffA); PG8_STAGE(PG8_SB(0, 1), cB + hstep, voffB); PG8_STAGE(PG8_SA(0, 1), cA + hstep, voffA);
        if (wr == 1) PG8_BAR;
        PG8_WAIT_V(4); PG8_BAR;
        PG8_STAGE(PG8_SB(1, 0), cB + kstep, voffB); PG8_STAGE(PG8_SA(1, 0), cA + kstep, voffA); PG8_STAGE(PG8_SB(1, 1), cB + hstep + kstep, voffB);
        PG8_WAIT_V(6); PG8_BAR;
    }
    for (;;) {
        const bool has_next = S.next(ui + 1, nxt);
        const char* nA = has_next ? (const char*)g.A + (size_t)nxt.pm * tstep : cA; const char* nB = has_next ? (const char*)g.Bt + (size_t)nxt.pn * tstep : cB;
        for (int t = 0; t < nt; t += 2) {
            const bool last = (t == nt - 2);
            const char* a1 = cA + (size_t)(t + 1) * kstep;
            const char* a2 = last ? nA : cA + (size_t)(t + 2) * kstep; const char* b2 = last ? nB : cB + (size_t)(t + 2) * kstep;
            const char* a3 = a2 + kstep; const char* b3 = b2 + kstep;
            if (last && has_next) S.a_ready(nxt);
            if constexpr (SP2) {
            PG8_LDB(B0, 0, 0); PG8_LDB(B1, 0, 1); PG8_SCHED; PG8_LDA(At, 0, 0); PG8_STAGE(PG8_SA(1, 1), a1 + hstep, voffA);
            PG8_WAIT_V(8); PG8_WAIT_L(0); PG8_BAR; PG8_MMA(0, 0, At, B0); PG8_MMA(0, 1, At, B1); PG8_BAR; PG8_SCHED;
            PG8_LDA(At, 0, 1); PG8_STAGE(PG8_SB(0, 0), b2, voffB); PG8_STAGE(PG8_SB(0, 1), b2 + hstep, voffB); PG8_STAGE(PG8_SA(0, 0), a2, voffA);
            PG8_WAIT_V(8); PG8_WAIT_L(0); PG8_BAR; PG8_MMA(1, 0, At, B0); PG8_MMA(1, 1, At, B1); PG8_BAR; PG8_SCHED;
            PG8_LDB(B0, 1, 0); PG8_LDB(B1, 1, 1); PG8_SCHED; PG8_LDA(At, 1, 0); PG8_STAGE(PG8_SA(0, 1), a2 + hstep, voffA);
            PG8_WAIT_V(8); PG8_WAIT_L(0); PG8_BAR; PG8_MMA(0, 0, At, B0); PG8_MMA(0, 1, At, B1); PG8_BAR; PG8_SCHED;
            PG8_LDA(At, 1, 1); PG8_STAGE(PG8_SB(1, 0), b3, voffB); PG8_STAGE(PG8_SB(1, 1), b3 + hstep, voffB); PG8_STAGE(PG8_SA(1, 0), a3, voffA);
            PG8_WAIT_V(8); PG8_WAIT_L(0); PG8_BAR; PG8_MMA(1, 0, At, B0); PG8_MMA(1, 1, At, B1); PG8_BAR; PG8_SCHED;
            } else {
            PG8_LDB(B0, 0, 0); PG8_SCHED; PG8_LDA(At, 0, 0); PG8_STAGE(PG8_SA(1, 1), a1 + hstep, voffA);
            PG8_WAIT_L(8); PG8_BAR; PG8_WAIT_L(0); PG8_MMA(0, 0, At, B0); PG8_BAR; PG8_SCHED;
            PG8_LDB(B1, 0, 1); PG8_STAGE(PG8_SB(0, 0), b2, voffB);
            PG8_BAR; PG8_WAIT_L(0); PG8_MMA(0, 1, At, B1); PG8_BAR;
            PG8_LDA(At, 0, 1); PG8_STAGE(PG8_SA(0, 0), a2, voffA);
            PG8_BAR; PG8_WAIT_L(0); PG8_MMA(1, 0, At, B0); PG8_BAR; PG8_SCHED;
            PG8_STAGE(PG8_SB(0, 1), b2 + hstep, voffB);
            PG8_WAIT_V(6); PG8_BAR; PG8_MMA(1, 1, At, B1); PG8_BAR;
            PG8_LDB(B0, 1, 0); PG8_SCHED; PG8_LDA(At, 1, 0); PG8_STAGE(PG8_SA(0, 1), a2 + hstep, voffA);
            PG8_WAIT_L(8); PG8_BAR; PG8_WAIT_L(0); PG8_MMA(0, 0, At, B0); PG8_BAR; PG8_SCHED;
            PG8_LDB(B1, 1, 1); PG8_STAGE(PG8_SB(1, 0), b3, voffB);
            PG8_BAR; PG8_WAIT_L(0); PG8_MMA(0, 1, At, B1); PG8_BAR;
            PG8_LDA(At, 1, 1); PG8_STAGE(PG8_SA(1, 0), a3, voffA);
            PG8_BAR; PG8_WAIT_L(0); PG8_MMA(1, 0, At, B0); PG8_BAR; PG8_SCHED;
            PG8_STAGE(PG8_SB(1, 1), b3 + hstep, voffB);
            PG8_WAIT_V(6); PG8_BAR; PG8_MMA(1, 1, At, B1); PG8_BAR;
            }
        }
        if constexpr (ALIGN_EPI) { if (wr == 0) PG8_BAR; }
        if constexpr (!Epi::AFTER_DRAIN) { E(acc, cur, wr, wc, fr, fq); S.done(cur); }
        if (!has_next) break;
#pragma unroll
        for (int a = 0; a < 2; ++a)
#pragma unroll
            for (int b = 0; b < 2; ++b)
#pragma unroll
                for (int m = 0; m < 4; ++m)
#pragma unroll
                    for (int n = 0; n < 2; ++n) acc[a][b][m][n] = (f32x4){0.f, 0.f, 0.f, 0.f};
        cur = nxt; cA = nA; cB = nB; ++ui;
        if constexpr (ALIGN_EPI) { if (wr == 1) PG8_BAR; }
    }
    PG8_WAIT_V(0);
    if constexpr (!ALIGN_EPI) { if (wr == 0) PG8_BAR; }
    PG8_BAR;
    if constexpr (Epi::AFTER_DRAIN) { E.fused(acc, cur, wr, wc, fr, fq, lds, wid, lane); S.done(cur); }
#undef PG8_SA
#undef PG8_SB
#undef PG8_STAGE
#undef PG8_LDA
#undef PG8_LDB
#undef PG8_MMA
#undef PG8_WAIT_V
#undef PG8_WAIT_L
#undef PG8_BAR
#undef PG8_SCHED
}
}

#define GAS __attribute__((address_space(1)))
#define LAS __attribute__((address_space(3)))
typedef unsigned v4u __attribute__((ext_vector_type(4)));
typedef GAS unsigned gu32;
#define RLX_AGENT __ATOMIC_RELAXED, __HIP_MEMORY_SCOPE_AGENT
#define LDS_WAIT() asm volatile("s_waitcnt lgkmcnt(0)" ::: "memory")
#define XB_TMO      128
#define XB_XCNT(j)  (256  + 64 * (j))
#define XB_XSUB(j)  (1280 + 64 * (j))
#define XB_XGEN(j)  (2304 + 64 * (j))
#define XB_TOP      3328
#define XB_TOPGEN   3392
#define XCD_BAR_WORDS 3456
#define XB_SPIN_CAP (1u << 18)

__device__ __forceinline__ unsigned xb_ld(unsigned* p)              { return __hip_atomic_load(p, __ATOMIC_RELAXED, __HIP_MEMORY_SCOPE_AGENT); }
__device__ __forceinline__ unsigned xb_add(unsigned* p, unsigned v) { return __hip_atomic_fetch_add(p, v, __ATOMIC_RELAXED, __HIP_MEMORY_SCOPE_AGENT); }
__device__ __forceinline__ unsigned xb_xcc_id() { return (unsigned)__builtin_amdgcn_s_getreg((3 << 11) | 20) & 0xFu; }
#define XB_SPIN(cond, bar) do { unsigned _sp = 0; while (cond) { __builtin_amdgcn_s_sleep(1); \
    if ((++_sp & 255u) == 0u) { if (xb_ld(&(bar)[XB_TMO])) break; if (_sp > XB_SPIN_CAP) { atomicAdd(&(bar)[XB_TMO], 1u); break; } } } } while (0)

struct XcdBarrier {
    unsigned* bar; unsigned x;
    volatile LAS unsigned* st;
};

__device__ __forceinline__ XcdBarrier xcd_barrier_post(unsigned* bar, volatile LAS unsigned* st) {
    XcdBarrier b; b.bar = bar; b.x = xb_xcc_id(); b.st = st;
    if (threadIdx.x == 0) (void)xb_add(&bar[XB_XCNT(b.x)], 1u);
    return b;
}
__device__ __forceinline__ void xcd_barrier_complete(unsigned* bar, unsigned x, unsigned& nloc, unsigned& nx) {
    const unsigned G = gridDim.x * gridDim.y * gridDim.z;
    unsigned sum, cnt, mine, sp = 0u;
    for (;;) {
        sum = 0u; cnt = 0u; mine = 0u;
#pragma unroll
        for (unsigned j = 0; j < 16; ++j) { const unsigned c = xb_ld(&bar[XB_XCNT(j)]); sum += c; cnt += (c > 0u) ? 1u : 0u; mine = (j == x) ? c : mine; }
        if (sum == G) break;
        __builtin_amdgcn_s_sleep(1);
        if ((++sp & 255u) == 0u) { if (xb_ld(&bar[XB_TMO])) break; if (sp > XB_SPIN_CAP) { atomicAdd(&bar[XB_TMO], 1u); break; } }
    }
    nloc = mine > 0u ? mine : 1u; nx = cnt > 0u ? cnt : 1u;
}

__device__ __forceinline__ void xcd_barrier(const XcdBarrier& b) {
    asm volatile("s_waitcnt vmcnt(0)" ::: "memory");
    __syncthreads();
    if (threadIdx.x == 0) {
        unsigned* bar = b.bar; asm volatile("" : "+s"(bar));
        __builtin_amdgcn_s_waitcnt(0);
        unsigned nloc = b.st[0], nx = b.st[1];
        if (nloc == 0u) { xcd_barrier_complete(bar, b.x, nloc, nx); b.st[0] = nloc; b.st[1] = nx; }
        const unsigned old = xb_add(&bar[XB_XSUB(b.x)], 1u);
        const unsigned gen = old / nloc;
        if (old + 1u == (gen + 1u) * nloc) {
            __builtin_amdgcn_fence(__ATOMIC_RELEASE, "agent");
            asm volatile("s_waitcnt vmcnt(0)" ::: "memory");
            const unsigned og = xb_add(&bar[XB_TOP], 1u);
            const unsigned tg = og / nx;
            if (og + 1u == (tg + 1u) * nx) xb_add(&bar[XB_TOPGEN], 1u);
            else XB_SPIN(xb_ld(&bar[XB_TOPGEN]) == tg, bar);
            __builtin_amdgcn_fence(__ATOMIC_ACQUIRE, "agent");
            xb_add(&bar[XB_XGEN(b.x)], 1u);
            asm volatile("s_waitcnt vmcnt(0)" ::: "memory");
        } else {
            XB_SPIN(xb_ld(&bar[XB_XGEN(b.x)]) == gen, bar);
            __builtin_amdgcn_fence(__ATOMIC_ACQUIRE, "agent");
            asm volatile("s_waitcnt vmcnt(0)" ::: "memory");
        }
    }
    __syncthreads();
}

template <int O> __device__ __forceinline__ float swz_xor(float v) { return __uint_as_float((unsigned)__builtin_amdgcn_ds_swizzle((int)__float_as_uint(v), (O << 10) | 0x1F)); }
template <int O> __device__ __forceinline__ int swz_xor_i(int v) { return __builtin_amdgcn_ds_swizzle(v, (O << 10) | 0x1F); }
__device__ __forceinline__ float wave_sum(float v) {
    v += swz_xor<1>(v); v += swz_xor<2>(v); v += swz_xor<4>(v); v += swz_xor<8>(v); v += swz_xor<16>(v);
    auto rr = __builtin_amdgcn_permlane32_swap(__float_as_uint(v), __float_as_uint(v), false, false);
    return __uint_as_float(rr[0]) + __uint_as_float(rr[1]);
}

__device__ __forceinline__ void ph_norm(const P& p, int bid, int nb, const float* g, int li, int sh_i, int sc_i, int Mrows, bf16_t* out, bool from_inputs) {
    const int lane = otid() & 63, wave = otid() >> 6; const float* X = (const float*)(p.ws + WS_X); const float* MOD = (const float*)(p.ws + WS_MOD);
    for (int row = bid * 8 + wave; row < Mrows; row += nb * 8) {
        const float4* xr = (const float4*)(from_inputs ? (row < ML ? p.x + (size_t)row * D : p.ctx + (size_t)(row - ML) * D) : X + (size_t)row * D); float4 v[4]; float ss = 0;
#pragma unroll
        for (int j = 0; j < 4; ++j) { v[j] = xr[64 * j + lane]; ss += v[j].x * v[j].x + v[j].y * v[j].y + v[j].z * v[j].z + v[j].w * v[j].w; }
        const float rs = rsqrtf(wave_sum(ss) * (1.f / D) + EPS);
        const float* mrow = MOD + ((size_t)li * 9 + row_mod_idx(row)) * 6144;
#pragma unroll
        for (int j = 0; j < 4; ++j) { const int c0 = (64 * j + lane) * 4; const float4 gg = *(const float4*)(g + c0), sh = *(const float4*)(mrow + sh_i * 1024 + c0), sc = *(const float4*)(mrow + sc_i * 1024 + c0);
            ushort4 o; o.x = f2bf(v[j].x * rs * gg.x * (1.f + sc.x) + sh.x); o.y = f2bf(v[j].y * rs * gg.y * (1.f + sc.y) + sh.y); o.z = f2bf(v[j].z * rs * gg.z * (1.f + sc.z) + sh.z); o.w = f2bf(v[j].w * rs * gg.w * (1.f + sc.w) + sh.w);
            *(ushort4*)(out + (size_t)row * D + c0) = o; }
    }
}
namespace att {
using bf16x8 = __attribute__((ext_vector_type(8))) short;
using s16x4  = __attribute__((ext_vector_type(4))) short;
using f32x16 = __attribute__((ext_vector_type(16))) float;
using u32x4  = __attribute__((ext_vector_type(4))) unsigned;
constexpr int QBLK = 32, KVBLK = 64;
constexpr float C2 = 0.125f * 1.4426950408889634f;
constexpr int KSLOT = 8192;
constexpr int OFF_K = 0, OFF_V = 3 * KSLOT, OFF_WS = OFF_V + 6 * KSLOT, OFF_OST = OFF_WS + 8 * 256, LDS_TOTAL = OFF_OST + 8 * 8192;
#define AT_SBAR() __builtin_amdgcn_sched_barrier(0)
#define AT_PIN(x) asm volatile("" : "+v"(x))
#define AT_MFMA(a, b, c) __builtin_amdgcn_mfma_f32_32x32x16_bf16(a, b, c, 0, 0, 0)
#define AT_WAIT_BAR(N) asm volatile("s_waitcnt vmcnt(" #N ") lgkmcnt(0)\n\ts_barrier" ::: "memory")
__device__ __forceinline__ int crow(int r, int hi) { return (r & 3) + 8 * (r >> 2) + 4 * hi; }
__device__ __forceinline__ unsigned cvtpk(float lo, float hi) { unsigned r; asm("v_cvt_pk_bf16_f32 %0, %1, %2" : "=v"(r) : "v"(lo), "v"(hi)); return r; }
__device__ __forceinline__ void glds16(unsigned voff, const void* sbase, unsigned lds_base) {
    unsigned sv; asm volatile("s_mov_b32 %0, m0\n\ts_mov_b32 m0, %3\n\ts_nop 0\n\tglobal_load_lds_dwordx4 %1, %2\n\ts_mov_b32 m0, %0" : "=&s"(sv) : "v"(voff), "s"(sbase), "s"(lds_base) : "memory"); }
typedef __attribute__((address_space(3))) const char* lds_cptr;
typedef short v4i16_t __attribute__((ext_vector_type(4)));
__device__ __forceinline__ void kload2(bf16x8* kf, lds_cptr kp, int d0) { kf[2 * d0] = *(const __attribute__((address_space(3))) bf16x8*)(kp + d0 * 2048); kf[2 * d0 + 1] = *(const __attribute__((address_space(3))) bf16x8*)(kp + d0 * 2048 + 512); }
__device__ __forceinline__ s16x4 vtr(lds_cptr p) { return __builtin_bit_cast(s16x4, __builtin_amdgcn_ds_read_tr16_b64_v4i16((__attribute__((address_space(3))) v4i16_t*)p)); }
#define AT_MX3(a, b, c) __builtin_fmaxf(__builtin_fmaxf((a), (b)), (c))
__device__ __forceinline__ float rowmax(const f32x16& p0, const f32x16& p1) {
    float a = AT_MX3(p0[0], p0[1], p1[0]), b = AT_MX3(p0[2], p0[3], p1[1]); a = AT_MX3(a, p1[2], p1[3]);
#pragma unroll
    for (int r = 4; r < 16; r += 4) { a = AT_MX3(a, p0[r], p0[r + 1]); b = AT_MX3(b, p0[r + 2], p0[r + 3]); a = AT_MX3(a, p1[r], p1[r + 1]); b = AT_MX3(b, p1[r + 2], p1[r + 3]); }
    float m = __builtin_fmaxf(a, b); auto rr = __builtin_amdgcn_permlane32_swap(__float_as_uint(m), __float_as_uint(m), false, false);
    return __builtin_fmaxf(__uint_as_float(rr[0]), __uint_as_float(rr[1])); }

__device__ __forceinline__ void attn_unit(const bf16_t* __restrict__ PROJ, bf16_t* __restrict__ ATT, float* stash, int h, int qrow0, int NT, int ctx0, int lat0,
                                          float lam, float osc, const float* __restrict__ sg, char* lds) {
  const int tid = otid(), lane = tid & 63, r32 = lane & 31, hi = lane >> 5; const int wid = __builtin_amdgcn_readfirstlane(tid >> 6);
  const unsigned lds0 = (unsigned)(uintptr_t)lds; float* wsf = (float*)(lds + OFF_WS) + wid * 64;
  const unsigned kdst = lds0 + OFF_K + wid * 1024, vdst = lds0 + OFF_V + wid * 1024;
  const lds_cptr vp0 = (lds_cptr)lds + OFF_V + ((lane >> 4) & 1) * 32 + (lane & 3) * 8 + (4 * hi + ((lane & 15) >> 2)) * 64;
  const lds_cptr kp0 = (lds_cptr)lds + OFF_K + hi * 1024 + r32 * 16;
  const unsigned voffV = (unsigned)(((16 * (wid & 3) + (lane >> 2)) * DIN + C_V + h * 128 + (wid >> 2) * 32 + (lane & 3) * 8) * 2);
  f32x16 o[4];
  const int moff0 = wid * 64 * 64 + lane;
#define AT_TBASE(t) ((const char*)PROJ + (size_t)((t) < 4 ? ctx0 + (t) * 64 : lat0 + ((t) - 4) * 64) * (size_t)(DIN * 2))
#define AT_RFL(x) ((unsigned)__builtin_amdgcn_readfirstlane((int)(x)))
#define AT_DMA_K(t, slot) glds16(voffK, AT_TBASE(t), AT_RFL(kdst + (slot)))
#define AT_DMA_V(t, slot) do { const char* tb_ = AT_TBASE(t); glds16(voffV, tb_, AT_RFL(vdst + 2 * (slot))); glds16(voffV, tb_ + 128, AT_RFL(vdst + 2 * (slot) + 8192)); } while (0)
  for (int m = 0; m < 2; ++m) {
    const unsigned voffK = (unsigned)((lane * DIN + C_K + h * 128 + m * 64 + wid * 8) * 2);
    __syncthreads();
    AT_DMA_K(0, 0); AT_DMA_V(0, 0); AT_DMA_K(1, KSLOT);
    bf16x8 qr[4];
    { const bf16_t* Qw = PROJ + (size_t)(qrow0 + wid * QBLK + r32) * DIN + C_Q + h * 128 + m * 64 + hi * 8;
#pragma unroll
      for (int d0 = 0; d0 < 4; ++d0) qr[d0] = *reinterpret_cast<const bf16x8*>(Qw + d0 * 16); }
    float mhat = 0.f, l_reg = 0.f;
#pragma unroll
    for (int d = 0; d < 4; ++d) o[d] = f32x16{};
    const f32x16 zero16 = f32x16{};
    bool resc = false;
    f32x16 pA0, pA1, pB0, pB1; bf16x8 kf[8]; s16x4 vlo[8], vhi[8]; u32x4 pw0, pw1, pw2, pw3;
    int sl_prev = 0, sl_cur = 0, sl_next = KSLOT;
#define AT_ROT() do { sl_prev = sl_cur; sl_cur = sl_next; sl_next = (sl_next == 2 * KSLOT) ? 0 : sl_next + KSLOT; } while (0)
#define AT_EX(v) __builtin_amdgcn_exp2f(__builtin_fmaf((v), C2, nmh))
#define AT_RESC() do { if (resc) { _Pragma("unroll") for (int d_ = 0; d_ < 4; ++d_) _Pragma("unroll") for (int r = 0; r < 16; ++r) o[d_][r] *= wsf[crow(r, hi)]; } } while (0)
    AT_DMA_K(2, 2 * KSLOT);
    AT_WAIT_BAR(4);
    _Pragma("unroll") for (int d0 = 0; d0 < 4; ++d0) kload2(kf, kp0, d0);
    pA0 = AT_MFMA(kf[0], qr[0], zero16); pA1 = AT_MFMA(kf[1], qr[0], zero16); pA0 = AT_MFMA(kf[2], qr[1], pA0); pA1 = AT_MFMA(kf[3], qr[1], pA1);
    pA0 = AT_MFMA(kf[4], qr[2], pA0); pA1 = AT_MFMA(kf[5], qr[2], pA1); pA0 = AT_MFMA(kf[6], qr[3], pA0); pA1 = AT_MFMA(kf[7], qr[3], pA1);
    { const float rm = rowmax(pA0, pA1); mhat = rm * C2; const float nmh = -mhat;
#pragma unroll
      for (int r = 0; r < 16; ++r) { pA0[r] = AT_EX(pA0[r]); pA1[r] = AT_EX(pA1[r]); } }
    AT_WAIT_BAR(0);
    AT_DMA_K(3, 0); AT_DMA_V(1, KSLOT); AT_ROT();
    _Pragma("unroll") for (int d0 = 0; d0 < 4; ++d0) kload2(kf, kp0 + sl_cur, d0);
    AT_WAIT_BAR(3);
#define AT_PKW(P, i) cvtpk(P[i], P[i + 1])
#define AT_PAF(k) __builtin_bit_cast(bf16x8, pw##k)
#define AT_VFR(i) (bf16x8){vlo[i][0], vlo[i][1], vlo[i][2], vlo[i][3], vhi[i][0], vhi[i][1], vhi[i][2], vhi[i][3]}
#define AT_VRD(i) do { vlo[i] = vtr(vp_ + (((i) >> 2) * 4096 + ((i) & 3) * 1024)); vhi[i] = vtr(vp_ + (((i) >> 2) * 4096 + ((i) & 3) * 1024 + 512)); } while (0)
#define AT_VRDX(i) do { vlo[i] = vtr(vp_ + ((((i) >> 2) + 2) * 4096 + ((i) & 3) * 1024)); vhi[i] = vtr(vp_ + ((((i) >> 2) + 2) * 4096 + ((i) & 3) * 1024 + 512)); AT_SBAR(); } while (0)
#define AT_KRD(G, d0) do { if (G) { kload2(kf, kp0 + sl_next, d0); AT_SBAR(); } } while (0)
#define AT_GAPA(MF, a0, a1, a2, a3, W0, W1, PW) do { MF; sacc += a0; sacc += a1; sacc += a2; sacc += a3; W0; W1; AT_PIN(PW); AT_PIN(sacc); AT_SBAR(); } while (0)
#define AT_GAPB(MF, X, i) do { MF; X[i] = AT_EX(X[i]); X[i + 1] = AT_EX(X[i + 1]); AT_PIN(X); AT_SBAR(); } while (0)
#define AT_STEP(C0, C1, P0, P1, t, GK, GV, GL) do { AT_SBAR(); \
    const lds_cptr vp_ = vp0 + 2 * sl_prev; \
    AT_VRD(0); AT_SBAR(); float sacc = P0[0] + P0[1]; \
                          AT_GAPA(C0 = AT_MFMA(kf[0], qr[0], zero16), P0[2], P0[3], P0[4], P0[5],     pw0[0] = AT_PKW(P0, 0),  pw0[1] = AT_PKW(P0, 2),  pw0); \
    AT_VRD(4); AT_SBAR(); AT_GAPA(C1 = AT_MFMA(kf[1], qr[0], zero16), P0[6], P0[7], P0[8], P0[9],     pw0[2] = AT_PKW(P0, 4),  pw0[3] = AT_PKW(P0, 6),  pw0); \
    AT_VRD(1); AT_SBAR(); AT_GAPA(C0 = AT_MFMA(kf[2], qr[1], C0),     P0[10], P0[11], P0[12], P0[13], pw1[0] = AT_PKW(P0, 8),  pw1[1] = AT_PKW(P0, 10), pw1); \
    AT_VRD(5); AT_SBAR(); AT_GAPA(C1 = AT_MFMA(kf[3], qr[1], C1),     P0[14], P0[15], P1[0], P1[1],   pw1[2] = AT_PKW(P0, 12), pw1[3] = AT_PKW(P0, 14), pw1); \
    AT_VRD(2); AT_SBAR(); AT_GAPA(C0 = AT_MFMA(kf[4], qr[2], C0),     P1[2], P1[3], P1[4], P1[5],     pw2[0] = AT_PKW(P1, 0),  pw2[1] = AT_PKW(P1, 2),  pw2); \
    AT_VRD(6); AT_SBAR(); AT_GAPA(C1 = AT_MFMA(kf[5], qr[2], C1),     P1[6], P1[7], P1[8], P1[9],     pw2[2] = AT_PKW(P1, 4),  pw2[3] = AT_PKW(P1, 6),  pw2); \
    AT_VRD(3); AT_SBAR(); AT_GAPA(C0 = AT_MFMA(kf[6], qr[3], C0),     P1[10], P1[11], P1[12], P1[13], pw3[0] = AT_PKW(P1, 8),  pw3[1] = AT_PKW(P1, 10), pw3); \
    AT_VRD(7); AT_SBAR(); AT_GAPA(C1 = AT_MFMA(kf[7], qr[3], C1),     P1[14], P1[15], 0.f, 0.f,       pw3[2] = AT_PKW(P1, 12), pw3[3] = AT_PKW(P1, 14), pw3); \
    l_reg += sacc; \
    if (GK) AT_DMA_K((t) + 3, sl_cur); if (GV) AT_DMA_V((t) + 1, sl_next);                                \
    { const float rm = __builtin_fmaf(rowmax(C0, C1), C2, -mhat); resc = false;                         \
      if (__builtin_expect(__any(rm > 8.f), 0)) { const float dl = __builtin_fmaxf(rm, 0.f); mhat += dl;     \
          const float f = __builtin_amdgcn_exp2f(-dl); l_reg *= f; if (hi == 0) wsf[r32] = f; resc = true; } } \
    const float nmh = -mhat; AT_SBAR(); \
    AT_GAPB(o[0] = AT_MFMA(AT_PAF(0), AT_VFR(0), o[0]), C0, 0);  AT_VRDX(0); AT_GAPB(o[1] = AT_MFMA(AT_PAF(0), AT_VFR(4), o[1]), C0, 2);  AT_VRDX(4); \
    AT_GAPB(o[0] = AT_MFMA(AT_PAF(1), AT_VFR(1), o[0]), C0, 4);  AT_VRDX(1); AT_GAPB(o[1] = AT_MFMA(AT_PAF(1), AT_VFR(5), o[1]), C0, 6);  AT_VRDX(5); \
    AT_GAPB(o[0] = AT_MFMA(AT_PAF(2), AT_VFR(2), o[0]), C0, 8);  AT_VRDX(2); AT_GAPB(o[1] = AT_MFMA(AT_PAF(2), AT_VFR(6), o[1]), C0, 10); AT_VRDX(6); \
    AT_GAPB(o[0] = AT_MFMA(AT_PAF(3), AT_VFR(3), o[0]), C0, 12); AT_VRDX(3); AT_GAPB(o[1] = AT_MFMA(AT_PAF(3), AT_VFR(7), o[1]), C0, 14); AT_VRDX(7); \
    AT_GAPB(o[2] = AT_MFMA(AT_PAF(0), AT_VFR(0), o[2]), C1, 0);  AT_KRD(GL, 0); AT_GAPB(o[3] = AT_MFMA(AT_PAF(0), AT_VFR(4), o[3]), C1, 2);  AT_KRD(GL, 1); \
    AT_GAPB(o[2] = AT_MFMA(AT_PAF(1), AT_VFR(1), o[2]), C1, 4);  AT_KRD(GL, 2); AT_GAPB(o[3] = AT_MFMA(AT_PAF(1), AT_VFR(5), o[3]), C1, 6);  AT_KRD(GL, 3); \
    AT_GAPB(o[2] = AT_MFMA(AT_PAF(2), AT_VFR(2), o[2]), C1, 8);  AT_GAPB(o[3] = AT_MFMA(AT_PAF(2), AT_VFR(6), o[3]), C1, 10); \
    AT_GAPB(o[2] = AT_MFMA(AT_PAF(3), AT_VFR(3), o[2]), C1, 12); AT_GAPB(o[3] = AT_MFMA(AT_PAF(3), AT_VFR(7), o[3]), C1, 14); \
    } while (0)
    int t = 1;
    for (; t + 5 < NT; t += 2) {
        AT_STEP(pB0, pB1, pA0, pA1, t, true, true, true);     AT_WAIT_BAR(3); AT_RESC(); AT_ROT();
        AT_STEP(pA0, pA1, pB0, pB1, t + 1, true, true, true); AT_WAIT_BAR(3); AT_RESC(); AT_ROT();
    }
#define AT_ENDW(tt) do { if ((tt) + 3 < NT) { AT_WAIT_BAR(3); } else if ((tt) + 2 < NT) { AT_WAIT_BAR(2); } else { AT_WAIT_BAR(0); } } while (0)
    for (; t + 1 < NT; t += 2) {
        AT_STEP(pB0, pB1, pA0, pA1, t, (t + 3 < NT), (t + 1 < NT), (t + 1 < NT));         AT_ENDW(t);     AT_RESC(); AT_ROT();
        AT_STEP(pA0, pA1, pB0, pB1, t + 1, (t + 4 < NT), (t + 2 < NT), (t + 2 < NT));     AT_ENDW(t + 1); AT_RESC(); AT_ROT();
    }
    AT_STEP(pB0, pB1, pA0, pA1, NT - 1, false, false, false); AT_RESC();
    { float sacc = pB0[0] + pB0[1];
#pragma unroll
      for (int r = 2; r < 16; ++r) sacc += pB0[r];
#pragma unroll
      for (int r = 0; r < 16; ++r) sacc += pB1[r];
      l_reg += sacc;
      pw0 = (u32x4){AT_PKW(pB0, 0), AT_PKW(pB0, 2), AT_PKW(pB0, 4), AT_PKW(pB0, 6)}; pw1 = (u32x4){AT_PKW(pB0, 8), AT_PKW(pB0, 10), AT_PKW(pB0, 12), AT_PKW(pB0, 14)};
      pw2 = (u32x4){AT_PKW(pB1, 0), AT_PKW(pB1, 2), AT_PKW(pB1, 4), AT_PKW(pB1, 6)}; pw3 = (u32x4){AT_PKW(pB1, 8), AT_PKW(pB1, 10), AT_PKW(pB1, 12), AT_PKW(pB1, 14)};
      const lds_cptr vp_ = vp0 + 2 * sl_cur; _Pragma("unroll") for (int i = 0; i < 8; ++i) AT_VRD(i);
      o[0] = AT_MFMA(AT_PAF(0), AT_VFR(0), o[0]); o[1] = AT_MFMA(AT_PAF(0), AT_VFR(4), o[1]); o[0] = AT_MFMA(AT_PAF(1), AT_VFR(1), o[0]); o[1] = AT_MFMA(AT_PAF(1), AT_VFR(5), o[1]);
      o[0] = AT_MFMA(AT_PAF(2), AT_VFR(2), o[0]); o[1] = AT_MFMA(AT_PAF(2), AT_VFR(6), o[1]); o[0] = AT_MFMA(AT_PAF(3), AT_VFR(3), o[0]); o[1] = AT_MFMA(AT_PAF(3), AT_VFR(7), o[1]);
      AT_SBAR();
      _Pragma("unroll") for (int i = 0; i < 8; ++i) AT_VRDX(i);
      o[2] = AT_MFMA(AT_PAF(0), AT_VFR(0), o[2]); o[3] = AT_MFMA(AT_PAF(0), AT_VFR(4), o[3]); o[2] = AT_MFMA(AT_PAF(1), AT_VFR(1), o[2]); o[3] = AT_MFMA(AT_PAF(1), AT_VFR(5), o[3]);
      o[2] = AT_MFMA(AT_PAF(2), AT_VFR(2), o[2]); o[3] = AT_MFMA(AT_PAF(2), AT_VFR(6), o[3]); o[2] = AT_MFMA(AT_PAF(3), AT_VFR(3), o[2]); o[3] = AT_MFMA(AT_PAF(3), AT_VFR(7), o[3]); }
    { auto rr = __builtin_amdgcn_permlane32_swap(__float_as_uint(l_reg), __float_as_uint(l_reg), false, false); l_reg = __uint_as_float(rr[0]) + __uint_as_float(rr[1]); }
    if (hi == 0) wsf[32 + r32] = l_reg;
    asm volatile("s_waitcnt lgkmcnt(0)" ::: "memory");
    float rli[16];
#pragma unroll
    for (int r = 0; r < 16; ++r) rli[r] = __builtin_amdgcn_rcpf(wsf[32 + crow(r, hi)]);
    if (m == 0) {
#pragma unroll
      for (int d0 = 0; d0 < 4; ++d0) { int mo_ = moff0 + d0 * 1024; asm volatile("" : "+v"(mo_)); float* ms = stash + mo_;
#pragma unroll
        for (int r = 0; r < 16; ++r) ms[r * 64] = o[d0][r] * rli[r]; }
    } else {
#pragma unroll
      for (int d0 = 0; d0 < 4; ++d0) { int mo_ = moff0 + d0 * 1024; asm volatile("" : "+v"(mo_)); const float* ms = stash + mo_;
#pragma unroll
        for (int r = 0; r < 16; ++r) o[d0][r] = ms[r * 64] - lam * (o[d0][r] * rli[r]); }
    }
#undef AT_ROT
#undef AT_EX
#undef AT_RESC
#undef AT_PKW
#undef AT_PAF
#undef AT_VFR
#undef AT_VRD
#undef AT_VRDX
#undef AT_KRD
#undef AT_GAPA
#undef AT_GAPB
#undef AT_STEP
#undef AT_ENDW
  }
#undef AT_TBASE
#undef AT_RFL
#undef AT_DMA_K
#undef AT_DMA_V
  float rs[16];
#pragma unroll
  for (int r = 0; r < 16; ++r) { float s = o[0][r] * o[0][r] + o[1][r] * o[1][r] + o[2][r] * o[2][r] + o[3][r] * o[3][r];
    s += swz_xor<1>(s); s += swz_xor<2>(s); s += swz_xor<4>(s); s += swz_xor<8>(s); s += swz_xor<16>(s);
    rs[r] = rsqrtf(s * (1.f / 128.f) + EPS) * osc; }
  float sgv[4];
#pragma unroll
  for (int d0 = 0; d0 < 4; ++d0) sgv[d0] = sg[d0 * 32 + r32];
  bf16_t* stg = (bf16_t*)(lds + OFF_OST) + wid * 4096;
#pragma unroll
  for (int r = 0; r < 16; ++r) { const int orow = crow(r, hi);
#pragma unroll
    for (int d0 = 0; d0 < 4; ++d0) stg[orow * 128 + d0 * 32 + r32] = f2bf(o[d0][r] * rs[r] * sgv[d0]); }
  asm volatile("s_waitcnt lgkmcnt(0)" ::: "memory");
  bf16_t* Ow = ATT + (size_t)(qrow0 + wid * QBLK) * D + h * 128;
#pragma unroll
  for (int i = 0; i < 8; ++i) { const int row = i * 4 + (lane >> 4), ch = lane & 15; const u32x4 v = *(const u32x4*)(stg + row * 128 + ch * 8); *(u32x4*)(Ow + (size_t)row * D + ch * 8) = v; }
}
#undef AT_SBAR
#undef AT_PIN
#undef AT_MFMA
#undef AT_WAIT_BAR
#undef AT_MX3
}

__device__ __forceinline__ void ph_attn(const P& p, int li, bool do_ctx, int bid, int nb, unsigned char* lds) {
    const bf16_t* PROJ = (const bf16_t*)(p.ws + WS_PROJ); bf16_t* ATT = (bf16_t*)(p.ws + WS_ATT);
    const float lam = ((const float*)(p.ws + WS_LAM))[li]; const float osc = 1.f - lambda_init_of(li);
    const int vcu = (nb % 8 == 0) ? (bid % 8) * (nb / 8) + bid / 8 : bid;
    float* stash = (float*)(p.ws + WS_STASH) + (size_t)bid * (8 * 64 * 64);
    const int nlat = 512, nctx = do_ctx ? 64 : 0;
    const int klat = vcu < nlat ? (nlat - vcu + nb - 1) / nb : 0;
    for (int k = 0;; ++k) { int h, qrow0, NT; int b;
        if (k < klat) { const int u = vcu + k * nb; b = u >> 6; h = (u >> 3) & 7; qrow0 = b * 2048 + (u & 7) * 256; NT = 36; }
        else { const int v = bid + (k - klat) * nb; if (v >= nctx) break; b = v >> 3; h = v & 7; qrow0 = ML + b * 256; NT = 4; }
        att::attn_unit(PROJ, ATT, stash, h, qrow0, NT, ML + b * 256, b * 2048, lam, osc, p.subln_g + li * 128, (char*)lds); }
}
namespace lru {
using bf16x8 = __attribute__((ext_vector_type(8))) short;
using f32x16 = __attribute__((ext_vector_type(16))) float;
using u32x4  = __attribute__((ext_vector_type(4))) unsigned;
constexpr int T = 256;
constexpr int L_URAW = 0, L_UCF = 33280, L_UCB = L_UCF + 32768, L_GLT = L_UCB + 256 * 144, L_LAT = L_GLT + 16384, L_SUMS = L_LAT + 16384, L_BW = L_SUMS + 8192, L_END = L_BW + 8192;
__device__ __forceinline__ float fast_sigmoid(float x) { return __builtin_amdgcn_rcpf(1.f + __expf(-x)); }
__device__ __forceinline__ float one_minus_exp(float x, float a) {
    float pl = 1.f / 5040.f; pl = fmaf(pl, x, 1.f / 720.f); pl = fmaf(pl, x, 1.f / 120.f); pl = fmaf(pl, x, 1.f / 24.f); pl = fmaf(pl, x, 1.f / 6.f); pl = fmaf(pl, x, 0.5f); pl = fmaf(pl, x, 1.f);
    return x > -0.5f ? -x * pl : 1.f - a * a; }
__device__ __forceinline__ float fast_gelu(float x) { const float u = 0.7978845608028654f * (x + 0.044715f * x * x * x); return x * fast_sigmoid(2.f * u); }
}

__device__ __forceinline__ void ph_lru(const P& p, int li, int bid, int nb, unsigned char* lds) {
    using namespace lru;
    const bf16_t* PROJ = (const bf16_t*)(p.ws + WS_PROJ); float* HF = (float*)(p.ws + WS_HF); bf16_t* LA = (bf16_t*)(p.ws + WS_LA);
    const int tid = otid(), wave = tid >> 6, lane = tid & 63, r32 = lane & 31, hi = lane >> 5, tt = wave;
    const int c = r32;
    const int sub = tt * 2 + hi;
    float* UCF = (float*)(lds + L_UCF); float* SUMS = (float*)(lds + L_SUMS);
    for (int item = bid; item < 256; item += nb) {
        const int b = item >> 5, n = (item >> 1) & 15, hfi = item & 1; const int ch0 = n * 64, cb32 = ch0 + hfi * 32;
        int tid_i = tid; asm volatile("" : "+v"(tid_i));
        const int c2 = tid_i & 31, tq = tid_i >> 5;
        float cw0[4], cw1[4];
#pragma unroll
        for (int k = 0; k < 4; ++k) { cw0[k] = p.conv_w[(size_t)(li * 4 + k) * 1024 + ch0 + 2 * c2]; cw1[k] = p.conv_w[(size_t)(li * 4 + k) * 1024 + ch0 + 2 * c2 + 1]; }
        const float cb0 = p.conv_b[li * 1024 + ch0 + 2 * c2], cb1 = p.conv_b[li * 1024 + ch0 + 2 * c2 + 1];
        for (int d = 0; d < 2; ++d) {
            int c_w = c; asm volatile("" : "+v"(c_w));
            { const int g = wave >> 2, ks = wave & 3;
              const float* wp = p.lru_w + ((((size_t)(li * 2 + d) * 2 + g) * 16 + n) * 64) * 64 + hfi * 32 + c_w + (size_t)(ks * 16 + 8 * hi) * 64;
              float wf[8];
#pragma unroll
              for (int j = 0; j < 8; ++j) wf[j] = wp[(size_t)j * 64];
              asm volatile("s_waitcnt vmcnt(0)" ::: "memory");
              *(u32x4*)(lds + L_BW + ((g * 4 + ks) * 64 + lane) * 16) = (u32x4){pk2(wf[0], wf[1]), pk2(wf[2], wf[3]), pk2(wf[4], wf[5]), pk2(wf[6], wf[7])}; }
            const float bias0 = p.lru_b[((size_t)(li * 2 + d) * 2 + 0) * 1024 + cb32 + c_w], bias1 = p.lru_b[((size_t)(li * 2 + d) * 2 + 1) * 1024 + cb32 + c_w];
            float sp8; { const float lam = p.lru_lam[(size_t)(li * 2 + d) * 1024 + cb32 + c_w]; const float z = -lam; const float ez = __expf(z);
              const float spl = ez < 0.1f ? ez * (1.f - ez * (0.5f - ez * (0.33333333f - ez * (0.25f - ez * 0.2f)))) : (z > 20.f ? z : __logf(1.f + ez)); sp8 = -8.f * spl; }
            float state = 0.f;
            u32x4 st_u[5]; u32x4 st_g[2];
#define LRU_CHUNK_ROW0(step_, row0_, L_, t0_) { int cc_; if ((step_) < 1) { cc_ = 0; L_ = 256; row0_ = ML + b * 256; } else { cc_ = d == 0 ? (step_) - 1 : 8 - (step_); L_ = 2048; row0_ = b * 2048; } t0_ = cc_ * T; }
#define LRU_STAGE_LOAD(step_) { int row0_, L_, t0_; LRU_CHUNK_ROW0(step_, row0_, L_, t0_); int tid_ = tid; asm volatile("" : "+v"(tid_));   \
            _Pragma("unroll") for (int q_ = 0; q_ < 5; ++q_) { const int piece_ = tid_ + 512 * q_; const int i_ = piece_ >> 3, chk_ = piece_ & 7; const int tr_ = t0_ - 2 + i_; st_u[q_] = (u32x4){0u, 0u, 0u, 0u}; \
                if (piece_ < 259 * 8 && tr_ >= 0 && tr_ < L_) st_u[q_] = *(const u32x4*)(PROJ + (size_t)(row0_ + tr_) * DIN + C_U + ch0 + chk_ * 8); } \
            if (d == 1) { _Pragma("unroll") for (int q_ = 0; q_ < 2; ++q_) { const int piece_ = tid_ + 512 * q_; const int i_ = piece_ >> 2, chk_ = piece_ & 3; st_g[q_] = *(const u32x4*)(PROJ + (size_t)(row0_ + t0_ + i_) * DIN + C_GL + cb32 + chk_ * 8); } } }
            LRU_STAGE_LOAD(0);
            for (int step = 0; step < 9; ++step) {
                int row0, Lseq, t0; LRU_CHUNK_ROW0(step, row0, Lseq, t0);
                const int crow0 = row0 + t0;
                const int spos0 = (Lseq == 256 ? 0 : 256) + t0;
#pragma unroll
                for (int q = 0; q < 5; ++q) { const int piece = tid + 512 * q; if (piece < 259 * 8) *(u32x4*)(lds + L_URAW + piece * 16) = st_u[q]; }
                if (d == 1) {
#pragma unroll
                    for (int q = 0; q < 2; ++q) { const int piece = tid + 512 * q; *(u32x4*)(lds + L_GLT + piece * 16) = st_g[q]; } }
                __syncthreads();
                if (step + 1 < 9) LRU_STAGE_LOAD(step + 1);
                float hf[16];
                if (d == 1) { int sub_o = sub; asm volatile("" : "+v"(sub_o)); int ho_ = (item * 2304 + spos0 + 255 - sub_o * 16) * 32 + c; asm volatile("" : "+v"(ho_)); const float* hp = HF + ho_;
#pragma unroll
                    for (int r = 0; r < 16; ++r) hf[r] = hp[-r * 32]; }
#pragma unroll
                for (int hh = 0; hh < 2; ++hh) {
                    float x0[11], x1[11]; const int tb8 = tq * 16 + hh * 8;
#pragma unroll
                    for (int i = 0; i < 11; ++i) { const unsigned w = *(const unsigned*)(lds + L_URAW + (tb8 + i) * 128 + c2 * 4); x0[i] = __uint_as_float(w << 16); x1[i] = __uint_as_float(w & 0xffff0000u); }
                    const bool mine = (c2 >> 4) == hfi;
#pragma unroll
                    for (int e = 0; e < 8; ++e) { const int tk = tb8 + e, t = d ? 255 - tk : tk;
                        const float y0 = cb0 + cw0[0] * x0[e] + cw0[1] * x0[e + 1] + cw0[2] * x0[e + 2] + cw0[3] * x0[e + 3];
                        const float y1 = cb1 + cw1[0] * x1[e] + cw1[1] * x1[e + 1] + cw1[2] * x1[e + 2] + cw1[3] * x1[e + 3];
                        if (mine) *(float2*)(UCF + t * 32 + 2 * (c2 & 15)) = make_float2(y0, y1);
                        *(unsigned*)(lds + L_UCB + t * 144 + c2 * 4) = pk2(y0, y1); }
                    __builtin_amdgcn_sched_barrier(0);
                }
                __syncthreads();
                f32x16 acc0 = f32x16{}, acc1 = f32x16{};
                {
                    const int i = r32, hc = (i >> 2) & 1, rr = (i & 3) + 4 * (i >> 3), rho = (tt * 2 + hc) * 16 + rr;
                    const unsigned char* ap = lds + L_UCB + rho * 144 + hi * 16;
#pragma unroll
                    for (int ks = 0; ks < 4; ++ks) { const bf16x8 a = *(const bf16x8*)(ap + ks * 32);
                        const bf16x8 b0 = *(const bf16x8*)(lds + L_BW + (ks * 64 + lane) * 16), b1 = *(const bf16x8*)(lds + L_BW + ((4 + ks) * 64 + lane) * 16);
                        acc0 = __builtin_amdgcn_mfma_f32_32x32x16_bf16(a, b0, acc0, 0, 0, 0); acc1 = __builtin_amdgcn_mfma_f32_32x32x16_bf16(a, b1, acc1, 0, 0, 0); }
                }
                float hl[16], ap_[16]; float P = 1.f, h = 0.f;
                const float* ucp = UCF + (sub * 16) * 32 + c;
#pragma unroll
                for (int r = 0; r < 16; ++r) {
                    const float u = ucp[r * 32]; const float rec = fast_sigmoid(acc0[r] + bias0), inp = fast_sigmoid(acc1[r] + bias1);
                    const float la = sp8 * rec; const float a = __expf(la); const float m2 = one_minus_exp(2.f * la, a); const float drive = __builtin_amdgcn_sqrtf(m2) * (inp * u);
                    h = a * h + drive; P *= a; hl[r] = h; ap_[r] = P;
                    if ((r & 3) == 3) __builtin_amdgcn_sched_barrier(0); }
                float* sums = SUMS + (step & 1) * 1024;
                *(float2*)(sums + (sub * 32 + c) * 2) = make_float2(P, h);
                __syncthreads();
                float carry = state, mine = state;
#pragma unroll
                for (int s = 0; s < 16; ++s) { if (s == sub) mine = carry; const float2 ph = *(const float2*)(sums + (s * 32 + c) * 2); carry = ph.x * carry + ph.y; }
                state = carry;
                if (d == 0) {
                    int sub_o = sub; asm volatile("" : "+v"(sub_o)); int ho_ = (item * 2304 + spos0 + sub_o * 16) * 32 + c; asm volatile("" : "+v"(ho_)); float* hp = HF + ho_;
#pragma unroll
                    for (int r = 0; r < 16; ++r) hp[r * 32] = hl[r] + ap_[r] * mine;
                } else {
                    bf16_t* lat = (bf16_t*)(lds + L_LAT); const bf16_t* glt = (const bf16_t*)(lds + L_GLT);
                    const int tb = 255 - sub * 16;
#pragma unroll
                    for (int r = 0; r < 16; ++r) { const float hb = hl[r] + ap_[r] * mine; const float gl = bf2f(glt[(tb - r) * 32 + c]);
                        lat[(tb - r) * 32 + c] = f2bf((hf[r] + hb) * fast_gelu(gl)); }
                    __syncthreads();
                    int tid3 = tid; asm volatile("" : "+v"(tid3));
#pragma unroll
                    for (int q = 0; q < 2; ++q) { const int piece = tid3 + 512 * q; const int i = piece >> 2, chk = piece & 3;
                        *(u32x4*)(LA + (size_t)(crow0 + i) * D + cb32 + chk * 8) = *(const u32x4*)(lds + L_LAT + piece * 16); }
                }
            }
#undef LRU_STAGE_LOAD
#undef LRU_CHUNK_ROW0
            asm volatile("s_waitcnt vmcnt(0)" ::: "memory");
            __syncthreads();
            if (tid == 0) { __builtin_amdgcn_fence(__ATOMIC_ACQUIRE, "agent"); asm volatile("s_waitcnt vmcnt(0)" ::: "memory"); }
            __syncthreads();
        }
    }
}
namespace peer {
using bf16x8 = __attribute__((ext_vector_type(8))) short;
using f32x16 = __attribute__((ext_vector_type(16))) float;
using u32x4  = __attribute__((ext_vector_type(4))) unsigned;
typedef __bf16 bf16x2_t __attribute__((ext_vector_type(2)));
__device__ __forceinline__ unsigned sortable(float f) { const unsigned u = __float_as_uint(f); return (u & 0x80000000u) ? ~u : (u | 0x80000000u); }
__device__ __forceinline__ float unsortable(unsigned u) { return __uint_as_float((u & 0x80000000u) ? (u & 0x7fffffffu) : ~u); }
__device__ __forceinline__ unsigned umax_(unsigned a, unsigned b) { return a > b ? a : b; }
__device__ __forceinline__ unsigned umin_(unsigned a, unsigned b) { return a < b ? a : b; }
__device__ __forceinline__ void sort16_desc(unsigned (&v)[16]) {
#pragma unroll
    for (int kk = 1; kk <= 4; ++kk)
#pragma unroll
        for (int jj = 3; jj >= 0; --jj)
#pragma unroll
            for (int i = 0; i < 16; ++i) { const int k = 1 << kk, j = 1 << jj, l = i ^ j; if (jj >= kk) continue;
                if (l > i) { const unsigned mx = umax_(v[i], v[l]), mn = umin_(v[i], v[l]); if ((i & k) == 0) { v[i] = mx; v[l] = mn; } else { v[i] = mn; v[l] = mx; } } }
}
__device__ __forceinline__ void merge_top16(unsigned (&a)[16], const unsigned (&b)[16]) {
#pragma unroll
    for (int i = 0; i < 16; ++i) a[i] = umax_(a[i], b[15 - i]);
#pragma unroll
    for (int jj = 3; jj >= 0; --jj)
#pragma unroll
        for (int i = 0; i < 16; ++i) { const int j = 1 << jj, l = i ^ j; if (l > i) { const unsigned mx = umax_(a[i], a[l]), mn = umin_(a[i], a[l]); a[i] = mx; a[l] = mn; } }
}
__device__ __forceinline__ int crow(int r, int hi) { return (r & 3) + 8 * (r >> 2) + 4 * hi; }
__device__ __forceinline__ float dot2(unsigned a, unsigned b, float acc) { return __builtin_amdgcn_fdot2_f32_bf16(__builtin_bit_cast(bf16x2_t, a), __builtin_bit_cast(bf16x2_t, b), acc, false); }
__device__ __forceinline__ unsigned msel(unsigned a, unsigned b, unsigned m) { return a ^ ((a ^ b) & m); }
__device__ __forceinline__ unsigned pick16(const unsigned (&a)[16], int i) {
    const unsigned m0 = 0u - (unsigned)(i & 1), m1 = 0u - (unsigned)((i >> 1) & 1), m2 = 0u - (unsigned)((i >> 2) & 1), m3 = 0u - (unsigned)((i >> 3) & 1);
    unsigned t8[8], t4[4], t2[2];
#pragma unroll
    for (int k = 0; k < 8; ++k) t8[k] = msel(a[2 * k], a[2 * k + 1], m0);
#pragma unroll
    for (int k = 0; k < 4; ++k) t4[k] = msel(t8[2 * k], t8[2 * k + 1], m1);
#pragma unroll
    for (int k = 0; k < 2; ++k) t2[k] = msel(t4[2 * k], t4[2 * k + 1], m2);
    return msel(t2[0], t2[1], m3); }
__device__ __forceinline__ void score_list(const bf16_t* __restrict__ PQ, const bf16_t* __restrict__ KEYS, int tok, int hp, int r32, int hi, unsigned (&T)[16]) {
    const bf16_t* qp = PQ + (size_t)tok * D + hp * 64 + hi * 8; bf16x8 qf[4];
#pragma unroll
    for (int ks = 0; ks < 4; ++ks) qf[ks] = *reinterpret_cast<const bf16x8*>(qp + ks * 16);
    const bf16_t* kp = KEYS + ((size_t)hp * 128 + r32) * 64 + hi * 8;
#pragma unroll
    for (int kt = 0; kt < 4; ++kt) { f32x16 acc = f32x16{};
#pragma unroll
        for (int ks = 0; ks < 4; ++ks) { const bf16x8 a = *reinterpret_cast<const bf16x8*>(kp + (size_t)kt * 32 * 64 + ks * 16); acc = __builtin_amdgcn_mfma_f32_32x32x16_bf16(a, qf[ks], acc, 0, 0, 0); }
        unsigned v[16];
#pragma unroll
        for (int r = 0; r < 16; ++r) v[r] = (sortable(acc[r]) & ~127u) | (unsigned)(127 - (kt * 32 + crow(r, hi)));
        sort16_desc(v);
        if (kt == 0) {
#pragma unroll
            for (int r = 0; r < 16; ++r) T[r] = v[r];
        } else merge_top16(T, v);
    }
}
}

__device__ __forceinline__ void ph_peer_score(const P& p, int li, int Mrows, int bid, int nb) {
    using namespace peer;
    const bf16_t* PQ = (const bf16_t*)(p.ws + WS_PQ); const bf16_t* KEYS = (const bf16_t*)(p.ws + WS_KEYS) + (size_t)li * 16 * 128 * 64;
    int* IDX = (int*)(p.ws + WS_IDX); float* G = (float*)(p.ws + WS_G);
    const int tid = otid(), wave = tid >> 6, lane = tid & 63, r32 = lane & 31, hi = lane >> 5;
    const int gw = bid * NWAVES + wave, NGW = nb * NWAVES, ntask = (Mrows / 32) * 4;
    for (int task = gw; task < ntask; task += NGW) {
        const int tok = (task >> 2) * 32 + r32, hp2 = task & 3;
        for (int hh = 0; hh < 2; ++hh) { const int h = hp2 * 2 + hh;
            unsigned A0[16], B0[16];
            score_list(PQ, KEYS, tok, h * 2 + 0, r32, hi, A0); score_list(PQ, KEYS, tok, h * 2 + 1, r32, hi, B0);
            unsigned M[16], Y[16];
#pragma unroll
            for (int i = 0; i < 16; ++i) { auto rr = __builtin_amdgcn_permlane32_swap(A0[i], B0[i], false, false); M[i] = rr[0]; Y[i] = rr[1]; }
            merge_top16(M, Y);
            unsigned P0[16], P1[16];
#pragma unroll
            for (int i = 0; i < 16; ++i) { auto rr = __builtin_amdgcn_permlane32_swap(M[i], M[i], false, false); P0[i] = rr[0]; P1[i] = rr[1]; }
            float X[16], Yv[16];
#pragma unroll
            for (int i = 0; i < 16; ++i) { const float f0 = unsortable(P0[i]), f1 = unsortable(P1[i]); X[i] = hi ? f1 : f0; Yv[i] = hi ? f0 : f1; }
            unsigned C0[16], C1[16];
#pragma unroll
            for (int c = 0; c < 16; ++c) { const float s = X[0] + Yv[c]; const unsigned flat = hi ? (unsigned)(c * 16) : (unsigned)c; unsigned key = (sortable(s) & ~255u) | (255u - flat); if (c == 0 && hi) key = 0u; C0[c] = key; }
#define PEER_CAND(c, i, j) { const float s_ = X[i] + Yv[j]; const unsigned flat_ = hi ? (unsigned)((j) * 16 + (i)) : (unsigned)((i) * 16 + (j)); unsigned key_ = (sortable(s_) & ~255u) | (255u - flat_); if ((i) == (j) && hi) key_ = 0u; C1[c] = key_; }
            PEER_CAND(0, 1, 1) PEER_CAND(1, 1, 2) PEER_CAND(2, 1, 3) PEER_CAND(3, 1, 4) PEER_CAND(4, 1, 5) PEER_CAND(5, 1, 6) PEER_CAND(6, 1, 7) PEER_CAND(7, 2, 2) PEER_CAND(8, 2, 3) PEER_CAND(9, 2, 4) PEER_CAND(10, 3, 3)
#undef PEER_CAND
            C1[11] = 0u; C1[12] = 0u; C1[13] = 0u; C1[14] = 0u; C1[15] = 0u;
            sort16_desc(C0); sort16_desc(C1); merge_top16(C0, C1);
            unsigned F[16]; unsigned mxk;
            { unsigned Clo[16], Chi[16];
#pragma unroll
              for (int i = 0; i < 16; ++i) { auto rr = __builtin_amdgcn_permlane32_swap(C0[i], C0[i], false, false); Clo[i] = rr[0]; Chi[i] = rr[1]; }
#pragma unroll
              for (int i = 0; i < 16; ++i) F[i] = umax_(Clo[i], Chi[15 - i]);
              mxk = umax_(Clo[0], Chi[0]); }
            const float fmx = unsortable(mxk); float w[16]; float wsum = 0.f;
#pragma unroll
            for (int i = 0; i < 16; ++i) { w[i] = __expf(unsortable(F[i]) - fmx); wsum += w[i]; }
            const float inv = 1.f / wsum;
            int oi[8]; float og[8]; const unsigned him = 0u - (unsigned)hi;
#pragma unroll
            for (int k = 0; k < 8; ++k) { const unsigned e = msel(F[k], F[8 + k], him); const float wk = __uint_as_float(msel(__float_as_uint(w[k]), __float_as_uint(w[8 + k]), him));
                const int cf = 255 - (int)(e & 255u), i1 = cf >> 4, i2 = cf & 15;
                const int n1 = 127 - (int)(pick16(P0, i1) & 127u), n2 = 127 - (int)(pick16(P1, i2) & 127u);
                oi[k] = n1 * 128 + n2; og[k] = wk * inv; }
            int* ip = IDX + (size_t)tok * 128 + h * 16 + hi * 8; float* gp = G + (size_t)tok * 128 + h * 16 + hi * 8;
            *(int4*)ip = make_int4(oi[0], oi[1], oi[2], oi[3]); *(int4*)(ip + 4) = make_int4(oi[4], oi[5], oi[6], oi[7]);
            *(float4*)gp = make_float4(og[0], og[1], og[2], og[3]); *(float4*)(gp + 4) = make_float4(og[4], og[5], og[6], og[7]);
        }
    }
}

#ifndef FP6_INTERLEAVED
#define FP6_INTERLEAVED 1
#endif
namespace peer {
typedef float v16f __attribute__((ext_vector_type(16)));
typedef float v32f __attribute__((ext_vector_type(32)));
typedef unsigned v6u __attribute__((ext_vector_type(6)));
typedef unsigned v16u __attribute__((ext_vector_type(16)));
typedef unsigned u32x2 __attribute__((ext_vector_type(2)));
__host__ __device__ constexpr int fp6_src_of(int k) { return FP6_INTERLEAVED ? ((k & 1) * 16 + (k >> 1)) : k; }
}
__device__ __forceinline__ void ph_peer_tables(const P& p, int li, int bid, int nb) {
    using namespace peer;
    const int tid = otid(), lane = tid & 63, wave = tid >> 6, g = lane & 31, hb = lane >> 5;
    const int first = nb >= 128 ? 64 : 0;
    if (bid < first) return;
    const int gw = (bid - first) * NWAVES + wave, NGW = (nb - first) * NWAVES;
    for (int rp = gw; rp < 16384; rp += NGW) {
        const int rr = 2 * rp + hb, tab = rr >> 14, row = rr & 16383;
        const float4* src = (const float4*)((tab ? p.peer_v : p.peer_u) + ((size_t)li * 16384 + row) * 1024 + g * 32);
        unsigned char* dst = (unsigned char*)(p.ws + (tab ? WS_PV : WS_PU)) + (tab ? (size_t)row * 768 + g * 24 : (size_t)row * 512 + g * 16); float* sc = (float*)(p.ws + (tab ? WS_SV : WS_SU));
        float4 v[8]; float mx = 0.f;
#pragma unroll
        for (int j = 0; j < 8; ++j) { v[j] = src[j]; mx = fmaxf(fmaxf(mx, fmaxf(fabsf(v[j].x), fabsf(v[j].y))), fmaxf(fabsf(v[j].z), fabsf(v[j].w))); }
        mx = fmaxf(mx, swz_xor<1>(mx)); mx = fmaxf(mx, swz_xor<2>(mx)); mx = fmaxf(mx, swz_xor<4>(mx)); mx = fmaxf(mx, swz_xor<8>(mx)); mx = fmaxf(mx, swz_xor<16>(mx));
        const float top = tab ? 7.5f : 6.0f;
        const float inv = mx > 0.f ? top / mx : 0.f;
        v16f a, b;
#pragma unroll
        for (int j = 0; j < 4; ++j) { a[4 * j] = v[j].x * inv; a[4 * j + 1] = v[j].y * inv; a[4 * j + 2] = v[j].z * inv; a[4 * j + 3] = v[j].w * inv;
                                      b[4 * j] = v[4 + j].x * inv; b[4 * j + 1] = v[4 + j].y * inv; b[4 * j + 2] = v[4 + j].z * inv; b[4 * j + 3] = v[4 + j].w * inv; }
        if (tab) { const v6u w = __builtin_amdgcn_cvt_scalef32_2xpk16_fp6_f32(a, b, 1.0f);
            *(u32x2*)(dst) = (u32x2){w[0], w[1]}; *(u32x2*)(dst + 8) = (u32x2){w[2], w[3]}; *(u32x2*)(dst + 16) = (u32x2){w[4], w[5]}; }
        else { unsigned w4[4] = {0u, 0u, 0u, 0u};
#define FP4_ENC(W, SRC, I, SEL) W = __builtin_amdgcn_cvt_scalef32_pk_fp4_f32(W, SRC[2 * (I)], SRC[2 * (I) + 1], 1.0f, SEL);
            FP4_ENC(w4[0], a, 0, 0) FP4_ENC(w4[0], a, 1, 1) FP4_ENC(w4[0], a, 2, 2) FP4_ENC(w4[0], a, 3, 3) FP4_ENC(w4[1], a, 4, 0) FP4_ENC(w4[1], a, 5, 1) FP4_ENC(w4[1], a, 6, 2) FP4_ENC(w4[1], a, 7, 3)
            FP4_ENC(w4[2], b, 0, 0) FP4_ENC(w4[2], b, 1, 1) FP4_ENC(w4[2], b, 2, 2) FP4_ENC(w4[2], b, 3, 3) FP4_ENC(w4[3], b, 4, 0) FP4_ENC(w4[3], b, 5, 1) FP4_ENC(w4[3], b, 6, 2) FP4_ENC(w4[3], b, 7, 3)
#undef FP4_ENC
            *(u32x4*)dst = (u32x4){w4[0], w4[1], w4[2], w4[3]}; }
        if (g == 0) sc[row] = mx / top;
    }
}

__device__ __forceinline__ void ph_peer_expert(const P& p, int li, int Mrows, int bid, int nb, bool dry) {
    using namespace peer;
    typedef float f32x2 __attribute__((ext_vector_type(2)));
    const bf16_t* HQ = (const bf16_t*)(p.ws + WS_HX); const int* IDX = (const int*)(p.ws + WS_IDX); const float* G = (const float*)(p.ws + WS_G);
    const float* X = (const float*)(p.ws + WS_X); const float* MOD = (const float*)(p.ws + WS_MOD);
    float* Xw = dry ? (float*)(p.ws + WS_HF) : (float*)(p.ws + WS_X); bf16_t* HXo = dry ? (bf16_t*)(p.ws + WS_ATT) : (bf16_t*)(p.ws + WS_HX); float* OUTw = dry ? (float*)(p.ws + WS_HF) : p.out;
    const unsigned char* UT = (const unsigned char*)(p.ws + WS_PU); const unsigned char* VT = (const unsigned char*)(p.ws + WS_PV);
    const float* SU = (const float*)(p.ws + WS_SU); const float* SV = (const float*)(p.ws + WS_SV);
    const auto rsU = __builtin_amdgcn_make_buffer_rsrc((void*)UT, 0, 16384 * 512, 0x00020000); const auto rsV = __builtin_amdgcn_make_buffer_rsrc((void*)VT, 0, 16384 * 768, 0x00020000);
    const int tid = otid(), lane = tid & 63, wave = __builtin_amdgcn_readfirstlane(tid >> 6), g = lane & 31, hb = lane >> 5;
    const bool b4 = (lane >> 4) & 1, b3 = (lane >> 3) & 1;
    const int eL = 2 * (2 * (int)b4 + (int)b3) + hb;
    const unsigned goff = (unsigned)g * 24u;
    for (int tok = bid * NWAVES + wave; tok < Mrows; tok += nb * NWAVES) {
        f32x2 hv2[16];
        { int g_t = g; asm volatile("" : "+v"(g_t)); const u32x4* hsrc = (const u32x4*)(HQ + (size_t)tok * D + g_t * 32);
#pragma unroll
          for (int j = 0; j < 4; ++j) { const u32x4 hw = hsrc[j]; hv2[4 * j] = (f32x2){pg8::bflo(hw.x), pg8::bfhi(hw.x)}; hv2[4 * j + 1] = (f32x2){pg8::bflo(hw.y), pg8::bfhi(hw.y)};
              hv2[4 * j + 2] = (f32x2){pg8::bflo(hw.z), pg8::bfhi(hw.z)}; hv2[4 * j + 3] = (f32x2){pg8::bflo(hw.w), pg8::bfhi(hw.w)}; } }
        f32x2 y2[16];
#pragma unroll
        for (int k = 0; k < 16; ++k) y2[k] = (f32x2){0.f, 0.f};
        const int* ip = IDX + (size_t)tok * 128; const float* gp = G + (size_t)tok * 128;
        int idx_nx = ip[lane & 7]; u32x4 ud[4]; v6u vd[4]; const unsigned goff4 = (unsigned)g * 16u;
#define PEER_ISSUE(dst, RS, idxreg) { _Pragma("unroll") for (int j_ = 0; j_ < 4; ++j_) { const int e0_ = __builtin_amdgcn_readlane(idxreg, 2 * j_), e1_ = __builtin_amdgcn_readlane(idxreg, 2 * j_ + 1); \
            const unsigned vo_ = (unsigned)(hb ? e1_ : e0_) * 768u + goff; const u32x4 q4_ = __builtin_amdgcn_raw_buffer_load_b128(RS, vo_, 0, 0); const u32x2 q2_ = __builtin_amdgcn_raw_buffer_load_b64(RS, vo_ + 16u, 0, 0); \
            dst[j_] = (v6u){q4_.x, q4_.y, q4_.z, q4_.w, q2_.x, q2_.y}; } __builtin_amdgcn_sched_barrier(0); }
#define PEER_ISSUE_U(idxreg) { _Pragma("unroll") for (int j_ = 0; j_ < 4; ++j_) { const int e0_ = __builtin_amdgcn_readlane(idxreg, 2 * j_), e1_ = __builtin_amdgcn_readlane(idxreg, 2 * j_ + 1); \
            ud[j_] = __builtin_amdgcn_raw_buffer_load_b128(rsU, (unsigned)(hb ? e1_ : e0_) * 512u + goff4, 0, 0); } __builtin_amdgcn_sched_barrier(0); }
        PEER_ISSUE_U(idx_nx); PEER_ISSUE(vd, rsV, idx_nx);
        for (int hu = 0; hu < 16; ++hu) {
            const int idxL = ip[hu * 8 + eL]; const float gL = gp[hu * 8 + eL] * SV[idxL]; const float suL = SU[idxL];
            if (hu < 15) idx_nx = ip[(hu + 1) * 8 + (lane & 7)];
            float part[4];
#pragma unroll
            for (int j = 0; j < 4; ++j) { const unsigned uw[4] = {ud[j].x, ud[j].y, ud[j].z, ud[j].w}; f32x2 a0 = (f32x2){0.f, 0.f}, a1 = (f32x2){0.f, 0.f};
#define FP4_FMA(ACC, KK, SEL) ACC += hv2[KK] * __builtin_amdgcn_cvt_scalef32_pk_f32_fp4(uw[(KK) >> 2], 1.0f, SEL);
                FP4_FMA(a0, 0, 0) FP4_FMA(a1, 1, 1) FP4_FMA(a0, 2, 2) FP4_FMA(a1, 3, 3) FP4_FMA(a0, 4, 0) FP4_FMA(a1, 5, 1) FP4_FMA(a0, 6, 2) FP4_FMA(a1, 7, 3)
                FP4_FMA(a0, 8, 0) FP4_FMA(a1, 9, 1) FP4_FMA(a0, 10, 2) FP4_FMA(a1, 11, 3) FP4_FMA(a0, 12, 0) FP4_FMA(a1, 13, 1) FP4_FMA(a0, 14, 2) FP4_FMA(a1, 15, 3)
#undef FP4_FMA
                a0 += a1; part[j] = a0.x + a0.y; __builtin_amdgcn_sched_barrier(0); }
            if (hu < 15) PEER_ISSUE_U(idx_nx);
            float s2[2];
#pragma unroll
            for (int k = 0; k < 2; ++k) { const float keep = b4 ? part[k + 2] : part[k], send = b4 ? part[k] : part[k + 2]; s2[k] = keep + swz_xor<16>(send); }
            float s1; { const float keep = b3 ? s2[1] : s2[0], send = b3 ? s2[0] : s2[1]; s1 = keep + swz_xor<8>(send); }
            s1 += swz_xor<4>(s1); s1 += swz_xor<1>(s1); s1 += swz_xor<2>(s1);
            const float wL = lru::fast_gelu(s1 * suL) * gL;
#pragma unroll
            for (int j = 0; j < 4; ++j) {
                const int src0 = ((j >> 1) & 1) * 16 + (j & 1) * 8;
                const float w0 = __uint_as_float(__builtin_amdgcn_readlane(__float_as_uint(wL), src0)), w1 = __uint_as_float(__builtin_amdgcn_readlane(__float_as_uint(wL), src0 + 32));
                const float wk = hb ? w1 : w0;
                const v32f z = __builtin_amdgcn_cvt_scalef32_pk32_f32_fp6(vd[j], 1.0f); const f32x2 wk2 = (f32x2){wk, wk};
#pragma unroll
                for (int k = 0; k < 16; ++k) y2[k] += wk2 * (f32x2){z[2 * k], z[2 * k + 1]};
                __builtin_amdgcn_sched_barrier(0); }
            if (hu < 15) PEER_ISSUE(vd, rsV, idx_nx);
        }
#undef PEER_ISSUE
#undef PEER_ISSUE_U
        float ye[16];
        { float yt[32];
#pragma unroll
          for (int k = 0; k < 32; ++k) { const float yk = (k & 1) ? y2[k >> 1].y : y2[k >> 1].x; auto rr = __builtin_amdgcn_permlane32_swap(__float_as_uint(yk), __float_as_uint(yk), false, false); yt[k] = __uint_as_float(rr[0]) + __uint_as_float(rr[1]); }
          float yo[32];
#pragma unroll
          for (int k = 0; k < 32; ++k) yo[fp6_src_of(k)] = yt[k];
          const unsigned hm = 0u - (unsigned)hb;
#pragma unroll
          for (int e = 0; e < 16; ++e) ye[e] = __uint_as_float(msel(__float_as_uint(yo[e]), __float_as_uint(yo[16 + e]), hm)); }
        int lane_e = lane; asm volatile("" : "+v"(lane_e));
        const int ridx = row_mod_idx(tok); const float* g2 = MOD + ((size_t)li * 9 + ridx) * 6144 + 5 * 1024; const int c0 = (lane_e & 31) * 32 + (lane_e >> 5) * 16;
        float xn[16]; float ss = 0.f; const float* xp = X + (size_t)tok * D + c0; float* xw = Xw + (size_t)tok * D + c0;
#pragma unroll
        for (int q = 0; q < 4; ++q) { const float4 xv = *(const float4*)(xp + 4 * q), gg = *(const float4*)(g2 + c0 + 4 * q);
            xn[4 * q] = xv.x + gg.x * ye[4 * q]; xn[4 * q + 1] = xv.y + gg.y * ye[4 * q + 1]; xn[4 * q + 2] = xv.z + gg.z * ye[4 * q + 2]; xn[4 * q + 3] = xv.w + gg.w * ye[4 * q + 3];
            *(float4*)(xw + 4 * q) = make_float4(xn[4 * q], xn[4 * q + 1], xn[4 * q + 2], xn[4 * q + 3]);
            ss += xn[4 * q] * xn[4 * q] + xn[4 * q + 1] * xn[4 * q + 1] + xn[4 * q + 2] * xn[4 * q + 2] + xn[4 * q + 3] * xn[4 * q + 3]; }
        const float rs = rsqrtf(wave_sum(ss) * (1.f / D) + EPS);
        if (li < DEPTH - 1) {
            const float* gN = p.norm1_g + (li + 1) * D; const float* mrow = MOD + ((size_t)(li + 1) * 9 + ridx) * 6144; float o[16];
#pragma unroll
            for (int q = 0; q < 4; ++q) { const float4 gg = *(const float4*)(gN + c0 + 4 * q), sh = *(const float4*)(mrow + c0 + 4 * q), sc = *(const float4*)(mrow + 1024 + c0 + 4 * q);
                o[4 * q] = xn[4 * q] * rs * gg.x * (1.f + sc.x) + sh.x; o[4 * q + 1] = xn[4 * q + 1] * rs * gg.y * (1.f + sc.y) + sh.y;
                o[4 * q + 2] = xn[4 * q + 2] * rs * gg.z * (1.f + sc.z) + sh.z; o[4 * q + 3] = xn[4 * q + 3] * rs * gg.w * (1.f + sc.w) + sh.w; }
            *(u32x4*)(HXo + (size_t)tok * D + c0) = (u32x4){pk2(o[0], o[1]), pk2(o[2], o[3]), pk2(o[4], o[5]), pk2(o[6], o[7])};
            *(u32x4*)(HXo + (size_t)tok * D + c0 + 8) = (u32x4){pk2(o[8], o[9]), pk2(o[10], o[11]), pk2(o[12], o[13]), pk2(o[14], o[15])};
        } else {
            float* op = OUTw + (size_t)tok * D + c0;
#pragma unroll
            for (int q = 0; q < 4; ++q) { const float4 gg = *(const float4*)(p.final_g + c0 + 4 * q);
                *(float4*)(op + 4 * q) = make_float4(xn[4 * q] * rs * gg.x, xn[4 * q + 1] * rs * gg.y, xn[4 * q + 2] * rs * gg.z, xn[4 * q + 3] * rs * gg.w); }
        }
    }
}
template <bool ROPEPERM>
__device__ __forceinline__ void p0_transpose_item(const float* W, int K, int N, bf16_t* WT, LAS float* scr, int item, int lane) {
    const int nblk = N / 32, kb = item / nblk, nbk = item % nblk, k0 = 64 * kb, n0 = 32 * nbk;
#pragma unroll 8
    for (int i = 0; i < 32; ++i) { const int kk = 2 * i + (lane >> 5); scr[kk * 33 + (lane & 31)] = W[(size_t)(k0 + kk) * N + n0 + (lane & 31)]; }
    LDS_WAIT(); asm volatile("" ::: "memory");
    const int c = lane & 7;
#pragma unroll
    for (int j = 0; j < 4; ++j) { const int n = (lane >> 3) + 8 * j; const int ns = ROPEPERM ? ((n & 1) * 16 + (n >> 1)) : n; const LAS float* s = scr + (8 * c) * 33 + ns;
        v4u o; o.x = pk2(s[0 * 33], s[1 * 33]); o.y = pk2(s[2 * 33], s[3 * 33]); o.z = pk2(s[4 * 33], s[5 * 33]); o.w = pk2(s[6 * 33], s[7 * 33]);
        *(GAS v4u*)(WT + (size_t)(n0 + n) * K + k0 + 8 * c) = o; }
    LDS_WAIT(); asm volatile("" ::: "memory");
}

__device__ __forceinline__ void ph_prologue(const P& p, int bid, int nb, unsigned char* lds) {
    const int tid = otid(), lane = tid & 63, wave = tid >> 6; const long gtid = (long)bid * NTHREADS + tid, gsz = (long)nb * NTHREADS;
    float2* R = (float2*)(p.ws + WS_ROPE);
    for (long i = gtid; i < 2048 * 32; i += gsz) { const int t = (int)(i >> 5), j = (int)(i & 31), a = j >> 4, f = j & 15;
        const float pos = a == 0 ? (float)(t >> 6) : (float)(t & 63); const float inv = exp2f(-(float)f * (13.287712379549449f / 16.0f)); const float ang = pos * inv;
        R[i] = make_float2(__cosf(ang), __sinf(ang)); }
    if (gtid < 4) { const int li = (int)gtid; const float* lp = p.diff_lam + li * 4 * 64; float s0 = 0, s1 = 0; for (int d = 0; d < 64; ++d) { s0 += lp[d] * lp[64 + d]; s1 += lp[128 + d] * lp[192 + d]; }
        ((float*)(p.ws + WS_LAM))[li] = expf(s0) - expf(s1) + lambda_init_of(li); }
    { bf16_t* KB = (bf16_t*)(p.ws + WS_KEYS); for (long i = gtid; i < (long)4 * 16 * 128 * 64; i += gsz) KB[i] = f2bf(p.peer_keys[i]); }
    {
        float* s = (float*)lds;
        for (int i = tid; i < 9 * 1024; i += NTHREADS) { const int r = i >> 10, k = i & 1023; const float v = r < 8 ? p.c[r * 1024 + k] : p.c_ctx[k]; s[i] = siluf_(v); }
        __syncthreads();
        float* MODP = (float*)(p.ws + WS_MODP);
        for (int item = bid; item < 8 * 4 * 12; item += nb) {
            const int ks = item / 48, li = (item / 12) & 3, jb = item % 12; const int j = jb * 512 + tid; const float* W = p.mod_w + ((size_t)li * 1024 + ks * 128) * 6144 + j; const float* sk = s + ks * 128;
            float a0 = 0, a1 = 0, a2 = 0, a3 = 0, a4 = 0, a5 = 0, a6 = 0, a7 = 0, a8 = 0;
#pragma unroll 4
            for (int k = 0; k < 128; ++k) { const float w = W[(size_t)k * 6144];
                a0 += sk[k] * w; a1 += sk[1024 + k] * w; a2 += sk[2048 + k] * w; a3 += sk[3072 + k] * w; a4 += sk[4096 + k] * w; a5 += sk[5120 + k] * w; a6 += sk[6144 + k] * w; a7 += sk[7168 + k] * w; a8 += sk[8192 + k] * w; }
            float* o = MODP + ((size_t)(ks * 4 + li) * 9) * 6144 + j;
            o[0 * 6144] = a0; o[1 * 6144] = a1; o[2 * 6144] = a2; o[3 * 6144] = a3; o[4 * 6144] = a4; o[5 * 6144] = a5; o[6 * 6144] = a6; o[7 * 6144] = a7; o[8 * 6144] = a8;
        }
        __syncthreads();
    }
    {
        LAS float* scr = (LAS float*)((LAS unsigned char*)lds + wave * 16384);
        const int gw = bid * NWAVES + wave, NGW = nb * NWAVES;
        constexpr int I_IN = (D / 64) * (DIN / 32), I_SQ = (D / 64) * (D / 32);
        constexpr int PER_L = I_IN + 4 * I_SQ, NITEMS = DEPTH * PER_L;
        for (int it = gw; it < NITEMS; it += NGW) {
            const int li = it / PER_L; int r = it % PER_L;
            if (r < I_IN) { const int nbk = r % (DIN / 32); const bool perm = nbk >= (C_Q / 32) && nbk < (C_V / 32);
                const float* W = p.w_in + (size_t)li * D * DIN; bf16_t* WT = (bf16_t*)(p.ws + WS_WIN_T) + (size_t)li * DIN * D;
                if (perm) p0_transpose_item<true>(W, D, DIN, WT, scr, r, lane); else p0_transpose_item<false>(W, D, DIN, WT, scr, r, lane);
                continue; }
            r -= I_IN; const int which = r / I_SQ; r %= I_SQ;
            const float* W = (which == 0 ? p.w_br_lru : which == 1 ? p.w_br_attn : which == 2 ? p.w_out : p.peer_wq) + (size_t)li * D * D;
            bf16_t* WT = (bf16_t*)(p.ws + (which == 0 ? WS_WBL_T : which == 1 ? WS_WBA_T : which == 2 ? WS_WOUT_T : WS_WQ_T)) + (size_t)li * D * D;
            p0_transpose_item<false>(W, D, D, WT, scr, r, lane);
        }
    }
}
__device__ __forceinline__ void ph_modfin(const P& p, int bid, int nb) {
    const long gtid = (long)bid * NTHREADS + otid(), gsz = (long)nb * NTHREADS; const float* MODP = (const float*)(p.ws + WS_MODP); float* MOD = (float*)(p.ws + WS_MOD);
    for (long i = gtid; i < 4 * 9 * 6144; i += gsz) { const int j = (int)(i % 6144), li = (int)(i / (9 * 6144)); float a = p.mod_b[li * 6144 + j];
#pragma unroll
        for (int ks = 0; ks < 8; ++ks) a += MODP[(size_t)ks * 4 * 9 * 6144 + i];
        MOD[i] = a; }
}

constexpr int NPL = 8;
constexpr int NSTEPS = 3 + DEPTH * NPL;

__device__ __forceinline__ void run_step(const P& p, int s, int bid, int nb, unsigned char* lds) {
    bf16_t* HX = (bf16_t*)(p.ws + WS_HX); bf16_t* PROJ = (bf16_t*)(p.ws + WS_PROJ); bf16_t* LA = (bf16_t*)(p.ws + WS_LA); bf16_t* ATT = (bf16_t*)(p.ws + WS_ATT);
    bf16_t* MIX = (bf16_t*)(p.ws + WS_MIX); bf16_t* PQ = (bf16_t*)(p.ws + WS_PQ); float* X = (float*)(p.ws + WS_X); const float* MOD = (const float*)(p.ws + WS_MOD);
    PG8_LAS unsigned char* glds = (PG8_LAS unsigned char*)lds;
    if (s == 0) { ph_prologue(p, bid, nb, lds);
#if PROBE_CAT == 11
        for (int r2 = 0; r2 < PROBE_N; ++r2) { __syncthreads(); ph_prologue(p, bid, nb, lds); }
#endif
        return; }
    if (s == 1) { ph_modfin(p, bid, nb); return; }
    if (s == 2) { ph_norm(p, bid, nb, p.norm1_g, 0, 0, 1, MT, HX, true); return; }
    const int li = (s - 3) / NPL, ph = (s - 3) % NPL; const bool do_ctx = li < DEPTH - 1; const int Mr = do_ctx ? MT : ML;
    const int extra = (PROBE_CAT != 0 && ph + 1 == PROBE_CAT) ? PROBE_N : 0;
    for (int rep = 0; rep <= extra; ++rep) { const bool dry = rep < extra;
    float* Xo = dry ? (float*)(p.ws + WS_HF) : X;
    switch (ph) {
    case 0: {
        pg8::Gemm g{HX, (const bf16_t*)(p.ws + WS_WIN_T) + (size_t)li * DIN * D, MT, DIN, D}; pg8::StaticOrder S; S.init(MT, DIN, nb, bid);
        pg8::EpiIn E{PROJ, (const float*)(p.ws + WS_ROPE)};
        pg8::gemm_phase<pg8::EpiIn, pg8::StaticOrder, true, true>(glds, g, S, E);
    } break;
    case 1: ph_lru(p, li, bid, nb, lds);
        ph_peer_tables(p, li, bid, nb);
#if PROBE_CAT == 10
        for (int r2 = 0; r2 < PROBE_N; ++r2) ph_lru(p, li, bid, nb, lds);
#endif
        ph_attn(p, li, do_ctx, bid, nb, lds);
#if PROBE_CAT == 9
        for (int r2 = 0; r2 < PROBE_N; ++r2) ph_attn(p, li, do_ctx, bid, nb, lds);
#endif
        break;
    case 2: {
        { pg8::Gemm g{LA, (const bf16_t*)(p.ws + WS_WBL_T) + (size_t)li * D * D, Mr, D, D}; pg8::StaticOrder S; S.init(Mr, D, nb, bid);
          pg8::EpiBr<false> E{PROJ, MIX, C_GA}; pg8::gemm_phase<pg8::EpiBr<false>, pg8::StaticOrder, true, true>(glds, g, S, E); }
        { pg8::Gemm g{ATT, (const bf16_t*)(p.ws + WS_WBA_T) + (size_t)li * D * D, Mr, D, D}; pg8::StaticOrder S; S.init(Mr, D, nb, bid);
          pg8::EpiBr<true> E{PROJ, MIX, C_GB}; pg8::gemm_phase<pg8::EpiBr<true>, pg8::StaticOrder, true, true>(glds, g, S, E); }
    } break;
    case 3: {
        pg8::Gemm g{MIX, (const bf16_t*)(p.ws + WS_WOUT_T) + (size_t)li * D * D, Mr, D, D}; pg8::StaticOrder S; S.init(Mr, D, nb, bid);
        pg8::EpiOut E{li == 0 ? p.x : X, li == 0 ? p.ctx - (size_t)ML * D : X, Xo, MOD + (size_t)li * 9 * 6144 + 2 * 1024};   pg8::gemm_phase<pg8::EpiOut, pg8::StaticOrder, true, true>(glds, g, S, E);
    } break;
    case 4: ph_norm(p, bid, nb, p.norm2_g + li * D, li, 3, 4, Mr, HX, false); break;
    case 5: {
        pg8::Gemm g{HX, (const bf16_t*)(p.ws + WS_WQ_T) + (size_t)li * D * D, Mr, D, D}; pg8::StaticOrder S; S.init(Mr, D, nb, bid);
        pg8::EpiPlain E{PQ}; pg8::gemm_phase<pg8::EpiPlain, pg8::StaticOrder, true, true>(glds, g, S, E);
    } break;
    case 6: ph_peer_score(p, li, Mr, bid, nb); break;
    case 7: ph_peer_expert(p, li, Mr, bid, nb, dry); break;
    }
    }
}

constexpr int RING_BYTES = 155648, LDSCTL_OFF = RING_BYTES, MISC_OFF = LDSCTL_OFF + 320, LDS_BYTES = RING_BYTES + 1024;
constexpr int CW_BAR = 4096;
#ifndef N_LAUNCH_MODE
#define N_LAUNCH_MODE 1
#endif

__global__ void __launch_bounds__(NTHREADS, 2) mega(P p) {
    extern __shared__ __attribute__((aligned(16))) unsigned char lds[];
    const int tid = threadIdx.x;
    for (int u = tid; u < (LDS_BYTES - LDSCTL_OFF) / 4; u += NTHREADS) ((LAS unsigned*)((LAS unsigned char*)lds + LDSCTL_OFF))[u] = 0u;
    __syncthreads();
    volatile LAS unsigned* MISC = (volatile LAS unsigned*)((LAS unsigned char*)lds + MISC_OFF);
    XcdBarrier bar = xcd_barrier_post((unsigned*)(p.ws + WS_CTL) + CW_BAR, MISC + 8);
    const int bid = blockIdx.x, nb = gridDim.x;
    for (int s = p.lo; s < p.hi; ++s) {
        P q = p; int bido = bid, nbo = nb;
        asm volatile("" : "+s"(bido), "+s"(nbo));
        run_step(q, s, bido, nbo, lds);
        if (s + 1 < p.hi) xcd_barrier(bar);
#if PROBE_CAT == 12
        for (int r2 = 0; r2 < PROBE_N; ++r2) xcd_barrier(bar);
#endif
    }
}

extern "C" void kernel_launch(void* const* d_in, const int* in_sizes, int n_in, void* d_out, int out_size, void* d_ws, size_t ws_size, hipStream_t stream) {
    static int grid = 0;
    if (grid == 0) {
        if (n_in != 24 || ws_size < WS_END) { fprintf(stderr, "kernel_launch: n_in %d ws %zu need %zu\n", n_in, ws_size, (size_t)WS_END); grid = -1; return; }
        int dev = 0, cus = 0, per_cu = 0;
        if (hipGetDevice(&dev) != hipSuccess || hipDeviceGetAttribute(&cus, hipDeviceAttributeMultiprocessorCount, dev) != hipSuccess) { grid = -1; return; }
        if (hipFuncSetAttribute((const void*)mega, hipFuncAttributeMaxDynamicSharedMemorySize, LDS_BYTES) != hipSuccess) { fprintf(stderr, "kernel_launch: hipFuncSetAttribute failed\n"); grid = -1; return; }
        if (hipOccupancyMaxActiveBlocksPerMultiprocessor(&per_cu, (const void*)mega, NTHREADS, LDS_BYTES) != hipSuccess || per_cu < 1) { fprintf(stderr, "kernel_launch: occupancy query says %d\n", per_cu); per_cu = 1; }
        (void)hipGetLastError();
        grid = cus > 256 ? 256 : cus;
    }
    if (grid < 0) return;
    (void)hipMemsetAsync((char*)d_ws + WS_CTL, 0, CTL_ZERO_BYTES, stream);
    P p{};
    const float** pp = (const float**)&p;
    for (int i = 0; i < 24; ++i) pp[i] = (const float*)d_in[i];
    p.out = (float*)d_out; p.ws = (unsigned char*)d_ws;
#if N_LAUNCH_MODE == 1
    p.lo = 0; p.hi = NSTEPS; hipLaunchKernelGGL(mega, dim3(grid), dim3(NTHREADS), LDS_BYTES, stream, p);
#else
    for (int s = 0; s < NSTEPS; ++s) { p.lo = s; p.hi = s + 1; hipLaunchKernelGGL(mega, dim3(grid), dim3(NTHREADS), LDS_BYTES, stream, p); }
#endif
}
```

```cpp
#include <hip/hip_runtime.h>
#include <cstdio>
#include <cstdint>

#ifndef PROBE_CAT
#define PROBE_CAT 0
#endif
#ifndef PROBE_N
#define PROBE_N 1
#endif
#define PEER_DBG_SIMPLE_REDUCE 0
#define PEER_DBG_NAIVE_EPI 0
#ifndef OPT_LRU
#define OPT_LRU 1
#endif
constexpr int D = 1024, NBATCH = 8, SEQ = 2048, CTXL = 256, DEPTH = 4;
constexpr int ML = NBATCH * SEQ, MC = NBATCH * CTXL, MT = ML + MC;
constexpr int DIN = 7168;
constexpr int C_U = 0, C_GL = 1024, C_Q = 2048, C_K = 3072, C_V = 4096, C_GA = 5120, C_GB = 6144;
constexpr float EPS = 1e-6f;
constexpr int NTHREADS = 512, NWAVES = 8;

typedef unsigned short bf16_t;
__device__ __forceinline__ float bf2f(bf16_t v) { return __uint_as_float(((unsigned)v) << 16); }
__device__ __forceinline__ unsigned pk2(float lo, float hi) { unsigned r; asm("v_cvt_pk_bf16_f32 %0, %1, %2" : "=v"(r) : "v"(lo), "v"(hi)); return r; }
__device__ __forceinline__ bf16_t f2bf(float f) { return (bf16_t)(pk2(f, f) & 0xffffu); }
__device__ __forceinline__ float sigmoidf_(float x) { return 1.f / (1.f + __expf(-x)); }
__device__ __forceinline__ float gelu_tanh(float x) { const float u = 0.7978845608028654f * (x + 0.044715f * x * x * x); return 0.5f * x * (1.f + tanhf(u)); }
__device__ __forceinline__ float siluf_(float x) { return x / (1.f + expf(-x)); }

constexpr size_t MiB = 1u << 20;
constexpr size_t WS_CTL = 0, CTL_ZERO_BYTES = 1 * MiB;
constexpr size_t WS_X = 1 * MiB;
constexpr size_t WS_HX = WS_X + (size_t)MT * D * 4;
constexpr size_t WS_PROJ = WS_HX + (size_t)MT * D * 2;
constexpr size_t WS_LA = WS_PROJ + (size_t)MT * DIN * 2;
constexpr size_t WS_ATT = WS_LA + (size_t)MT * D * 2;
constexpr size_t WS_MIX = WS_ATT + (size_t)MT * D * 2;
constexpr size_t WS_IDX = WS_MIX + (size_t)MT * D * 2;
constexpr size_t WS_G = WS_IDX + (size_t)MT * 128 * 4;
constexpr size_t WS_MOD = WS_G + (size_t)MT * 128 * 4;
constexpr size_t WS_ROPE = WS_MOD + (size_t)4 * 9 * 6144 * 4;
constexpr size_t WS_LAM = WS_ROPE + (size_t)2048 * 32 * 2 * 4;
constexpr size_t WS_MODP = WS_LAM + 256;
constexpr size_t WS_WIN_T = WS_MODP + (size_t)8 * 4 * 9 * 6144 * 4;
constexpr size_t WS_WBL_T = WS_WIN_T + (size_t)4 * DIN * D * 2;
constexpr size_t WS_WBA_T = WS_WBL_T + (size_t)4 * D * D * 2;
constexpr size_t WS_WOUT_T = WS_WBA_T + (size_t)4 * D * D * 2;
constexpr size_t WS_WQ_T = WS_WOUT_T + (size_t)4 * D * D * 2;
constexpr size_t WS_STASH = WS_WQ_T + (size_t)4 * D * D * 2;
constexpr size_t WS_KEYS = WS_STASH + (size_t)256 * 8 * 64 * 64 * 4;
constexpr size_t WS_PU = WS_KEYS + (size_t)4 * 16 * 128 * 64 * 2;
constexpr size_t WS_PV = WS_PU + (size_t)16384 * 1024;
constexpr size_t WS_SU = WS_PV + (size_t)16384 * 1024;
constexpr size_t WS_SV = WS_SU + (size_t)16384 * 4;
constexpr size_t WS_HF = WS_SV + (size_t)16384 * 4;
constexpr size_t WS_UC = WS_HF;
constexpr size_t WS_HD = WS_UC + (size_t)MT * D * 4;
#if OPT_LRU
constexpr size_t WS_END = WS_HF + (size_t)MT * D * 4;
#else
constexpr size_t WS_END = WS_HD + (size_t)2 * MT * D * 4;
#endif
#define WS_PQ WS_LA

struct P {
    const float *x, *c, *ctx, *c_ctx, *mod_w, *mod_b, *norm1_g, *norm2_g, *w_in, *conv_w, *conv_b, *lru_w, *lru_b, *lru_lam, *diff_lam, *subln_g,
        *w_br_lru, *w_br_attn, *w_out, *peer_wq, *peer_keys, *peer_u, *peer_v, *final_g;
    float* out; unsigned char* ws; int lo, hi;
};

__device__ __forceinline__ int otid() { int t = threadIdx.x; asm volatile("" : "+v"(t)); return t; }
__device__ __forceinline__ int row_mod_idx(int row) { return row < ML ? (row >> 11) : 8; }
__device__ __forceinline__ float lambda_init_of(int li) { return 0.8f - 0.6f * expf(-0.3f * (float)li); }

namespace pg8 {
#define PG8_LAS __attribute__((address_space(3)))
typedef unsigned short bf16_t;
typedef short bf16x8 __attribute__((ext_vector_type(8)));
typedef float f32x4 __attribute__((ext_vector_type(4)));
typedef unsigned u32x4 __attribute__((ext_vector_type(4)));
constexpr int BM = 256, BK = 64, HALF = 128, HTB = HALF * BK * 2  , STAGE_BYTES = 8 * HTB, NXCD = 8, WGM = 8;

__host__ __device__ __forceinline__ int lds_byte(int r, int c) { const int st = (r >> 4) * 2 + (c >> 5), rr = r & 15, cc = c & 31, ob = rr * 64 + cc * 2; return st * 1024 + (ob ^ (((ob >> 9) & 1) << 5)); }
__host__ __device__ __forceinline__ void stage_rc(int b, int& R, int& C) { const int st = b / 1024, sb = b % 1024, swz = sb ^ (((sb >> 9) & 1) << 5); R = (st >> 1) * 16 + swz / 64; C = (st & 1) * 32 + (swz % 64) / 2; }
__host__ __device__ __forceinline__ int perm32(int rho) { const int n = rho >> 4, i = rho & 15; return 8 * (i >> 2) + 4 * n + (i & 3); }

struct Unit { int pm, pn; };
struct Gemm { const bf16_t* A; const bf16_t* Bt; int M, N, K; };

struct StaticOrder {
    int nM, nN, nwg, G, c;
    __host__ __device__ void init(int M, int N, int G_, int c_) { nM = M / BM; nN = N / BM; nwg = nM * nN; G = G_; c = c_; }
    __host__ __device__ bool next(int i, Unit& u) const {
        const long L = (long)i * G + c; if (L >= nwg) return false;
        int wgid = (int)L; { const int q = nwg / NXCD, r = nwg % NXCD, xcd = wgid % NXCD, off = wgid / NXCD; wgid = (xcd < r ? xcd * (q + 1) : r * (q + 1) + (xcd - r) * q) + off; }
        const int nig = WGM * nN, gid = wgid / nig, fm = gid * WGM, gsz = (nM - fm) < WGM ? (nM - fm) : WGM;
        u.pm = fm + ((wgid % nig) % gsz); u.pn = (wgid % nig) / gsz; return true;
    }
    __device__ __forceinline__ void a_ready(const Unit&) const {}
    __device__ __forceinline__ void done(const Unit&) const {}
};

__device__ __forceinline__ unsigned cvt_pk_bf16(float lo, float hi) { unsigned r; asm volatile("v_cvt_pk_bf16_f32 %0, %1, %2" : "=v"(r) : "v"(lo), "v"(hi)); return r; }
typedef float f32x2 __attribute__((ext_vector_type(2)));
__device__ __forceinline__ f32x2 gelu_pk(f32x2 v) {
    const f32x2 av = __builtin_elementwise_abs(v), d = av * 0.2316418882f + 1.0f;
    f32x2 t; t.x = __builtin_amdgcn_rcpf(d.x); t.y = __builtin_amdgcn_rcpf(d.y);
    f32x2 q = t * 0.5307027145f + (-0.7265760135f); q = q * t + 0.7107068705f; q = q * t + (-0.142248368f); q = q * t + 0.127414796f; q = q * t;
    const f32x2 s = (v * v) * (-0.72134752044f);
    f32x2 e; e.x = __builtin_amdgcn_exp2f(s.x); e.y = __builtin_amdgcn_exp2f(s.y);
    const f32x2 m = v * (q * e), r = v - m;
    f32x2 o; o.x = v.x < 0.f ? m.x : r.x; o.y = v.y < 0.f ? m.y : r.y; return o;
}

template <int ACT  > struct EpiBf16 {
    static constexpr bool PERM = true, AFTER_DRAIN = false; static_assert(ACT == 0 || ACT == 1, "EpiBf16: ACT is 0 (none) or 1 (gelu_pk)");
    bf16_t* O; int ldc; const float* bias; int split_cols; size_t split_stride; float scale0;
    __device__ __forceinline__ void operator()(const f32x4 (&acc)[2][2][4][2], const Unit& u, int wr, int wc, int fr, int fq) const {
        const int row0 = u.pm * BM + wr * 64 + fr; int colt = u.pn * BM; bf16_t* base = O;
        float sc = 1.f; if (split_cols) { const int t = colt / split_cols; base += (size_t)t * split_stride; colt -= t * split_cols; if (t == 0) sc = scale0; }
        const int col0 = colt + wc * 32 + 8 * fq, bcol0 = u.pn * BM + wc * 32 + 8 * fq;
        f32x4 bv[2][2];
#pragma unroll
        for (int bj = 0; bj < 2; ++bj)
#pragma unroll
            for (int n = 0; n < 2; ++n) bv[bj][n] = bias ? *(const f32x4*)(bias + bcol0 + bj * HALF + 4 * n) : (f32x4){0.f, 0.f, 0.f, 0.f};
#pragma unroll
        for (int ai = 0; ai < 2; ++ai)
#pragma unroll
            for (int m = 0; m < 4; ++m) { bf16_t* rowp = base + (size_t)(row0 + ai * HALF + m * 16) * ldc + col0;
#pragma unroll
                for (int bj = 0; bj < 2; ++bj) { f32x4 v0 = acc[ai][bj][m][0] + bv[bj][0], v1 = acc[ai][bj][m][1] + bv[bj][1];
                    if (ACT == 1) { f32x2 a = gelu_pk((f32x2){v0[0], v0[1]}), b = gelu_pk((f32x2){v0[2], v0[3]}), c = gelu_pk((f32x2){v1[0], v1[1]}), d = gelu_pk((f32x2){v1[2], v1[3]});
                        v0 = (f32x4){a.x, a.y, b.x, b.y}; v1 = (f32x4){c.x, c.y, d.x, d.y}; }
                    v0 = v0 * sc; v1 = v1 * sc; u32x4 w; w.x = cvt_pk_bf16(v0[0], v0[1]); w.y = cvt_pk_bf16(v0[2], v0[3]); w.z = cvt_pk_bf16(v1[0], v1[1]); w.w = cvt_pk_bf16(v1[2], v1[3]);
                    *(u32x4*)(rowp + bj * HALF) = w; } }
    }
};
__device__ __forceinline__ float bflo(unsigned w) { return __uint_as_float(w << 16); }
__device__ __forceinline__ float bfhi(unsigned w) { return __uint_as_float(w & 0xffff0000u); }
__device__ __forceinline__ float sigm(float x) { return 1.f / (1.f + __expf(-x)); }

struct EpiIn {
    static constexpr bool PERM = true, AFTER_DRAIN = false;
    bf16_t* O; const float* rope;
    __device__ __forceinline__ void operator()(const f32x4 (&acc)[2][2][4][2], const Unit& u, int wr, int wc, int fr, int fq) const {
        const int row0 = u.pm * BM + wr * 64 + fr, col0 = u.pn * BM + wc * 32 + 8 * fq;
        const bool dorope = (u.pn >= 8) && (u.pn < 16) && (u.pm < 64);
        const int i0 = ((wc & 1) << 4) + 4 * fq;
        const bool qscale = (u.pn >= 8) && (u.pn < 12); constexpr float QSC = 0.125f * 1.4426950408889634f;
#pragma unroll
        for (int ai = 0; ai < 2; ++ai)
#pragma unroll
            for (int m = 0; m < 4; ++m) { const int row = row0 + ai * HALF + m * 16; bf16_t* rowp = O + (size_t)row * DIN + col0;
                f32x4 r0 = {1.f, 0.f, 1.f, 0.f}, r1 = {1.f, 0.f, 1.f, 0.f};
                if (dorope) { const f32x4* rp = (const f32x4*)(rope + ((size_t)(row & 2047) * 32 + i0) * 2); r0 = rp[0]; r1 = rp[1]; }
#pragma unroll
                for (int bj = 0; bj < 2; ++bj) { f32x4 v0 = acc[ai][bj][m][0], v1 = acc[ai][bj][m][1];
                    if (dorope) { f32x4 a, b;
                        a[0] = v0[0] * r0[0] - v0[1] * r0[1]; a[1] = v0[1] * r0[0] + v0[0] * r0[1]; a[2] = v0[2] * r0[2] - v0[3] * r0[3]; a[3] = v0[3] * r0[2] + v0[2] * r0[3];
                        b[0] = v1[0] * r1[0] - v1[1] * r1[1]; b[1] = v1[1] * r1[0] + v1[0] * r1[1]; b[2] = v1[2] * r1[2] - v1[3] * r1[3]; b[3] = v1[3] * r1[2] + v1[2] * r1[3];
                        v0 = a; v1 = b; }
                    if (qscale) { v0 *= QSC; v1 *= QSC; }
                    u32x4 w; w.x = cvt_pk_bf16(v0[0], v0[1]); w.y = cvt_pk_bf16(v0[2], v0[3]); w.z = cvt_pk_bf16(v1[0], v1[1]); w.w = cvt_pk_bf16(v1[2], v1[3]);
                    *(u32x4*)(rowp + bj * HALF) = w; } }
    }
};
struct EpiPlain {
    static constexpr bool PERM = true, AFTER_DRAIN = false;
    bf16_t* O;
    __device__ __forceinline__ void operator()(const f32x4 (&acc)[2][2][4][2], const Unit& u, int wr, int wc, int fr, int fq) const {
        const int row0 = u.pm * BM + wr * 64 + fr, col0 = u.pn * BM + wc * 32 + 8 * fq;
#pragma unroll
        for (int ai = 0; ai < 2; ++ai)
#pragma unroll
            for (int m = 0; m < 4; ++m) { bf16_t* rowp = O + (size_t)(row0 + ai * HALF + m * 16) * D + col0;
#pragma unroll
                for (int bj = 0; bj < 2; ++bj) { const f32x4 v0 = acc[ai][bj][m][0], v1 = acc[ai][bj][m][1];
                    u32x4 w; w.x = cvt_pk_bf16(v0[0], v0[1]); w.y = cvt_pk_bf16(v0[2], v0[3]); w.z = cvt_pk_bf16(v1[0], v1[1]); w.w = cvt_pk_bf16(v1[2], v1[3]);
                    *(u32x4*)(rowp + bj * HALF) = w; } }
    }
};
template <bool ADD> struct EpiBr {
    static constexpr bool PERM = true, AFTER_DRAIN = false;
    const bf16_t* PROJ; bf16_t* MIX; int gcol;
    __device__ __forceinline__ void operator()(const f32x4 (&acc)[2][2][4][2], const Unit& u, int wr, int wc, int fr, int fq) const {
        const int row0 = u.pm * BM + wr * 64 + fr, col0 = u.pn * BM + wc * 32 + 8 * fq;
#pragma unroll
        for (int ai = 0; ai < 2; ++ai)
#pragma unroll
            for (int m = 0; m < 4; ++m) { const int row = row0 + ai * HALF + m * 16; bf16_t* rowp = MIX + (size_t)row * D + col0; const bf16_t* gp = PROJ + (size_t)row * DIN + gcol + col0;
#pragma unroll
                for (int bj = 0; bj < 2; ++bj) { const f32x4 v0 = acc[ai][bj][m][0], v1 = acc[ai][bj][m][1]; const u32x4 g = *(const u32x4*)(gp + bj * HALF);
                    float o[8] = {sigm(bflo(g.x)) * v0[0], sigm(bfhi(g.x)) * v0[1], sigm(bflo(g.y)) * v0[2], sigm(bfhi(g.y)) * v0[3], sigm(bflo(g.z)) * v1[0], sigm(bfhi(g.z)) * v1[1], sigm(bflo(g.w)) * v1[2], sigm(bfhi(g.w)) * v1[3]};
                    if (ADD) { const u32x4 q = *(const u32x4*)(rowp + bj * HALF); o[0] += bflo(q.x); o[1] += bfhi(q.x); o[2] += bflo(q.y); o[3] += bfhi(q.y); o[4] += bflo(q.z); o[5] += bfhi(q.z); o[6] += bflo(q.w); o[7] += bfhi(q.w); }
                    u32x4 w; w.x = cvt_pk_bf16(o[0], o[1]); w.y = cvt_pk_bf16(o[2], o[3]); w.z = cvt_pk_bf16(o[4], o[5]); w.w = cvt_pk_bf16(o[6], o[7]);
                    *(u32x4*)(rowp + bj * HALF) = w; } }
    }
};
struct EpiOut {
    static constexpr bool PERM = true, AFTER_DRAIN = false;
    const float* Xlat; const float* Xctx; float* Xo; const float* MODL;
    __device__ __forceinline__ void operator()(const f32x4 (&acc)[2][2][4][2], const Unit& u, int wr, int wc, int fr, int fq) const {
        const int row0 = u.pm * BM + wr * 64 + fr, col0 = u.pn * BM + wc * 32 + 8 * fq;
        const float* g1 = MODL + (size_t)(u.pm < 64 ? (u.pm >> 3) : 8) * 6144 + col0;
        f32x4 gv[2][2];
#pragma unroll
        for (int bj = 0; bj < 2; ++bj) { gv[bj][0] = *(const f32x4*)(g1 + bj * HALF); gv[bj][1] = *(const f32x4*)(g1 + bj * HALF + 4); }
#pragma unroll
        for (int ai = 0; ai < 2; ++ai)
#pragma unroll
            for (int m = 0; m < 4; ++m) { const size_t ro = (size_t)(row0 + ai * HALF + m * 16) * D + col0; const float* rowp = (u.pm < 64 ? Xlat : Xctx) + ro; float* rowo = Xo + ro;
#pragma unroll
                for (int bj = 0; bj < 2; ++bj) { const f32x4* xp = (const f32x4*)(rowp + bj * HALF); f32x4* xo = (f32x4*)(rowo + bj * HALF); f32x4 x0 = xp[0], x1 = xp[1];
                    x0 += gv[bj][0] * acc[ai][bj][m][0]; x1 += gv[bj][1] * acc[ai][bj][m][1]; xo[0] = x0; xo[1] = x1; } }
    }
};
template <class Epi, class Sched, bool ALIGN_EPI = false, bool SP2 = false>
__device__ __forceinline__ void gemm_phase(PG8_LAS unsigned char* lds, const Gemm g, const Sched& S, const Epi& E) {
    const int tid = otid(), wid = __builtin_amdgcn_readfirstlane(tid >> 6), lane = tid & 63, wr = wid >> 2, wc = wid & 3, fr = lane & 15, fq = lane >> 4;
    const int K = g.K, nt = K / BK;
    unsigned voffA[2], voffB[2];
#pragma unroll
    for (int i = 0; i < 2; ++i) { int R, C; stage_rc(tid * 16 + i * 8192, R, C); const int Rb = Epi::PERM ? ((R & ~31) + perm32(R & 31)) : R;
        voffA[i] = (unsigned)(R * K + C) * 2u; voffB[i] = (unsigned)(Rb * K + C) * 2u; }
    const size_t kstep = (size_t)(BK * 2);
    const size_t hstep = (size_t)HALF * K * 2;
    const size_t tstep = 2 * hstep;
    const unsigned ldsw = (unsigned)wid * 1024u;
    const int aoff = lds_byte(wr * 64 + fr, fq * 8), boff = lds_byte(wc * 32 + fr, fq * 8);
#define PG8_SA(b, h) (((b) * 2 + (h)) * HTB)
#define PG8_SB(b, h) ((4 + (b) * 2 + (h)) * HTB)
#define PG8_STAGE(bufoff, gbase, voff) do { _Pragma("unroll") for (int _i = 0; _i < 2; ++_i) \
        __builtin_amdgcn_global_load_lds((const unsigned*)((const char*)(gbase) + (voff)[_i]), (PG8_LAS unsigned*)(lds + (bufoff) + ldsw + _i * 8192), 16, 0, 0); } while (0)
#define PG8_LDA(dst, b, h) do { _Pragma("unroll") for (int m = 0; m < 4; ++m) _Pragma("unroll") for (int k = 0; k < 2; ++k) dst[m][k] = *(const PG8_LAS bf16x8*)(lds + PG8_SA(b, h) + aoff + m * 2048 + k * 1024); } while (0)
#define PG8_LDB(dst, b, h) do { _Pragma("unroll") for (int n = 0; n < 2; ++n) _Pragma("unroll") for (int k = 0; k < 2; ++k) dst[n][k] = *(const PG8_LAS bf16x8*)(lds + PG8_SB(b, h) + boff + n * 2048 + k * 1024); } while (0)
#define PG8_MMA(ai, bj, At, Bt) do { __builtin_amdgcn_s_setprio(1); _Pragma("unroll") for (int m = 0; m < 4; ++m) _Pragma("unroll") for (int n = 0; n < 2; ++n) _Pragma("unroll") for (int k = 0; k < 2; ++k) \
        acc[ai][bj][m][n] = __builtin_amdgcn_mfma_f32_16x16x32_bf16(Bt[n][k], At[m][k], acc[ai][bj][m][n], 0, 0, 0); __builtin_amdgcn_s_setprio(0); } while (0)
#define PG8_WAIT_V(n) asm volatile("s_waitcnt vmcnt(" #n ")" ::: "memory")
#define PG8_WAIT_L(n) asm volatile("s_waitcnt lgkmcnt(" #n ")" ::: "memory")
#define PG8_BAR __builtin_amdgcn_s_barrier()
#define PG8_SCHED __builtin_amdgcn_sched_barrier(0)
    Unit cur, nxt; int ui = 0;
    if (!S.next(0, cur)) return;
    f32x4 acc[2][2][4][2];
#pragma unroll
    for (int a = 0; a < 2; ++a)
#pragma unroll
        for (int b = 0; b < 2; ++b)
#pragma unroll
            for (int m = 0; m < 4; ++m)
#pragma unroll
                for (int n = 0; n < 2; ++n) acc[a][b][m][n] = (f32x4){0.f, 0.f, 0.f, 0.f};
    bf16x8 At[4][2], B0[2][2], B1[2][2];
    const char* cA = (const char*)g.A + (size_t)cur.pm * tstep; const char* cB = (const char*)g.Bt + (size_t)cur.pn * tstep;
    S.a_ready(cur);
    if constexpr (SP2) {
        PG8_STAGE(PG8_SB(0, 0), cB, voffB); PG8_STAGE(PG8_SB(0, 1), cB + hstep, voffB); PG8_STAGE(PG8_SA(0, 0), cA, voffA); PG8_STAGE(PG8_SA(0, 1), cA + hstep, voffA);
        if (wr == 1) PG8_BAR;
        PG8_WAIT_V(2); PG8_BAR;
        PG8_STAGE(PG8_SB(1, 0), cB + kstep, voffB); PG8_STAGE(PG8_SA(1, 0), cA + kstep, voffA); PG8_STAGE(PG8_SB(1, 1), cB + hstep + kstep, voffB);
        PG8_WAIT_V(6); PG8_BAR;
    } else {
        PG8_STAGE(PG8_SB(0, 0), cB, voffB); PG8_STAGE(PG8_SA(0, 0), cA, voffA); PG8_STAGE(PG8_SB(0, 1), cB + hstep, voffB); PG8_STAGE(PG8_SA(0, 1), cA + hstep, voffA);
        if (wr == 1) PG8_BAR;
        PG8_WAIT_V(4); PG8_BAR;
        PG8_STAGE(PG8_SB(1, 0), cB + kstep, voffB); PG8_STAGE(PG8_SA(1, 0), cA + kstep, voffA); PG8_STAGE(PG8_SB(1, 1), cB + hstep + kstep, voffB);
        PG8_WAIT_V(6); PG8_BAR;
    }
    for (;;) {
        const bool has_next = S.next(ui + 1, nxt);
        const char* nA = has_next ? (const char*)g.A + (size_t)nxt.pm * tstep : cA; const char* nB = has_next ? (const char*)g.Bt + (size_t)nxt.pn * tstep : cB;
        for (int t = 0; t < nt; t += 2) {
            const bool last = (t == nt - 2);
            const char* a1 = cA + (size_t)(t + 1) * kstep;
            const char* a2 = last ? nA : cA + (size_t)(t + 2) * kstep; const char* b2 = last ? nB : cB + (size_t)(t + 2) * kstep;
            const char* a3 = a2 + kstep; const char* b3 = b2 + kstep;
            if (last && has_next) S.a_ready(nxt);
            if constexpr (SP2) {
            PG8_LDB(B0, 0, 0); PG8_LDB(B1, 0, 1); PG8_SCHED; PG8_LDA(At, 0, 0); PG8_STAGE(PG8_SA(1, 1), a1 + hstep, voffA);
            PG8_WAIT_V(8); PG8_WAIT_L(0); PG8_BAR; PG8_MMA(0, 0, At, B0); PG8_MMA(0, 1, At, B1); PG8_BAR; PG8_SCHED;
            PG8_LDA(At, 0, 1); PG8_STAGE(PG8_SB(0, 0), b2, voffB); PG8_STAGE(PG8_SB(0, 1), b2 + hstep, voffB); PG8_STAGE(PG8_SA(0, 0), a2, voffA);
            PG8_WAIT_V(8); PG8_WAIT_L(0); PG8_BAR; PG8_MMA(1, 0, At, B0); PG8_MMA(1, 1, At, B1); PG8_BAR; PG8_SCHED;
            PG8_LDB(B0, 1, 0); PG8_LDB(B1, 1, 1); PG8_SCHED; PG8_LDA(At, 1, 0); PG8_STAGE(PG8_SA(0, 1), a2 + hstep, voffA);
            PG8_WAIT_V(8); PG8_WAIT_L(0); PG8_BAR; PG8_MMA(0, 0, At, B0); PG8_MMA(0, 1, At, B1); PG8_BAR; PG8_SCHED;
            PG8_LDA(At, 1, 1); PG8_STAGE(PG8_SB(1, 0), b3, voffB); PG8_STAGE(PG8_SB(1, 1), b3 + hstep, voffB); PG8_STAGE(PG8_SA(1, 0), a3, voffA);
            PG8_WAIT_V(8); PG8_WAIT_L(0); PG8_BAR; PG8_MMA(1, 0, At, B0); PG8_MMA(1, 1, At, B1); PG8_BAR; PG8_SCHED;
            } else {
            PG8_LDB(B0, 0, 0); PG8_SCHED; PG8_LDA(At, 0, 0); PG8_STAGE(PG8_SA(1, 1), a1 + hstep, voffA);
            PG8_WAIT_L(8); PG8_BAR; PG8_WAIT_L(0); PG8_MMA(0, 0, At, B0); PG8_BAR; PG8_SCHED;
            PG8_LDB(B1, 0, 1); PG8_STAGE(PG8_SB(0, 0), b2, voffB);
            PG8_BAR; PG8_WAIT_L(0); PG8_MMA(0, 1, At, B1); PG8_BAR;
            PG8_LDA(At, 0, 1); PG8_STAGE(PG8_SA(0, 0), a2, voffA);
            PG8_BAR; PG8_WAIT_L(0); PG8_MMA(1, 0, At, B0); PG8_BAR; PG8_SCHED;
            PG8_STAGE(PG8_SB(0, 1), b2 + hstep, voffB);
            PG8_WAIT_V(6); PG8_BAR; PG8_MMA(1, 1, At, B1); PG8_BAR;
            PG8_LDB(B0, 1, 0); PG8_SCHED; PG8_LDA(At, 1, 0); PG8_STAGE(PG8_SA(0, 1), a2 + hstep, voffA);
            PG8_WAIT_L(8); PG8_BAR; PG8_WAIT_L(0); PG8_MMA(0, 0, At, B0); PG8_BAR; PG8_SCHED;
            PG8_LDB(B1, 1, 1); PG8_STAGE(PG8_SB(1, 0), b3, voffB);
            PG8_BAR; PG8_WAIT_L(0); PG8_MMA(0, 1, At, B1); PG8_BAR;
            PG8_LDA(At, 1, 1); PG8_STAGE(PG8_SA(1, 0), a3, voffA);
            PG8_BAR; PG8_WAIT_L(0); PG8_MMA(1, 0, At, B0); PG8_BAR; PG8_SCHED;
            PG8_STAGE(PG8_SB(1, 1), b3 + hstep, voffB);
            PG8_WAIT_V(6); PG8_BAR; PG8_MMA(1, 1, At, B1); PG8_BAR;
            }
        }
        if constexpr (ALIGN_EPI) { if (wr == 0) PG8_BAR; }
        if constexpr (!Epi::AFTER_DRAIN) { E(acc, cur, wr, wc, fr, fq); S.done(cur); }
        if (!has_next) break;
#pragma unroll
        for (int a = 0; a < 2; ++a)
#pragma unroll
            for (int b = 0; b < 2; ++b)
#pragma unroll
                for (int m = 0; m < 4; ++m)
#pragma unroll
                    for (int n = 0; n < 2; ++n) acc[a][b][m][n] = (f32x4){0.f, 0.f, 0.f, 0.f};
        cur = nxt; cA = nA; cB = nB; ++ui;
        if constexpr (ALIGN_EPI) { if (wr == 1) PG8_BAR; }
    }
    PG8_WAIT_V(0);
    if constexpr (!ALIGN_EPI) { if (wr == 0) PG8_BAR; }
    PG8_BAR;
    if constexpr (Epi::AFTER_DRAIN) { E.fused(acc, cur, wr, wc, fr, fq, lds, wid, lane); S.done(cur); }
#undef PG8_SA
#undef PG8_SB
#undef PG8_STAGE
#undef PG8_LDA
#undef PG8_LDB
#undef PG8_MMA
#undef PG8_WAIT_V
#undef PG8_WAIT_L
#undef PG8_BAR
#undef PG8_SCHED
}
}

#define GAS __attribute__((address_space(1)))
#define LAS __attribute__((address_space(3)))
typedef unsigned v4u __attribute__((ext_vector_type(4)));
typedef GAS unsigned gu32;
#define RLX_AGENT __ATOMIC_RELAXED, __HIP_MEMORY_SCOPE_AGENT
#define LDS_WAIT() asm volatile("s_waitcnt lgkmcnt(0)" ::: "memory")
#define XB_TMO      128
#define XB_XCNT(j)  (256  + 64 * (j))
#define XB_XSUB(j)  (1280 + 64 * (j))
#define XB_XGEN(j)  (2304 + 64 * (j))
#define XB_TOP      3328
#define XB_TOPGEN   3392
#define XCD_BAR_WORDS 3456
#define XB_SPIN_CAP (1u << 18)

__device__ __forceinline__ unsigned xb_ld(unsigned* p)              { return __hip_atomic_load(p, __ATOMIC_RELAXED, __HIP_MEMORY_SCOPE_AGENT); }
__device__ __forceinline__ unsigned xb_add(unsigned* p, unsigned v) { return __hip_atomic_fetch_add(p, v, __ATOMIC_RELAXED, __HIP_MEMORY_SCOPE_AGENT); }
__device__ __forceinline__ unsigned xb_xcc_id() { return (unsigned)__builtin_amdgcn_s_getreg((3 << 11) | 20) & 0xFu; }
#define XB_SPIN(cond, bar) do { unsigned _sp = 0; while (cond) { __builtin_amdgcn_s_sleep(1); \
    if ((++_sp & 255u) == 0u) { if (xb_ld(&(bar)[XB_TMO])) break; if (_sp > XB_SPIN_CAP) { atomicAdd(&(bar)[XB_TMO], 1u); break; } } } } while (0)

struct XcdBarrier {
    unsigned* bar; unsigned x;
    volatile LAS unsigned* st;
};

__device__ __forceinline__ XcdBarrier xcd_barrier_post(unsigned* bar, volatile LAS unsigned* st) {
    XcdBarrier b; b.bar = bar; b.x = xb_xcc_id(); b.st = st;
    if (threadIdx.x == 0) (void)xb_add(&bar[XB_XCNT(b.x)], 1u);
    return b;
}
__device__ __forceinline__ void xcd_barrier_complete(unsigned* bar, unsigned x, unsigned& nloc, unsigned& nx) {
    const unsigned G = gridDim.x * gridDim.y * gridDim.z;
    unsigned sum, cnt, mine, sp = 0u;
    for (;;) {
        sum = 0u; cnt = 0u; mine = 0u;
#pragma unroll
        for (unsigned j = 0; j < 16; ++j) { const unsigned c = xb_ld(&bar[XB_XCNT(j)]); sum += c; cnt += (c > 0u) ? 1u : 0u; mine = (j == x) ? c : mine; }
        if (sum == G) break;
        __builtin_amdgcn_s_sleep(1);
        if ((++sp & 255u) == 0u) { if (xb_ld(&bar[XB_TMO])) break; if (sp > XB_SPIN_CAP) { atomicAdd(&bar[XB_TMO], 1u); break; } }
    }
    nloc = mine > 0u ? mine : 1u; nx = cnt > 0u ? cnt : 1u;
}

__device__ __forceinline__ void xcd_barrier(const XcdBarrier& b) {
    asm volatile("s_waitcnt vmcnt(0)" ::: "memory");
    __syncthreads();
    if (threadIdx.x == 0) {
        unsigned* bar = b.bar; asm volatile("" : "+s"(bar));
        __builtin_amdgcn_s_waitcnt(0);
        unsigned nloc = b.st[0], nx = b.st[1];
        if (nloc == 0u) { xcd_barrier_complete(bar, b.x, nloc, nx); b.st[0] = nloc; b.st[1] = nx; }
        const unsigned old = xb_add(&bar[XB_XSUB(b.x)], 1u);
        const unsigned gen = old / nloc;
        if (old + 1u == (gen + 1u) * nloc) {
            __builtin_amdgcn_fence(__ATOMIC_RELEASE, "agent");
            asm volatile("s_waitcnt vmcnt(0)" ::: "memory");
            const unsigned og = xb_add(&bar[XB_TOP], 1u);
            const unsigned tg = og / nx;
            if (og + 1u == (tg + 1u) * nx) xb_add(&bar[XB_TOPGEN], 1u);
            else XB_SPIN(xb_ld(&bar[XB_TOPGEN]) == tg, bar);
            __builtin_amdgcn_fence(__ATOMIC_ACQUIRE, "agent");
            xb_add(&bar[XB_XGEN(b.x)], 1u);
            asm volatile("s_waitcnt vmcnt(0)" ::: "memory");
        } else {
            XB_SPIN(xb_ld(&bar[XB_XGEN(b.x)]) == gen, bar);
            __builtin_amdgcn_fence(__ATOMIC_ACQUIRE, "agent");
            asm volatile("s_waitcnt vmcnt(0)" ::: "memory");
        }
    }
    __syncthreads();
}

template <int O> __device__ __forceinline__ float swz_xor(float v) { return __uint_as_float((unsigned)__builtin_amdgcn_ds_swizzle((int)__float_as_uint(v), (O << 10) | 0x1F)); }
template <int O> __device__ __forceinline__ int swz_xor_i(int v) { return __builtin_amdgcn_ds_swizzle(v, (O << 10) | 0x1F); }
__device__ __forceinline__ float wave_sum(float v) {
    v += swz_xor<1>(v); v += swz_xor<2>(v); v += swz_xor<4>(v); v += swz_xor<8>(v); v += swz_xor<16>(v);
    auto rr = __builtin_amdgcn_permlane32_swap(__float_as_uint(v), __float_as_uint(v), false, false);
    return __uint_as_float(rr[0]) + __uint_as_float(rr[1]);
}

__device__ __forceinline__ void ph_norm(const P& p, int bid, int nb, const float* g, int li, int sh_i, int sc_i, int Mrows, bf16_t* out, bool from_inputs) {
    const int lane = otid() & 63, wave = otid() >> 6; const float* X = (const float*)(p.ws + WS_X); const float* MOD = (const float*)(p.ws + WS_MOD);
    for (int row = bid * 8 + wave; row < Mrows; row += nb * 8) {
        const float4* xr = (const float4*)(from_inputs ? (row < ML ? p.x + (size_t)row * D : p.ctx + (size_t)(row - ML) * D) : X + (size_t)row * D); float4 v[4]; float ss = 0;
#pragma unroll
        for (int j = 0; j < 4; ++j) { v[j] = xr[64 * j + lane]; ss += v[j].x * v[j].x + v[j].y * v[j].y + v[j].z * v[j].z + v[j].w * v[j].w; }
        const float rs = rsqrtf(wave_sum(ss) * (1.f / D) + EPS);
        const float* mrow = MOD + ((size_t)li * 9 + row_mod_idx(row)) * 6144;
#pragma unroll
        for (int j = 0; j < 4; ++j) { const int c0 = (64 * j + lane) * 4; const float4 gg = *(const float4*)(g + c0), sh = *(const float4*)(mrow + sh_i * 1024 + c0), sc = *(const float4*)(mrow + sc_i * 1024 + c0);
            ushort4 o; o.x = f2bf(v[j].x * rs * gg.x * (1.f + sc.x) + sh.x); o.y = f2bf(v[j].y * rs * gg.y * (1.f + sc.y) + sh.y); o.z = f2bf(v[j].z * rs * gg.z * (1.f + sc.z) + sh.z); o.w = f2bf(v[j].w * rs * gg.w * (1.f + sc.w) + sh.w);
            *(ushort4*)(out + (size_t)row * D + c0) = o; }
    }
}
namespace att {
using bf16x8 = __attribute__((ext_vector_type(8))) short;
using s16x4  = __attribute__((ext_vector_type(4))) short;
using f32x16 = __attribute__((ext_vector_type(16))) float;
using u32x4  = __attribute__((ext_vector_type(4))) unsigned;
constexpr int QBLK = 32, KVBLK = 64;
constexpr int KSLOT = 8192;
constexpr int OFF_K = 0, OFF_V = 3 * KSLOT, OFF_WS = OFF_V + 6 * KSLOT, OFF_OST = OFF_WS + 8 * 256, LDS_TOTAL = OFF_OST + 8 * 8192;
#define AT_SBAR() __builtin_amdgcn_sched_barrier(0)
#define AT_PIN(x) asm volatile("" : "+v"(x))
#define AT_MFMA(a, b, c) __builtin_amdgcn_mfma_f32_32x32x16_bf16(a, b, c, 0, 0, 0)
#define AT_WAIT_BAR(N) asm volatile("s_waitcnt vmcnt(" #N ") lgkmcnt(0)\n\ts_barrier" ::: "memory")
__device__ __forceinline__ int crow(int r, int hi) { return (r & 3) + 8 * (r >> 2) + 4 * hi; }
__device__ __forceinline__ unsigned cvtpk(float lo, float hi) { unsigned r; asm("v_cvt_pk_bf16_f32 %0, %1, %2" : "=v"(r) : "v"(lo), "v"(hi)); return r; }
__device__ __forceinline__ void glds16(unsigned voff, const void* sbase, unsigned lds_base) {
    unsigned sv; asm volatile("s_mov_b32 %0, m0\n\ts_mov_b32 m0, %3\n\ts_nop 0\n\tglobal_load_lds_dwordx4 %1, %2\n\ts_mov_b32 m0, %0" : "=&s"(sv) : "v"(voff), "s"(sbase), "s"(lds_base) : "memory"); }
typedef __attribute__((address_space(3))) const char* lds_cptr;
typedef short v4i16_t __attribute__((ext_vector_type(4)));
__device__ __forceinline__ void kload2(bf16x8* kf, lds_cptr kp, int d0) { kf[2 * d0] = *(const __attribute__((address_space(3))) bf16x8*)(kp + d0 * 2048); kf[2 * d0 + 1] = *(const __attribute__((address_space(3))) bf16x8*)(kp + d0 * 2048 + 512); }
__device__ __forceinline__ s16x4 vtr(lds_cptr p) { return __builtin_bit_cast(s16x4, __builtin_amdgcn_ds_read_tr16_b64_v4i16((__attribute__((address_space(3))) v4i16_t*)p)); }
#define AT_MX3(a, b, c) __builtin_fmaxf(__builtin_fmaxf((a), (b)), (c))
__device__ __forceinline__ float rowmax(const f32x16& p0, const f32x16& p1) {
    float a = AT_MX3(p0[0], p0[1], p1[0]), b = AT_MX3(p0[2], p0[3], p1[1]); a = AT_MX3(a, p1[2], p1[3]);
#pragma unroll
    for (int r = 4; r < 16; r += 4) { a = AT_MX3(a, p0[r], p0[r + 1]); b = AT_MX3(b, p0[r + 2], p0[r + 3]); a = AT_MX3(a, p1[r], p1[r + 1]); b = AT_MX3(b, p1[r + 2], p1[r + 3]); }
    float m = __builtin_fmaxf(a, b); auto rr = __builtin_amdgcn_permlane32_swap(__float_as_uint(m), __float_as_uint(m), false, false);
    return __builtin_fmaxf(__uint_as_float(rr[0]), __uint_as_float(rr[1])); }

__device__ __forceinline__ void attn_unit(const bf16_t* __restrict__ PROJ, bf16_t* __restrict__ ATT, float* stash, int h, int qrow0, int NT, int ctx0, int lat0,
                                          float lam, float osc, const float* __restrict__ sg, char* lds) {
  const int tid = otid(), lane = tid & 63, r32 = lane & 31, hi = lane >> 5; const int wid = __builtin_amdgcn_readfirstlane(tid >> 6);
  const unsigned lds0 = (unsigned)__builtin_amdgcn_readfirstlane((int)(unsigned)(uintptr_t)lds); float* wsf = (float*)(lds + OFF_WS) + wid * 64;
  const unsigned kdst = lds0 + OFF_K + wid * 1024, vdst = lds0 + OFF_V + wid * 1024;
  const lds_cptr vp0 = (lds_cptr)lds + OFF_V + ((lane >> 4) & 1) * 32 + (lane & 3) * 8 + (4 * hi + ((lane & 15) >> 2)) * 64;
  const lds_cptr kp0 = (lds_cptr)lds + OFF_K + hi * 1024 + r32 * 16;
  const unsigned voffV = (unsigned)(((16 * (wid & 3) + (lane >> 2)) * DIN + C_V + h * 128 + (wid >> 2) * 32 + (lane & 3) * 8) * 2);
  f32x16 o[4];
  const int moff0 = wid * 64 * 64 + lane;
#define AT_TBASE(t) ((const char*)PROJ + (size_t)((t) < 4 ? ctx0 + (t) * 64 : lat0 + ((t) - 4) * 64) * (size_t)(DIN * 2))
#define AT_RFL(x) ((unsigned)__builtin_amdgcn_readfirstlane((int)(x)))
#define AT_DMA_K(t, slot) glds16(voffK, AT_TBASE(t), AT_RFL(kdst + (slot)))
#define AT_DMA_V(t, slot) do { const char* tb_ = AT_TBASE(t); glds16(voffV, tb_, AT_RFL(vdst + 2 * (slot))); glds16(voffV, tb_ + 128, AT_RFL(vdst + 2 * (slot) + 8192)); } while (0)
  for (int m = 0; m < 2; ++m) {
    const unsigned voffK = (unsigned)((lane * DIN + C_K + h * 128 + m * 64 + wid * 8) * 2);
    __syncthreads();
    AT_DMA_K(0, 0); AT_DMA_V(0, 0); AT_DMA_K(1, KSLOT);
    bf16x8 qr[4];
    { const bf16_t* Qw = PROJ + (size_t)(qrow0 + wid * QBLK + r32) * DIN + C_Q + h * 128 + m * 64 + hi * 8;
#pragma unroll
      for (int d0 = 0; d0 < 4; ++d0) qr[d0] = *reinterpret_cast<const bf16x8*>(Qw + d0 * 16); }
    float mhat = 0.f, l_reg = 0.f;
#pragma unroll
    for (int d = 0; d < 4; ++d) o[d] = f32x16{};
    f32x16 negm;
    bool resc = false;
    f32x16 pA0, pA1, pB0, pB1; bf16x8 kf[8]; s16x4 vlo[4], vhi[4]; u32x4 pw0, pw1, pw2, pw3;
    int sl_prev = 0, sl_cur = 0, sl_next = KSLOT;
#define AT_ROT() do { sl_prev = sl_cur; sl_cur = sl_next; sl_next = (sl_next == 2 * KSLOT) ? 0 : sl_next + KSLOT; } while (0)
#define AT_EX(v) __builtin_amdgcn_exp2f(v)
#define AT_RESC() do { if (resc) { _Pragma("unroll") for (int d_ = 0; d_ < 4; ++d_) _Pragma("unroll") for (int r = 0; r < 16; ++r) o[d_][r] *= wsf[crow(r, hi)]; } } while (0)
    AT_DMA_K(2, 2 * KSLOT);
    AT_WAIT_BAR(4);
    _Pragma("unroll") for (int d0 = 0; d0 < 4; ++d0) kload2(kf, kp0, d0);
    pA0 = AT_MFMA(kf[0], qr[0], f32x16{}); pA1 = AT_MFMA(kf[1], qr[0], f32x16{}); pA0 = AT_MFMA(kf[2], qr[1], pA0); pA1 = AT_MFMA(kf[3], qr[1], pA1);
    pA0 = AT_MFMA(kf[4], qr[2], pA0); pA1 = AT_MFMA(kf[5], qr[2], pA1); pA0 = AT_MFMA(kf[6], qr[3], pA0); pA1 = AT_MFMA(kf[7], qr[3], pA1);
    { const float rm = rowmax(pA0, pA1); mhat = rm;
#pragma unroll
      for (int r = 0; r < 16; ++r) negm[r] = -mhat;
      asm volatile("" : "+v"(negm));
#pragma unroll
      for (int r = 0; r < 16; ++r) { pA0[r] = AT_EX(pA0[r] - rm); pA1[r] = AT_EX(pA1[r] - rm); } }
    AT_WAIT_BAR(0);
    AT_DMA_K(3, 0); AT_DMA_V(1, KSLOT); AT_ROT();
    _Pragma("unroll") for (int d0 = 0; d0 < 4; ++d0) kload2(kf, kp0 + sl_cur, d0);
    AT_WAIT_BAR(3);
#define AT_PKW(P, i) cvtpk(P[i], P[i + 1])
#define AT_PAF(k) __builtin_bit_cast(bf16x8, pw##k)
#define AT_VFR(i) (bf16x8){vlo[i][0], vlo[i][1], vlo[i][2], vlo[i][3], vhi[i][0], vhi[i][1], vhi[i][2], vhi[i][3]}
#define AT_VRDS(s, db, ks) do { vlo[s] = vtr(vp_ + ((db) * 4096 + (ks) * 1024)); vhi[s] = vtr(vp_ + ((db) * 4096 + (ks) * 1024 + 512)); } while (0)
#define AT_KRD1(G, j) do { if (G) kf[j] = *(const __attribute__((address_space(3))) bf16x8*)(kp0 + sl_next + ((j) >> 1) * 2048 + ((j) & 1) * 512); } while (0)
#define AT_GAPA(MF, a0, a1, a2, a3, W0, W1, PW) do { MF; sacc += a0; sacc += a1; sacc += a2; sacc += a3; W0; W1; AT_PIN(PW); AT_PIN(sacc); AT_SBAR(); } while (0)
#define AT_GAPB(MF, X, i) do { MF; X[i] = AT_EX(X[i]); X[i + 1] = AT_EX(X[i + 1]); AT_PIN(X); AT_SBAR(); } while (0)
#define AT_STEP(C0, C1, P0, P1, t, GK, GV, GL) do { AT_SBAR(); \
    const lds_cptr vp_ = vp0 + 2 * sl_prev; \
    float sacc = P0[0] + P0[1]; \
    AT_GAPA(C0 = AT_MFMA(kf[0], qr[0], negm), P0[2], P0[3], P0[4], P0[5],     pw0[0] = AT_PKW(P0, 0),  pw0[1] = AT_PKW(P0, 2),  pw0); \
    AT_GAPA(C1 = AT_MFMA(kf[1], qr[0], negm), P0[6], P0[7], P0[8], P0[9],     pw0[2] = AT_PKW(P0, 4),  pw0[3] = AT_PKW(P0, 6),  pw0); \
    AT_GAPA(C0 = AT_MFMA(kf[2], qr[1], C0),   P0[10], P0[11], P0[12], P0[13], pw1[0] = AT_PKW(P0, 8),  pw1[1] = AT_PKW(P0, 10), pw1); \
    AT_GAPA(C1 = AT_MFMA(kf[3], qr[1], C1),   P0[14], P0[15], P1[0], P1[1],   pw1[2] = AT_PKW(P0, 12), pw1[3] = AT_PKW(P0, 14), pw1); \
    AT_VRDS(0, 0, 0); AT_SBAR(); AT_GAPA(C0 = AT_MFMA(kf[4], qr[2], C0),   P1[2], P1[3], P1[4], P1[5],     pw2[0] = AT_PKW(P1, 0),  pw2[1] = AT_PKW(P1, 2),  pw2); \
    AT_VRDS(1, 1, 0); AT_SBAR(); AT_GAPA(C1 = AT_MFMA(kf[5], qr[2], C1),   P1[6], P1[7], P1[8], P1[9],     pw2[2] = AT_PKW(P1, 4),  pw2[3] = AT_PKW(P1, 6),  pw2); \
    AT_VRDS(2, 0, 1); AT_SBAR(); AT_GAPA(C0 = AT_MFMA(kf[6], qr[3], C0),   P1[10], P1[11], P1[12], P1[13], pw3[0] = AT_PKW(P1, 8),  pw3[1] = AT_PKW(P1, 10), pw3); \
    AT_VRDS(3, 1, 1); AT_SBAR(); AT_GAPA(C1 = AT_MFMA(kf[7], qr[3], C1),   P1[14], P1[15], 0.f, 0.f,       pw3[2] = AT_PKW(P1, 12), pw3[3] = AT_PKW(P1, 14), pw3); \
    l_reg += sacc; \
    if (GK) AT_DMA_K((t) + 3, sl_cur); if (GV) AT_DMA_V((t) + 1, sl_next);                                \
    { const float rm = rowmax(C0, C1); resc = false;                                                    \
      if (__builtin_expect(__any(rm > 8.f), 0)) { const float dl = __builtin_fmaxf(rm, 0.f); mhat += dl;     \
          _Pragma("unroll") for (int r = 0; r < 16; ++r) { C0[r] -= dl; C1[r] -= dl; } \
          _Pragma("unroll") for (int r = 0; r < 16; ++r) negm[r] = -mhat; \
          asm volatile("" : "+v"(negm)); \
          const float f = __builtin_amdgcn_exp2f(-dl); l_reg *= f; if (hi == 0) wsf[r32] = f; resc = true; } } \
    AT_SBAR(); \
    AT_GAPB(o[0] = AT_MFMA(AT_PAF(0), AT_VFR(0), o[0]), C0, 0);  AT_VRDS(0, 0, 2); AT_SBAR(); \
    AT_GAPB(o[1] = AT_MFMA(AT_PAF(0), AT_VFR(1), o[1]), C0, 2);  AT_VRDS(1, 1, 2); AT_SBAR(); \
    AT_GAPB(o[0] = AT_MFMA(AT_PAF(1), AT_VFR(2), o[0]), C0, 4);  AT_VRDS(2, 0, 3); AT_SBAR(); \
    AT_GAPB(o[1] = AT_MFMA(AT_PAF(1), AT_VFR(3), o[1]), C0, 6);  AT_VRDS(3, 1, 3); AT_SBAR(); \
    AT_GAPB(o[0] = AT_MFMA(AT_PAF(2), AT_VFR(0), o[0]), C0, 8);  AT_VRDS(0, 2, 0); AT_KRD1(GL, 0); AT_SBAR(); \
    AT_GAPB(o[1] = AT_MFMA(AT_PAF(2), AT_VFR(1), o[1]), C0, 10); AT_VRDS(1, 3, 0); AT_KRD1(GL, 1); AT_SBAR(); \
    AT_GAPB(o[0] = AT_MFMA(AT_PAF(3), AT_VFR(2), o[0]), C0, 12); AT_VRDS(2, 2, 1); AT_KRD1(GL, 2); AT_SBAR(); \
    AT_GAPB(o[1] = AT_MFMA(AT_PAF(3), AT_VFR(3), o[1]), C0, 14); AT_VRDS(3, 3, 1); AT_KRD1(GL, 3); AT_SBAR(); \
    AT_GAPB(o[2] = AT_MFMA(AT_PAF(0), AT_VFR(0), o[2]), C1, 0);  AT_VRDS(0, 2, 2); AT_KRD1(GL, 4); AT_SBAR(); \
    AT_GAPB(o[3] = AT_MFMA(AT_PAF(0), AT_VFR(1), o[3]), C1, 2);  AT_VRDS(1, 3, 2); AT_KRD1(GL, 5); AT_SBAR(); \
    AT_GAPB(o[2] = AT_MFMA(AT_PAF(1), AT_VFR(2), o[2]), C1, 4);  AT_VRDS(2, 2, 3); AT_KRD1(GL, 6); AT_SBAR(); \
    AT_GAPB(o[3] = AT_MFMA(AT_PAF(1), AT_VFR(3), o[3]), C1, 6);  AT_VRDS(3, 3, 3); AT_KRD1(GL, 7); AT_SBAR(); \
    AT_GAPB(o[2] = AT_MFMA(AT_PAF(2), AT_VFR(0), o[2]), C1, 8);  \
    AT_GAPB(o[3] = AT_MFMA(AT_PAF(2), AT_VFR(1), o[3]), C1, 10); \
    AT_GAPB(o[2] = AT_MFMA(AT_PAF(3), AT_VFR(2), o[2]), C1, 12); \
    AT_GAPB(o[3] = AT_MFMA(AT_PAF(3), AT_VFR(3), o[3]), C1, 14); \
    } while (0)
    int t = 1;
    for (; t + 5 < NT; t += 2) {
        AT_STEP(pB0, pB1, pA0, pA1, t, true, true, true);     AT_WAIT_BAR(3); AT_RESC(); AT_ROT();
        AT_STEP(pA0, pA1, pB0, pB1, t + 1, true, true, true); AT_WAIT_BAR(3); AT_RESC(); AT_ROT();
    }
#define AT_ENDW(tt) do { if ((tt) + 3 < NT) { AT_WAIT_BAR(3); } else if ((tt) + 2 < NT) { AT_WAIT_BAR(2); } else { AT_WAIT_BAR(0); } } while (0)
    for (; t + 1 < NT; t += 2) {
        AT_STEP(pB0, pB1, pA0, pA1, t, (t + 3 < NT), (t + 1 < NT), (t + 1 < NT));         AT_ENDW(t);     AT_RESC(); AT_ROT();
        AT_STEP(pA0, pA1, pB0, pB1, t + 1, (t + 4 < NT), (t + 2 < NT), (t + 2 < NT));     AT_ENDW(t + 1); AT_RESC(); AT_ROT();
    }
    AT_STEP(pB0, pB1, pA0, pA1, NT - 1, false, false, false); AT_RESC();
    { float sacc = pB0[0] + pB0[1];
#pragma unroll
      for (int r = 2; r < 16; ++r) sacc += pB0[r];
#pragma unroll
      for (int r = 0; r < 16; ++r) sacc += pB1[r];
      l_reg += sacc;
      pw0 = (u32x4){AT_PKW(pB0, 0), AT_PKW(pB0, 2), AT_PKW(pB0, 4), AT_PKW(pB0, 6)}; pw1 = (u32x4){AT_PKW(pB0, 8), AT_PKW(pB0, 10), AT_PKW(pB0, 12), AT_PKW(pB0, 14)};
      pw2 = (u32x4){AT_PKW(pB1, 0), AT_PKW(pB1, 2), AT_PKW(pB1, 4), AT_PKW(pB1, 6)}; pw3 = (u32x4){AT_PKW(pB1, 8), AT_PKW(pB1, 10), AT_PKW(pB1, 12), AT_PKW(pB1, 14)};
      const lds_cptr vp_ = vp0 + 2 * sl_cur;
#define AT_DR4(OA, OB, DA, DB, K0, K1) do { AT_VRDS(0, DA, K0); AT_VRDS(1, DB, K0); AT_VRDS(2, DA, K1); AT_VRDS(3, DB, K1); \
      OA = AT_MFMA(AT_PAF(K0), AT_VFR(0), OA); OB = AT_MFMA(AT_PAF(K0), AT_VFR(1), OB); OA = AT_MFMA(AT_PAF(K1), AT_VFR(2), OA); OB = AT_MFMA(AT_PAF(K1), AT_VFR(3), OB); AT_SBAR(); } while (0)
      AT_DR4(o[0], o[1], 0, 1, 0, 1); AT_DR4(o[0], o[1], 0, 1, 2, 3); AT_DR4(o[2], o[3], 2, 3, 0, 1); AT_DR4(o[2], o[3], 2, 3, 2, 3);
#undef AT_DR4
    }
    { auto rr = __builtin_amdgcn_permlane32_swap(__float_as_uint(l_reg), __float_as_uint(l_reg), false, false); l_reg = __uint_as_float(rr[0]) + __uint_as_float(rr[1]); }
    if (hi == 0) wsf[32 + r32] = l_reg;
    asm volatile("s_waitcnt lgkmcnt(0)" ::: "memory");
    float rli[16];
#pragma unroll
    for (int r = 0; r < 16; ++r) rli[r] = __builtin_amdgcn_rcpf(wsf[32 + crow(r, hi)]);
    if (m == 0) {
#pragma unroll
      for (int d0 = 0; d0 < 4; ++d0) { int mo_ = moff0 + d0 * 1024; asm volatile("" : "+v"(mo_)); float* ms = stash + mo_;
#pragma unroll
        for (int r = 0; r < 16; ++r) ms[r * 64] = o[d0][r] * rli[r]; }
    } else {
#pragma unroll
      for (int d0 = 0; d0 < 4; ++d0) { int mo_ = moff0 + d0 * 1024; asm volatile("" : "+v"(mo_)); const float* ms = stash + mo_;
#pragma unroll
        for (int r = 0; r < 16; ++r) o[d0][r] = ms[r * 64] - lam * (o[d0][r] * rli[r]); }
    }
#undef AT_ROT
#undef AT_EX
#undef AT_RESC
#undef AT_PKW
#undef AT_PAF
#undef AT_VFR
#undef AT_VRDS
#undef AT_KRD1
#undef AT_GAPA
#undef AT_GAPB
#undef AT_STEP
#undef AT_ENDW
  }
#undef AT_TBASE
#undef AT_RFL
#undef AT_DMA_K
#undef AT_DMA_V
  float rs[16];
#pragma unroll
  for (int r = 0; r < 16; ++r) { float s = o[0][r] * o[0][r] + o[1][r] * o[1][r] + o[2][r] * o[2][r] + o[3][r] * o[3][r];
    s += swz_xor<1>(s); s += swz_xor<2>(s); s += swz_xor<4>(s); s += swz_xor<8>(s); s += swz_xor<16>(s);
    rs[r] = rsqrtf(s * (1.f / 128.f) + EPS) * osc; }
  float sgv[4];
#pragma unroll
  for (int d0 = 0; d0 < 4; ++d0) sgv[d0] = sg[d0 * 32 + r32];
  bf16_t* stg = (bf16_t*)(lds + OFF_OST) + wid * 4096;
#pragma unroll
  for (int r = 0; r < 16; ++r) { const int orow = crow(r, hi);
#pragma unroll
    for (int d0 = 0; d0 < 4; ++d0) stg[orow * 128 + d0 * 32 + r32] = f2bf(o[d0][r] * rs[r] * sgv[d0]); }
  asm volatile("s_waitcnt lgkmcnt(0)" ::: "memory");
  bf16_t* Ow = ATT + (size_t)(qrow0 + wid * QBLK) * D + h * 128;
#pragma unroll
  for (int i = 0; i < 8; ++i) { const int row = i * 4 + (lane >> 4), ch = lane & 15; const u32x4 v = *(const u32x4*)(stg + row * 128 + ch * 8); *(u32x4*)(Ow + (size_t)row * D + ch * 8) = v; }
}
#undef AT_SBAR
#undef AT_PIN
#undef AT_MFMA
#undef AT_WAIT_BAR
#undef AT_MX3
}

__device__ __forceinline__ void ph_attn(const P& p, int li, bool do_ctx, int bid, int nb, unsigned char* lds) {
    const bf16_t* PROJ = (const bf16_t*)(p.ws + WS_PROJ); bf16_t* ATT = (bf16_t*)(p.ws + WS_ATT);
    const float lam = ((const float*)(p.ws + WS_LAM))[li]; const float osc = 1.f - lambda_init_of(li);
    const int vcu = (nb % 8 == 0) ? (bid % 8) * (nb / 8) + bid / 8 : bid;
    float* stash = (float*)(p.ws + WS_STASH) + (size_t)bid * (8 * 64 * 64);
    const int nlat = 512, nctx = do_ctx ? 64 : 0;
    const int klat = vcu < nlat ? (nlat - vcu + nb - 1) / nb : 0;
    for (int k = 0;; ++k) { int h, qrow0, NT; int b;
        if (k < klat) { const int u = vcu + k * nb; b = u >> 6; h = (u >> 3) & 7; qrow0 = b * 2048 + (u & 7) * 256; NT = 36; }
        else { const int v = bid + (k - klat) * nb; if (v >= nctx) break; b = v >> 3; h = v & 7; qrow0 = ML + b * 256; NT = 4; }
        att::attn_unit(PROJ, ATT, stash, h, qrow0, NT, ML + b * 256, b * 2048, lam, osc, p.subln_g + li * 128, (char*)lds); }
}
namespace lru {
using bf16x8 = __attribute__((ext_vector_type(8))) short;
using f32x16 = __attribute__((ext_vector_type(16))) float;
using u32x4  = __attribute__((ext_vector_type(4))) unsigned;
constexpr int T = 256;
constexpr int L_URAW = 0, L_UCF = 33280, L_UCB = L_UCF + 32768, L_GLT = L_UCB + 256 * 144, L_LAT = L_GLT + 16384, L_SUMS = L_LAT + 16384, L_BW = L_SUMS + 8192, L_END = L_BW + 8192;
__device__ __forceinline__ float fast_sigmoid(float x) { return __builtin_amdgcn_rcpf(1.f + __expf(-x)); }
__device__ __forceinline__ float one_minus_exp(float x, float a) {
    float pl = 1.f / 5040.f; pl = fmaf(pl, x, 1.f / 720.f); pl = fmaf(pl, x, 1.f / 120.f); pl = fmaf(pl, x, 1.f / 24.f); pl = fmaf(pl, x, 1.f / 6.f); pl = fmaf(pl, x, 0.5f); pl = fmaf(pl, x, 1.f);
    return x > -0.5f ? -x * pl : 1.f - a * a; }
__device__ __forceinline__ float fast_gelu(float x) { const float u = 0.7978845608028654f * (x + 0.044715f * x * x * x); return x * fast_sigmoid(2.f * u); }
}

__device__ __forceinline__ void ph_lru(const P& p, int li, int bid, int nb, unsigned char* lds) {
    using namespace lru;
    const bf16_t* PROJ = (const bf16_t*)(p.ws + WS_PROJ); float* HF = (float*)(p.ws + WS_HF); bf16_t* LA = (bf16_t*)(p.ws + WS_LA);
    const int tid = otid(), wave = tid >> 6, lane = tid & 63, r32 = lane & 31, hi = lane >> 5, tt = wave;
    const int c = r32;
    const int sub = tt * 2 + hi;
    float* UCF = (float*)(lds + L_UCF); float* SUMS = (float*)(lds + L_SUMS);
    for (int item = bid; item < 256; item += nb) {
        const int b = item >> 5, n = (item >> 1) & 15, hfi = item & 1; const int ch0 = n * 64, cb32 = ch0 + hfi * 32;
        int tid_i = tid; asm volatile("" : "+v"(tid_i));
        const int c2 = tid_i & 31, tq = tid_i >> 5;
        float cw0[4], cw1[4];
#pragma unroll
        for (int k = 0; k < 4; ++k) { cw0[k] = p.conv_w[(size_t)(li * 4 + k) * 1024 + ch0 + 2 * c2]; cw1[k] = p.conv_w[(size_t)(li * 4 + k) * 1024 + ch0 + 2 * c2 + 1]; }
        const float cb0 = p.conv_b[li * 1024 + ch0 + 2 * c2], cb1 = p.conv_b[li * 1024 + ch0 + 2 * c2 + 1];
        for (int d = 0; d < 2; ++d) {
            int c_w = c; asm volatile("" : "+v"(c_w));
            { const int g = wave >> 2, ks = wave & 3;
              const float* wp = p.lru_w + ((((size_t)(li * 2 + d) * 2 + g) * 16 + n) * 64) * 64 + hfi * 32 + c_w + (size_t)(ks * 16 + 8 * hi) * 64;
              float wf[8];
#pragma unroll
              for (int j = 0; j < 8; ++j) wf[j] = wp[(size_t)j * 64];
              asm volatile("s_waitcnt vmcnt(0)" ::: "memory");
              *(u32x4*)(lds + L_BW + ((g * 4 + ks) * 64 + lane) * 16) = (u32x4){pk2(wf[0], wf[1]), pk2(wf[2], wf[3]), pk2(wf[4], wf[5]), pk2(wf[6], wf[7])}; }
            const float bias0 = p.lru_b[((size_t)(li * 2 + d) * 2 + 0) * 1024 + cb32 + c_w], bias1 = p.lru_b[((size_t)(li * 2 + d) * 2 + 1) * 1024 + cb32 + c_w];
            float sp8; { const float lam = p.lru_lam[(size_t)(li * 2 + d) * 1024 + cb32 + c_w]; const float z = -lam; const float ez = __expf(z);
              const float spl = ez < 0.1f ? ez * (1.f - ez * (0.5f - ez * (0.33333333f - ez * (0.25f - ez * 0.2f)))) : (z > 20.f ? z : __logf(1.f + ez)); sp8 = -8.f * spl; }
            float state = 0.f;
            u32x4 st_u[5]; u32x4 st_g[2];
#define LRU_CHUNK_ROW0(step_, row0_, L_, t0_) { int cc_; if ((step_) < 1) { cc_ = 0; L_ = 256; row0_ = ML + b * 256; } else { cc_ = d == 0 ? (step_) - 1 : 8 - (step_); L_ = 2048; row0_ = b * 2048; } t0_ = cc_ * T; }
#define LRU_STAGE_LOAD(step_) { int row0_, L_, t0_; LRU_CHUNK_ROW0(step_, row0_, L_, t0_); int tid_ = tid; asm volatile("" : "+v"(tid_));   \
            _Pragma("unroll") for (int q_ = 0; q_ < 5; ++q_) { const int piece_ = tid_ + 512 * q_; const int i_ = piece_ >> 3, chk_ = piece_ & 7; const int tr_ = t0_ - 2 + i_; st_u[q_] = (u32x4){0u, 0u, 0u, 0u}; \
                if (piece_ < 259 * 8 && tr_ >= 0 && tr_ < L_) st_u[q_] = *(const u32x4*)(PROJ + (size_t)(row0_ + tr_) * DIN + C_U + ch0 + chk_ * 8); } \
            if (d == 1) { _Pragma("unroll") for (int q_ = 0; q_ < 2; ++q_) { const int piece_ = tid_ + 512 * q_; const int i_ = piece_ >> 2, chk_ = piece_ & 3; st_g[q_] = *(const u32x4*)(PROJ + (size_t)(row0_ + t0_ + i_) * DIN + C_GL + cb32 + chk_ * 8); } } }
            LRU_STAGE_LOAD(0);
            for (int step = 0; step < 9; ++step) {
                int row0, Lseq, t0; LRU_CHUNK_ROW0(step, row0, Lseq, t0);
                const int crow0 = row0 + t0;
                const int spos0 = (Lseq == 256 ? 0 : 256) + t0;
#pragma unroll
                for (int q = 0; q < 5; ++q) { const int piece = tid + 512 * q; if (piece < 259 * 8) *(u32x4*)(lds + L_URAW + piece * 16) = st_u[q]; }
                if (d == 1) {
#pragma unroll
                    for (int q = 0; q < 2; ++q) { const int piece = tid + 512 * q; *(u32x4*)(lds + L_GLT + piece * 16) = st_g[q]; } }
                __syncthreads();
                if (step + 1 < 9) LRU_STAGE_LOAD(step + 1);
                float hf[16];
                if (d == 1) { int sub_o = sub; asm volatile("" : "+v"(sub_o)); int ho_ = (item * 2304 + spos0 + 255 - sub_o * 16) * 32 + c; asm volatile("" : "+v"(ho_)); const float* hp = HF + ho_;
#pragma unroll
                    for (int r = 0; r < 16; ++r) hf[r] = hp[-r * 32]; }
#pragma unroll
                for (int hh = 0; hh < 2; ++hh) {
                    float x0[11], x1[11]; const int tb8 = tq * 16 + hh * 8;
#pragma unroll
                    for (int i = 0; i < 11; ++i) { const unsigned w = *(const unsigned*)(lds + L_URAW + (tb8 + i) * 128 + c2 * 4); x0[i] = __uint_as_float(w << 16); x1[i] = __uint_as_float(w & 0xffff0000u); }
                    const bool mine = (c2 >> 4) == hfi;
#pragma unroll
                    for (int e = 0; e < 8; ++e) { const int tk = tb8 + e, t = d ? 255 - tk : tk;
                        const float y0 = cb0 + cw0[0] * x0[e] + cw0[1] * x0[e + 1] + cw0[2] * x0[e + 2] + cw0[3] * x0[e + 3];
                        const float y1 = cb1 + cw1[0] * x1[e] + cw1[1] * x1[e + 1] + cw1[2] * x1[e + 2] + cw1[3] * x1[e + 3];
                        if (mine) *(float2*)(UCF + t * 32 + 2 * (c2 & 15)) = make_float2(y0, y1);
                        *(unsigned*)(lds + L_UCB + t * 144 + c2 * 4) = pk2(y0, y1); }
                    __builtin_amdgcn_sched_barrier(0);
                }
                __syncthreads();
                f32x16 acc0 = f32x16{}, acc1 = f32x16{};
                {
                    const int i = r32, hc = (i >> 2) & 1, rr = (i & 3) + 4 * (i >> 3), rho = (tt * 2 + hc) * 16 + rr;
                    const unsigned char* ap = lds + L_UCB + rho * 144 + hi * 16;
#pragma unroll
                    for (int ks = 0; ks < 4; ++ks) { const bf16x8 a = *(const bf16x8*)(ap + ks * 32);
                        const bf16x8 b0 = *(const bf16x8*)(lds + L_BW + (ks * 64 + lane) * 16), b1 = *(const bf16x8*)(lds + L_BW + ((4 + ks) * 64 + lane) * 16);
                        acc0 = __builtin_amdgcn_mfma_f32_32x32x16_bf16(a, b0, acc0, 0, 0, 0); acc1 = __builtin_amdgcn_mfma_f32_32x32x16_bf16(a, b1, acc1, 0, 0, 0); }
                }
                float hl[16], ap_[16]; float P = 1.f, h = 0.f;
                const float* ucp = UCF + (sub * 16) * 32 + c;
#pragma unroll
                for (int r = 0; r < 16; ++r) {
                    const float u = ucp[r * 32]; const float rec = fast_sigmoid(acc0[r] + bias0), inp = fast_sigmoid(acc1[r] + bias1);
                    const float la = sp8 * rec; const float a = __expf(la); const float m2 = one_minus_exp(2.f * la, a); const float drive = __builtin_amdgcn_sqrtf(m2) * (inp * u);
                    h = a * h + drive; P *= a; hl[r] = h; ap_[r] = P;
                    if ((r & 3) == 3) __builtin_amdgcn_sched_barrier(0); }
                float* sums = SUMS + (step & 1) * 1024;
                *(float2*)(sums + (sub * 32 + c) * 2) = make_float2(P, h);
                __syncthreads();
                float carry = state, mine = state;
#pragma unroll
                for (int s = 0; s < 16; ++s) { if (s == sub) mine = carry; const float2 ph = *(const float2*)(sums + (s * 32 + c) * 2); carry = ph.x * carry + ph.y; }
                state = carry;
                if (d == 0) {
                    int sub_o = sub; asm volatile("" : "+v"(sub_o)); int ho_ = (item * 2304 + spos0 + sub_o * 16) * 32 + c; asm volatile("" : "+v"(ho_)); float* hp = HF + ho_;
#pragma unroll
                    for (int r = 0; r < 16; ++r) hp[r * 32] = hl[r] + ap_[r] * mine;
                } else {
                    bf16_t* lat = (bf16_t*)(lds + L_LAT); const bf16_t* glt = (const bf16_t*)(lds + L_GLT);
                    const int tb = 255 - sub * 16;
#pragma unroll
                    for (int r = 0; r < 16; ++r) { const float hb = hl[r] + ap_[r] * mine; const float gl = bf2f(glt[(tb - r) * 32 + c]);
                        lat[(tb - r) * 32 + c] = f2bf((hf[r] + hb) * fast_gelu(gl)); }
                    __syncthreads();
                    int tid3 = tid; asm volatile("" : "+v"(tid3));
#pragma unroll
                    for (int q = 0; q < 2; ++q) { const int piece = tid3 + 512 * q; const int i = piece >> 2, chk = piece & 3;
                        *(u32x4*)(LA + (size_t)(crow0 + i) * D + cb32 + chk * 8) = *(const u32x4*)(lds + L_LAT + piece * 16); }
                }
            }
#undef LRU_STAGE_LOAD
#undef LRU_CHUNK_ROW0
            asm volatile("s_waitcnt vmcnt(0)" ::: "memory");
            __syncthreads();
            if (tid == 0) { __builtin_amdgcn_fence(__ATOMIC_ACQUIRE, "agent"); asm volatile("s_waitcnt vmcnt(0)" ::: "memory"); }
            __syncthreads();
        }
    }
}
namespace peer {
using bf16x8 = __attribute__((ext_vector_type(8))) short;
using f32x16 = __attribute__((ext_vector_type(16))) float;
using u32x4  = __attribute__((ext_vector_type(4))) unsigned;
typedef __bf16 bf16x2_t __attribute__((ext_vector_type(2)));
__device__ __forceinline__ unsigned sortable(float f) { const unsigned u = __float_as_uint(f); return (u & 0x80000000u) ? ~u : (u | 0x80000000u); }
__device__ __forceinline__ float unsortable(unsigned u) { return __uint_as_float((u & 0x80000000u) ? (u & 0x7fffffffu) : ~u); }
__device__ __forceinline__ unsigned umax_(unsigned a, unsigned b) { return a > b ? a : b; }
__device__ __forceinline__ unsigned umin_(unsigned a, unsigned b) { return a < b ? a : b; }
__device__ __forceinline__ void sort16_desc(unsigned (&v)[16]) {
#pragma unroll
    for (int kk = 1; kk <= 4; ++kk)
#pragma unroll
        for (int jj = 3; jj >= 0; --jj)
#pragma unroll
            for (int i = 0; i < 16; ++i) { const int k = 1 << kk, j = 1 << jj, l = i ^ j; if (jj >= kk) continue;
                if (l > i) { const unsigned mx = umax_(v[i], v[l]), mn = umin_(v[i], v[l]); if ((i & k) == 0) { v[i] = mx; v[l] = mn; } else { v[i] = mn; v[l] = mx; } } }
}
__device__ __forceinline__ void merge_top16(unsigned (&a)[16], const unsigned (&b)[16]) {
#pragma unroll
    for (int i = 0; i < 16; ++i) a[i] = umax_(a[i], b[15 - i]);
#pragma unroll
    for (int jj = 3; jj >= 0; --jj)
#pragma unroll
        for (int i = 0; i < 16; ++i) { const int j = 1 << jj, l = i ^ j; if (l > i) { const unsigned mx = umax_(a[i], a[l]), mn = umin_(a[i], a[l]); a[i] = mx; a[l] = mn; } }
}
__device__ __forceinline__ int crow(int r, int hi) { return (r & 3) + 8 * (r >> 2) + 4 * hi; }
__device__ __forceinline__ float dot2(unsigned a, unsigned b, float acc) { return __builtin_amdgcn_fdot2_f32_bf16(__builtin_bit_cast(bf16x2_t, a), __builtin_bit_cast(bf16x2_t, b), acc, false); }
__device__ __forceinline__ unsigned msel(unsigned a, unsigned b, unsigned m) { return a ^ ((a ^ b) & m); }
__device__ __forceinline__ unsigned pick16(const unsigned (&a)[16], int i) {
    const unsigned m0 = 0u - (unsigned)(i & 1), m1 = 0u - (unsigned)((i >> 1) & 1), m2 = 0u - (unsigned)((i >> 2) & 1), m3 = 0u - (unsigned)((i >> 3) & 1);
    unsigned t8[8], t4[4], t2[2];
#pragma unroll
    for (int k = 0; k < 8; ++k) t8[k] = msel(a[2 * k], a[2 * k + 1], m0);
#pragma unroll
    for (int k = 0; k < 4; ++k) t4[k] = msel(t8[2 * k], t8[2 * k + 1], m1);
#pragma unroll
    for (int k = 0; k < 2; ++k) t2[k] = msel(t4[2 * k], t4[2 * k + 1], m2);
    return msel(t2[0], t2[1], m3); }
__device__ __forceinline__ void score_list(const bf16_t* __restrict__ PQ, const bf16_t* __restrict__ KEYS, int tok, int hp, int r32, int hi, unsigned (&T)[16]) {
    const bf16_t* qp = PQ + (size_t)tok * D + hp * 64 + hi * 8; bf16x8 qf[4];
#pragma unroll
    for (int ks = 0; ks < 4; ++ks) qf[ks] = *reinterpret_cast<const bf16x8*>(qp + ks * 16);
    const bf16_t* kp = KEYS + ((size_t)hp * 128 + r32) * 64 + hi * 8;
#pragma unroll
    for (int kt = 0; kt < 4; ++kt) { f32x16 acc = f32x16{};
#pragma unroll
        for (int ks = 0; ks < 4; ++ks) { const bf16x8 a = *reinterpret_cast<const bf16x8*>(kp + (size_t)kt * 32 * 64 + ks * 16); acc = __builtin_amdgcn_mfma_f32_32x32x16_bf16(a, qf[ks], acc, 0, 0, 0); }
        unsigned v[16];
#pragma unroll
        for (int r = 0; r < 16; ++r) v[r] = (sortable(acc[r]) & ~127u) | (unsigned)(127 - (kt * 32 + crow(r, hi)));
        sort16_desc(v);
        if (kt == 0) {
#pragma unroll
            for (int r = 0; r < 16; ++r) T[r] = v[r];
        } else merge_top16(T, v);
    }
}
}

__device__ __forceinline__ void ph_peer_score(const P& p, int li, int Mrows, int bid, int nb) {
    using namespace peer;
    const bf16_t* PQ = (const bf16_t*)(p.ws + WS_PQ); const bf16_t* KEYS = (const bf16_t*)(p.ws + WS_KEYS) + (size_t)li * 16 * 128 * 64;
    int* IDX = (int*)(p.ws + WS_IDX); float* G = (float*)(p.ws + WS_G);
    const int tid = otid(), wave = tid >> 6, lane = tid & 63, r32 = lane & 31, hi = lane >> 5;
    const int gw = bid * NWAVES + wave, NGW = nb * NWAVES, ntask = (Mrows / 32) * 4;
    for (int task = gw; task < ntask; task += NGW) {
        const int tok = (task >> 2) * 32 + r32, hp2 = task & 3;
        for (int hh = 0; hh < 2; ++hh) { const int h = hp2 * 2 + hh;
            unsigned A0[16], B0[16];
            score_list(PQ, KEYS, tok, h * 2 + 0, r32, hi, A0); score_list(PQ, KEYS, tok, h * 2 + 1, r32, hi, B0);
            unsigned M[16], Y[16];
#pragma unroll
            for (int i = 0; i < 16; ++i) { auto rr = __builtin_amdgcn_permlane32_swap(A0[i], B0[i], false, false); M[i] = rr[0]; Y[i] = rr[1]; }
            merge_top16(M, Y);
            unsigned P0[16], P1[16];
#pragma unroll
            for (int i = 0; i < 16; ++i) { auto rr = __builtin_amdgcn_permlane32_swap(M[i], M[i], false, false); P0[i] = rr[0]; P1[i] = rr[1]; }
            float X[16], Yv[16];
#pragma unroll
            for (int i = 0; i < 16; ++i) { const float f0 = unsortable(P0[i]), f1 = unsortable(P1[i]); X[i] = hi ? f1 : f0; Yv[i] = hi ? f0 : f1; }
            unsigned C0[16], C1[16];
#pragma unroll
            for (int c = 0; c < 16; ++c) { const float s = X[0] + Yv[c]; const unsigned flat = hi ? (unsigned)(c * 16) : (unsigned)c; unsigned key = (sortable(s) & ~255u) | (255u - flat); if (c == 0 && hi) key = 0u; C0[c] = key; }
#define PEER_CAND(c, i, j) { const float s_ = X[i] + Yv[j]; const unsigned flat_ = hi ? (unsigned)((j) * 16 + (i)) : (unsigned)((i) * 16 + (j)); unsigned key_ = (sortable(s_) & ~255u) | (255u - flat_); if ((i) == (j) && hi) key_ = 0u; C1[c] = key_; }
            PEER_CAND(0, 1, 1) PEER_CAND(1, 1, 2) PEER_CAND(2, 1, 3) PEER_CAND(3, 1, 4) PEER_CAND(4, 1, 5) PEER_CAND(5, 1, 6) PEER_CAND(6, 1, 7) PEER_CAND(7, 2, 2) PEER_CAND(8, 2, 3) PEER_CAND(9, 2, 4) PEER_CAND(10, 3, 3)
#undef PEER_CAND
            C1[11] = 0u; C1[12] = 0u; C1[13] = 0u; C1[14] = 0u; C1[15] = 0u;
            sort16_desc(C0); sort16_desc(C1); merge_top16(C0, C1);
            unsigned F[16]; unsigned mxk;
            { unsigned Clo[16], Chi[16];
#pragma unroll
              for (int i = 0; i < 16; ++i) { auto rr = __builtin_amdgcn_permlane32_swap(C0[i], C0[i], false, false); Clo[i] = rr[0]; Chi[i] = rr[1]; }
#pragma unroll
              for (int i = 0; i < 16; ++i) F[i] = umax_(Clo[i], Chi[15 - i]);
              mxk = umax_(Clo[0], Chi[0]); }
            const float fmx = unsortable(mxk); float w[16]; float wsum = 0.f;
#pragma unroll
            for (int i = 0; i < 16; ++i) { w[i] = __expf(unsortable(F[i]) - fmx); wsum += w[i]; }
            const float inv = 1.f / wsum;
            int oi[8]; float og[8]; const unsigned him = 0u - (unsigned)hi;
#pragma unroll
            for (int k = 0; k < 8; ++k) { const unsigned e = msel(F[k], F[8 + k], him); const float wk = __uint_as_float(msel(__float_as_uint(w[k]), __float_as_uint(w[8 + k]), him));
                const int cf = 255 - (int)(e & 255u), i1 = cf >> 4, i2 = cf & 15;
                const int n1 = 127 - (int)(pick16(P0, i1) & 127u), n2 = 127 - (int)(pick16(P1, i2) & 127u);
                oi[k] = n1 * 128 + n2; og[k] = wk * inv; }
            int* ip = IDX + (size_t)tok * 128 + h * 16 + hi * 8; float* gp = G + (size_t)tok * 128 + h * 16 + hi * 8;
            *(int4*)ip = make_int4(oi[0], oi[1], oi[2], oi[3]); *(int4*)(ip + 4) = make_int4(oi[4], oi[5], oi[6], oi[7]);
            *(float4*)gp = make_float4(og[0], og[1], og[2], og[3]); *(float4*)(gp + 4) = make_float4(og[4], og[5], og[6], og[7]);
        }
    }
}

#ifndef FP6_INTERLEAVED
#define FP6_INTERLEAVED 1
#endif
namespace peer {
typedef float v16f __attribute__((ext_vector_type(16)));
typedef float v32f __attribute__((ext_vector_type(32)));
typedef unsigned v6u __attribute__((ext_vector_type(6)));
typedef unsigned v16u __attribute__((ext_vector_type(16)));
typedef unsigned u32x2 __attribute__((ext_vector_type(2)));
__host__ __device__ constexpr int fp6_src_of(int k) { return FP6_INTERLEAVED ? ((k & 1) * 16 + (k >> 1)) : k; }
}
__device__ __forceinline__ void ph_peer_tables(const P& p, int li, int bid, int nb) {
    using namespace peer;
    const int tid = otid(), lane = tid & 63, wave = tid >> 6, g = lane & 31, hb = lane >> 5;
    const int first = nb >= 128 ? 64 : 0;
    if (bid < first) return;
    const int gw = (bid - first) * NWAVES + wave, NGW = (nb - first) * NWAVES;
    for (int rp = gw; rp < 16384; rp += NGW) {
        const int rr = 2 * rp + hb, tab = rr >> 14, row = rr & 16383;
        const float4* src = (const float4*)((tab ? p.peer_v : p.peer_u) + ((size_t)li * 16384 + row) * 1024 + g * 32);
        unsigned char* dst = (unsigned char*)(p.ws + (tab ? WS_PV : WS_PU)) + (tab ? (size_t)row * 768 + g * 24 : (size_t)row * 512 + g * 16); float* sc = (float*)(p.ws + (tab ? WS_SV : WS_SU));
        float4 v[8]; float mx = 0.f;
#pragma unroll
        for (int j = 0; j < 8; ++j) { v[j] = src[j]; mx = fmaxf(fmaxf(mx, fmaxf(fabsf(v[j].x), fabsf(v[j].y))), fmaxf(fabsf(v[j].z), fabsf(v[j].w))); }
        mx = fmaxf(mx, swz_xor<1>(mx)); mx = fmaxf(mx, swz_xor<2>(mx)); mx = fmaxf(mx, swz_xor<4>(mx)); mx = fmaxf(mx, swz_xor<8>(mx)); mx = fmaxf(mx, swz_xor<16>(mx));
        const float top = tab ? 7.5f : 6.0f;
        const float inv = mx > 0.f ? top / mx : 0.f;
        v16f a, b;
#pragma unroll
        for (int j = 0; j < 4; ++j) { a[4 * j] = v[j].x * inv; a[4 * j + 1] = v[j].y * inv; a[4 * j + 2] = v[j].z * inv; a[4 * j + 3] = v[j].w * inv;
                                      b[4 * j] = v[4 + j].x * inv; b[4 * j + 1] = v[4 + j].y * inv; b[4 * j + 2] = v[4 + j].z * inv; b[4 * j + 3] = v[4 + j].w * inv; }
        if (tab) { const v6u w = __builtin_amdgcn_cvt_scalef32_2xpk16_fp6_f32(a, b, 1.0f);
            *(u32x2*)(dst) = (u32x2){w[0], w[1]}; *(u32x2*)(dst + 8) = (u32x2){w[2], w[3]}; *(u32x2*)(dst + 16) = (u32x2){w[4], w[5]}; }
        else { unsigned w4[4] = {0u, 0u, 0u, 0u};
#define FP4_ENC(W, SRC, I, SEL) W = __builtin_amdgcn_cvt_scalef32_pk_fp4_f32(W, SRC[2 * (I)], SRC[2 * (I) + 1], 1.0f, SEL);
            FP4_ENC(w4[0], a, 0, 0) FP4_ENC(w4[0], a, 1, 1) FP4_ENC(w4[0], a, 2, 2) FP4_ENC(w4[0], a, 3, 3) FP4_ENC(w4[1], a, 4, 0) FP4_ENC(w4[1], a, 5, 1) FP4_ENC(w4[1], a, 6, 2) FP4_ENC(w4[1], a, 7, 3)
            FP4_ENC(w4[2], b, 0, 0) FP4_ENC(w4[2], b, 1, 1) FP4_ENC(w4[2], b, 2, 2) FP4_ENC(w4[2], b, 3, 3) FP4_ENC(w4[3], b, 4, 0) FP4_ENC(w4[3], b, 5, 1) FP4_ENC(w4[3], b, 6, 2) FP4_ENC(w4[3], b, 7, 3)
#undef FP4_ENC
            *(u32x4*)dst = (u32x4){w4[0], w4[1], w4[2], w4[3]}; }
        if (g == 0) sc[row] = mx / top;
    }
}

__device__ __forceinline__ void ph_peer_expert(const P& p, int li, int Mrows, int bid, int nb, bool dry) {
    using namespace peer;
    typedef float f32x2 __attribute__((ext_vector_type(2)));
    const bf16_t* HQ = (const bf16_t*)(p.ws + WS_HX); const int* IDX = (const int*)(p.ws + WS_IDX); const float* G = (const float*)(p.ws + WS_G);
    const float* X = (const float*)(p.ws + WS_X); const float* MOD = (const float*)(p.ws + WS_MOD);
    float* Xw = dry ? (float*)(p.ws + WS_HF) : (float*)(p.ws + WS_X); bf16_t* HXo = dry ? (bf16_t*)(p.ws + WS_ATT) : (bf16_t*)(p.ws + WS_HX); float* OUTw = dry ? (float*)(p.ws + WS_HF) : p.out;
    const unsigned char* UT = (const unsigned char*)(p.ws + WS_PU); const unsigned char* VT = (const unsigned char*)(p.ws + WS_PV);
    const float* SU = (const float*)(p.ws + WS_SU); const float* SV = (const float*)(p.ws + WS_SV);
    const auto rsU = __builtin_amdgcn_make_buffer_rsrc((void*)UT, 0, 16384 * 512, 0x00020000); const auto rsV = __builtin_amdgcn_make_buffer_rsrc((void*)VT, 0, 16384 * 768, 0x00020000);
    const int tid = otid(), lane = tid & 63, wave = __builtin_amdgcn_readfirstlane(tid >> 6), g = lane & 31, hb = lane >> 5;
    const bool b4 = (lane >> 4) & 1, b3 = (lane >> 3) & 1;
    const int eL = 2 * (2 * (int)b4 + (int)b3) + hb;
    const unsigned goff = (unsigned)g * 24u;
    for (int tok = bid * NWAVES + wave; tok < Mrows; tok += nb * NWAVES) {
        f32x2 hv2[16];
        { int g_t = g; asm volatile("" : "+v"(g_t)); const u32x4* hsrc = (const u32x4*)(HQ + (size_t)tok * D + g_t * 32);
#pragma unroll
          for (int j = 0; j < 4; ++j) { const u32x4 hw = hsrc[j]; hv2[4 * j] = (f32x2){pg8::bflo(hw.x), pg8::bfhi(hw.x)}; hv2[4 * j + 1] = (f32x2){pg8::bflo(hw.y), pg8::bfhi(hw.y)};
              hv2[4 * j + 2] = (f32x2){pg8::bflo(hw.z), pg8::bfhi(hw.z)}; hv2[4 * j + 3] = (f32x2){pg8::bflo(hw.w), pg8::bfhi(hw.w)}; } }
        f32x2 y2[16];
#pragma unroll
        for (int k = 0; k < 16; ++k) y2[k] = (f32x2){0.f, 0.f};
        const int* ip = IDX + (size_t)tok * 128; const float* gp = G + (size_t)tok * 128;
        int idx_nx = ip[lane & 7]; u32x4 ud[4]; v6u vd[4]; const unsigned goff4 = (unsigned)g * 16u;
#define PEER_ISSUE(dst, RS, idxreg) { _Pragma("unroll") for (int j_ = 0; j_ < 4; ++j_) { const int e0_ = __builtin_amdgcn_readlane(idxreg, 2 * j_), e1_ = __builtin_amdgcn_readlane(idxreg, 2 * j_ + 1); \
            const unsigned vo_ = (unsigned)(hb ? e1_ : e0_) * 768u + goff; const u32x4 q4_ = __builtin_amdgcn_raw_buffer_load_b128(RS, vo_, 0, 0); const u32x2 q2_ = __builtin_amdgcn_raw_buffer_load_b64(RS, vo_ + 16u, 0, 0); \
            dst[j_] = (v6u){q4_.x, q4_.y, q4_.z, q4_.w, q2_.x, q2_.y}; } __builtin_amdgcn_sched_barrier(0); }
#define PEER_ISSUE_U(idxreg) { _Pragma("unroll") for (int j_ = 0; j_ < 4; ++j_) { const int e0_ = __builtin_amdgcn_readlane(idxreg, 2 * j_), e1_ = __builtin_amdgcn_readlane(idxreg, 2 * j_ + 1); \
            ud[j_] = __builtin_amdgcn_raw_buffer_load_b128(rsU, (unsigned)(hb ? e1_ : e0_) * 512u + goff4, 0, 0); } __builtin_amdgcn_sched_barrier(0); }
        PEER_ISSUE_U(idx_nx); PEER_ISSUE(vd, rsV, idx_nx);
        for (int hu = 0; hu < 16; ++hu) {
            const int idxL = ip[hu * 8 + eL]; const float gL = gp[hu * 8 + eL] * SV[idxL]; const float suL = SU[idxL];
            if (hu < 15) idx_nx = ip[(hu + 1) * 8 + (lane & 7)];
            float part[4];
#pragma unroll
            for (int j = 0; j < 4; ++j) { const unsigned uw[4] = {ud[j].x, ud[j].y, ud[j].z, ud[j].w}; f32x2 a0 = (f32x2){0.f, 0.f}, a1 = (f32x2){0.f, 0.f};
#define FP4_FMA(ACC, KK, SEL) ACC += hv2[KK] * __builtin_amdgcn_cvt_scalef32_pk_f32_fp4(uw[(KK) >> 2], 1.0f, SEL);
                FP4_FMA(a0, 0, 0) FP4_FMA(a1, 1, 1) FP4_FMA(a0, 2, 2) FP4_FMA(a1, 3, 3) FP4_FMA(a0, 4, 0) FP4_FMA(a1, 5, 1) FP4_FMA(a0, 6, 2) FP4_FMA(a1, 7, 3)
                FP4_FMA(a0, 8, 0) FP4_FMA(a1, 9, 1) FP4_FMA(a0, 10, 2) FP4_FMA(a1, 11, 3) FP4_FMA(a0, 12, 0) FP4_FMA(a1, 13, 1) FP4_FMA(a0, 14, 2) FP4_FMA(a1, 15, 3)
#undef FP4_FMA
                a0 += a1; part[j] = a0.x + a0.y; __builtin_amdgcn_sched_barrier(0); }
            if (hu < 15) PEER_ISSUE_U(idx_nx);
            float s2[2];
#pragma unroll
            for (int k = 0; k < 2; ++k) { const float keep = b4 ? part[k + 2] : part[k], send = b4 ? part[k] : part[k + 2]; s2[k] = keep + swz_xor<16>(send); }
            float s1; { const float keep = b3 ? s2[1] : s2[0], send = b3 ? s2[0] : s2[1]; s1 = keep + swz_xor<8>(send); }
            s1 += swz_xor<4>(s1); s1 += swz_xor<1>(s1); s1 += swz_xor<2>(s1);
            const float wL = lru::fast_gelu(s1 * suL) * gL;
#pragma unroll
            for (int j = 0; j < 4; ++j) {
                const int src0 = ((j >> 1) & 1) * 16 + (j & 1) * 8;
                const float w0 = __uint_as_float(__builtin_amdgcn_readlane(__float_as_uint(wL), src0)), w1 = __uint_as_float(__builtin_amdgcn_readlane(__float_as_uint(wL), src0 + 32));
                const float wk = hb ? w1 : w0;
                const v32f z = __builtin_amdgcn_cvt_scalef32_pk32_f32_fp6(vd[j], 1.0f); const f32x2 wk2 = (f32x2){wk, wk};
#pragma unroll
                for (int k = 0; k < 16; ++k) y2[k] += wk2 * (f32x2){z[2 * k], z[2 * k + 1]};
                __builtin_amdgcn_sched_barrier(0); }
            if (hu < 15) PEER_ISSUE(vd, rsV, idx_nx);
        }
#undef PEER_ISSUE
#undef PEER_ISSUE_U
        float ye[16];
        { float yt[32];
#pragma unroll
          for (int k = 0; k < 32; ++k) { const float yk = (k & 1) ? y2[k >> 1].y : y2[k >> 1].x; auto rr = __builtin_amdgcn_permlane32_swap(__float_as_uint(yk), __float_as_uint(yk), false, false); yt[k] = __uint_as_float(rr[0]) + __uint_as_float(rr[1]); }
          float yo[32];
#pragma unroll
          for (int k = 0; k < 32; ++k) yo[fp6_src_of(k)] = yt[k];
          const unsigned hm = 0u - (unsigned)hb;
#pragma unroll
          for (int e = 0; e < 16; ++e) ye[e] = __uint_as_float(msel(__float_as_uint(yo[e]), __float_as_uint(yo[16 + e]), hm)); }
        int lane_e = lane; asm volatile("" : "+v"(lane_e));
        const int ridx = row_mod_idx(tok); const float* g2 = MOD + ((size_t)li * 9 + ridx) * 6144 + 5 * 1024; const int c0 = (lane_e & 31) * 32 + (lane_e >> 5) * 16;
        float xn[16]; float ss = 0.f; const float* xp = X + (size_t)tok * D + c0; float* xw = Xw + (size_t)tok * D + c0;
#pragma unroll
        for (int q = 0; q < 4; ++q) { const float4 xv = *(const float4*)(xp + 4 * q), gg = *(const float4*)(g2 + c0 + 4 * q);
            xn[4 * q] = xv.x + gg.x * ye[4 * q]; xn[4 * q + 1] = xv.y + gg.y * ye[4 * q + 1]; xn[4 * q + 2] = xv.z + gg.z * ye[4 * q + 2]; xn[4 * q + 3] = xv.w + gg.w * ye[4 * q + 3];
            *(float4*)(xw + 4 * q) = make_float4(xn[4 * q], xn[4 * q + 1], xn[4 * q + 2], xn[4 * q + 3]);
            ss += xn[4 * q] * xn[4 * q] + xn[4 * q + 1] * xn[4 * q + 1] + xn[4 * q + 2] * xn[4 * q + 2] + xn[4 * q + 3] * xn[4 * q + 3]; }
        const float rs = rsqrtf(wave_sum(ss) * (1.f / D) + EPS);
        if (li < DEPTH - 1) {
            const float* gN = p.norm1_g + (li + 1) * D; const float* mrow = MOD + ((size_t)(li + 1) * 9 + ridx) * 6144; float o[16];
#pragma unroll
            for (int q = 0; q < 4; ++q) { const float4 gg = *(const float4*)(gN + c0 + 4 * q), sh = *(const float4*)(mrow + c0 + 4 * q), sc = *(const float4*)(mrow + 1024 + c0 + 4 * q);
                o[4 * q] = xn[4 * q] * rs * gg.x * (1.f + sc.x) + sh.x; o[4 * q + 1] = xn[4 * q + 1] * rs * gg.y * (1.f + sc.y) + sh.y;
                o[4 * q + 2] = xn[4 * q + 2] * rs * gg.z * (1.f + sc.z) + sh.z; o[4 * q + 3] = xn[4 * q + 3] * rs * gg.w * (1.f + sc.w) + sh.w; }
            *(u32x4*)(HXo + (size_t)tok * D + c0) = (u32x4){pk2(o[0], o[1]), pk2(o[2], o[3]), pk2(o[4], o[5]), pk2(o[6], o[7])};
            *(u32x4*)(HXo + (size_t)tok * D + c0 + 8) = (u32x4){pk2(o[8], o[9]), pk2(o[10], o[11]), pk2(o[12], o[13]), pk2(o[14], o[15])};
        } else {
            float* op = OUTw + (size_t)tok * D + c0;
#pragma unroll
            for (int q = 0; q < 4; ++q) { const float4 gg = *(const float4*)(p.final_g + c0 + 4 * q);
                *(float4*)(op + 4 * q) = make_float4(xn[4 * q] * rs * gg.x, xn[4 * q + 1] * rs * gg.y, xn[4 * q + 2] * rs * gg.z, xn[4 * q + 3] * rs * gg.w); }
        }
    }
}
template <bool ROPEPERM>
__device__ __forceinline__ void p0_transpose_item(const float* W, int K, int N, bf16_t* WT, LAS float* scr, int item, int lane) {
    const int nblk = N / 32, kb = item / nblk, nbk = item % nblk, k0 = 64 * kb, n0 = 32 * nbk;
#pragma unroll 8
    for (int i = 0; i < 32; ++i) { const int kk = 2 * i + (lane >> 5); scr[kk * 33 + (lane & 31)] = W[(size_t)(k0 + kk) * N + n0 + (lane & 31)]; }
    LDS_WAIT(); asm volatile("" ::: "memory");
    const int c = lane & 7;
#pragma unroll
    for (int j = 0; j < 4; ++j) { const int n = (lane >> 3) + 8 * j; const int ns = ROPEPERM ? ((n & 1) * 16 + (n >> 1)) : n; const LAS float* s = scr + (8 * c) * 33 + ns;
        v4u o; o.x = pk2(s[0 * 33], s[1 * 33]); o.y = pk2(s[2 * 33], s[3 * 33]); o.z = pk2(s[4 * 33], s[5 * 33]); o.w = pk2(s[6 * 33], s[7 * 33]);
        *(GAS v4u*)(WT + (size_t)(n0 + n) * K + k0 + 8 * c) = o; }
    LDS_WAIT(); asm volatile("" ::: "memory");
}

__device__ __forceinline__ void ph_prologue(const P& p, int bid, int nb, unsigned char* lds) {
    const int tid = otid(), lane = tid & 63, wave = tid >> 6; const long gtid = (long)bid * NTHREADS + tid, gsz = (long)nb * NTHREADS;
    float2* R = (float2*)(p.ws + WS_ROPE);
    for (long i = gtid; i < 2048 * 32; i += gsz) { const int t = (int)(i >> 5), j = (int)(i & 31), a = j >> 4, f = j & 15;
        const float pos = a == 0 ? (float)(t >> 6) : (float)(t & 63); const float inv = exp2f(-(float)f * (13.287712379549449f / 16.0f)); const float ang = pos * inv;
        R[i] = make_float2(__cosf(ang), __sinf(ang)); }
    if (gtid < 4) { const int li = (int)gtid; const float* lp = p.diff_lam + li * 4 * 64; float s0 = 0, s1 = 0; for (int d = 0; d < 64; ++d) { s0 += lp[d] * lp[64 + d]; s1 += lp[128 + d] * lp[192 + d]; }
        ((float*)(p.ws + WS_LAM))[li] = expf(s0) - expf(s1) + lambda_init_of(li); }
    { bf16_t* KB = (bf16_t*)(p.ws + WS_KEYS); for (long i = gtid; i < (long)4 * 16 * 128 * 64; i += gsz) KB[i] = f2bf(p.peer_keys[i]); }
    {
        float* s = (float*)lds;
        for (int i = tid; i < 9 * 1024; i += NTHREADS) { const int r = i >> 10, k = i & 1023; const float v = r < 8 ? p.c[r * 1024 + k] : p.c_ctx[k]; s[i] = siluf_(v); }
        __syncthreads();
        float* MODP = (float*)(p.ws + WS_MODP);
        for (int item = bid; item < 8 * 4 * 12; item += nb) {
            const int ks = item / 48, li = (item / 12) & 3, jb = item % 12; const int j = jb * 512 + tid; const float* W = p.mod_w + ((size_t)li * 1024 + ks * 128) * 6144 + j; const float* sk = s + ks * 128;
            float a0 = 0, a1 = 0, a2 = 0, a3 = 0, a4 = 0, a5 = 0, a6 = 0, a7 = 0, a8 = 0;
#pragma unroll 4
            for (int k = 0; k < 128; ++k) { const float w = W[(size_t)k * 6144];
                a0 += sk[k] * w; a1 += sk[1024 + k] * w; a2 += sk[2048 + k] * w; a3 += sk[3072 + k] * w; a4 += sk[4096 + k] * w; a5 += sk[5120 + k] * w; a6 += sk[6144 + k] * w; a7 += sk[7168 + k] * w; a8 += sk[8192 + k] * w; }
            float* o = MODP + ((size_t)(ks * 4 + li) * 9) * 6144 + j;
            o[0 * 6144] = a0; o[1 * 6144] = a1; o[2 * 6144] = a2; o[3 * 6144] = a3; o[4 * 6144] = a4; o[5 * 6144] = a5; o[6 * 6144] = a6; o[7 * 6144] = a7; o[8 * 6144] = a8;
        }
        __syncthreads();
    }
    {
        LAS float* scr = (LAS float*)((LAS unsigned char*)lds + wave * 16384);
        const int gw = bid * NWAVES + wave, NGW = nb * NWAVES;
        constexpr int I_IN = (D / 64) * (DIN / 32), I_SQ = (D / 64) * (D / 32);
        constexpr int PER_L = I_IN + 4 * I_SQ, NITEMS = DEPTH * PER_L;
        for (int it = gw; it < NITEMS; it += NGW) {
            const int li = it / PER_L; int r = it % PER_L;
            if (r < I_IN) { const int nbk = r % (DIN / 32); const bool perm = nbk >= (C_Q / 32) && nbk < (C_V / 32);
                const float* W = p.w_in + (size_t)li * D * DIN; bf16_t* WT = (bf16_t*)(p.ws + WS_WIN_T) + (size_t)li * DIN * D;
                if (perm) p0_transpose_item<true>(W, D, DIN, WT, scr, r, lane); else p0_transpose_item<false>(W, D, DIN, WT, scr, r, lane);
                continue; }
            r -= I_IN; const int which = r / I_SQ; r %= I_SQ;
            const float* W = (which == 0 ? p.w_br_lru : which == 1 ? p.w_br_attn : which == 2 ? p.w_out : p.peer_wq) + (size_t)li * D * D;
            bf16_t* WT = (bf16_t*)(p.ws + (which == 0 ? WS_WBL_T : which == 1 ? WS_WBA_T : which == 2 ? WS_WOUT_T : WS_WQ_T)) + (size_t)li * D * D;
            p0_transpose_item<false>(W, D, D, WT, scr, r, lane);
        }
    }
}
__device__ __forceinline__ void ph_modfin(const P& p, int bid, int nb) {
    const long gtid = (long)bid * NTHREADS + otid(), gsz = (long)nb * NTHREADS; const float* MODP = (const float*)(p.ws + WS_MODP); float* MOD = (float*)(p.ws + WS_MOD);
    for (long i = gtid; i < 4 * 9 * 6144; i += gsz) { const int j = (int)(i % 6144), li = (int)(i / (9 * 6144)); float a = p.mod_b[li * 6144 + j];
#pragma unroll
        for (int ks = 0; ks < 8; ++ks) a += MODP[(size_t)ks * 4 * 9 * 6144 + i];
        MOD[i] = a; }
}

constexpr int NPL = 8;
constexpr int NSTEPS = 3 + DEPTH * NPL;

__device__ __forceinline__ void run_step(const P& p, int s, int bid, int nb, unsigned char* lds) {
    bf16_t* HX = (bf16_t*)(p.ws + WS_HX); bf16_t* PROJ = (bf16_t*)(p.ws + WS_PROJ); bf16_t* LA = (bf16_t*)(p.ws + WS_LA); bf16_t* ATT = (bf16_t*)(p.ws + WS_ATT);
    bf16_t* MIX = (bf16_t*)(p.ws + WS_MIX); bf16_t* PQ = (bf16_t*)(p.ws + WS_PQ); float* X = (float*)(p.ws + WS_X); const float* MOD = (const float*)(p.ws + WS_MOD);
    PG8_LAS unsigned char* glds = (PG8_LAS unsigned char*)lds;
    if (s == 0) { ph_prologue(p, bid, nb, lds);
#if PROBE_CAT == 11
        for (int r2 = 0; r2 < PROBE_N; ++r2) { __syncthreads(); ph_prologue(p, bid, nb, lds); }
#endif
        return; }
    if (s == 1) { ph_modfin(p, bid, nb); return; }
    if (s == 2) { ph_norm(p, bid, nb, p.norm1_g, 0, 0, 1, MT, HX, true); return; }
    const int li = (s - 3) / NPL, ph = (s - 3) % NPL; const bool do_ctx = li < DEPTH - 1; const int Mr = do_ctx ? MT : ML;
    const int extra = (PROBE_CAT != 0 && ph + 1 == PROBE_CAT) ? PROBE_N : 0;
    for (int rep = 0; rep <= extra; ++rep) { const bool dry = rep < extra;
    float* Xo = dry ? (float*)(p.ws + WS_HF) : X;
    switch (ph) {
    case 0: {
        pg8::Gemm g{HX, (const bf16_t*)(p.ws + WS_WIN_T) + (size_t)li * DIN * D, MT, DIN, D}; pg8::StaticOrder S; S.init(MT, DIN, nb, bid);
        pg8::EpiIn E{PROJ, (const float*)(p.ws + WS_ROPE)};
        pg8::gemm_phase<pg8::EpiIn, pg8::StaticOrder, true, true>(glds, g, S, E);
    } break;
    case 1: ph_lru(p, li, bid, nb, lds);
        ph_peer_tables(p, li, bid, nb);
#if PROBE_CAT == 10
        for (int r2 = 0; r2 < PROBE_N; ++r2) ph_lru(p, li, bid, nb, lds);
#endif
        ph_attn(p, li, do_ctx, bid, nb, lds);
#if PROBE_CAT == 9
        for (int r2 = 0; r2 < PROBE_N; ++r2) ph_attn(p, li, do_ctx, bid, nb, lds);
#endif
        break;
    case 2: {
        { pg8::Gemm g{LA, (const bf16_t*)(p.ws + WS_WBL_T) + (size_t)li * D * D, Mr, D, D}; pg8::StaticOrder S; S.init(Mr, D, nb, bid);
          pg8::EpiBr<false> E{PROJ, MIX, C_GA}; pg8::gemm_phase<pg8::EpiBr<false>, pg8::StaticOrder, true, true>(glds, g, S, E); }
        { pg8::Gemm g{ATT, (const bf16_t*)(p.ws + WS_WBA_T) + (size_t)li * D * D, Mr, D, D}; pg8::StaticOrder S; S.init(Mr, D, nb, bid);
          pg8::EpiBr<true> E{PROJ, MIX, C_GB}; pg8::gemm_phase<pg8::EpiBr<true>, pg8::StaticOrder, true, true>(glds, g, S, E); }
    } break;
    case 3: {
        pg8::Gemm g{MIX, (const bf16_t*)(p.ws + WS_WOUT_T) + (size_t)li * D * D, Mr, D, D}; pg8::StaticOrder S; S.init(Mr, D, nb, bid);
        pg8::EpiOut E{li == 0 ? p.x : X, li == 0 ? p.ctx - (size_t)ML * D : X, Xo, MOD + (size_t)li * 9 * 6144 + 2 * 1024};   pg8::gemm_phase<pg8::EpiOut, pg8::StaticOrder, true, true>(glds, g, S, E);
    } break;
    case 4: ph_norm(p, bid, nb, p.norm2_g + li * D, li, 3, 4, Mr, HX, false); break;
    case 5: {
        pg8::Gemm g{HX, (const bf16_t*)(p.ws + WS_WQ_T) + (size_t)li * D * D, Mr, D, D}; pg8::StaticOrder S; S.init(Mr, D, nb, bid);
        pg8::EpiPlain E{PQ}; pg8::gemm_phase<pg8::EpiPlain, pg8::StaticOrder, true, true>(glds, g, S, E);
    } break;
    case 6: ph_peer_score(p, li, Mr, bid, nb); break;
    case 7: ph_peer_expert(p, li, Mr, bid, nb, dry); break;
    }
    }
}

constexpr int RING_BYTES = 155648, LDSCTL_OFF = RING_BYTES, MISC_OFF = LDSCTL_OFF + 320, LDS_BYTES = RING_BYTES + 1024;
constexpr int CW_BAR = 4096;
#ifndef N_LAUNCH_MODE
#define N_LAUNCH_MODE 1
#endif

__global__ void __launch_bounds__(NTHREADS, 2) mega(P p) {
    extern __shared__ __attribute__((aligned(16))) unsigned char lds[];
    const int tid = threadIdx.x;
    for (int u = tid; u < (LDS_BYTES - LDSCTL_OFF) / 4; u += NTHREADS) ((LAS unsigned*)((LAS unsigned char*)lds + LDSCTL_OFF))[u] = 0u;
    __syncthreads();
    volatile LAS unsigned* MISC = (volatile LAS unsigned*)((LAS unsigned char*)lds + MISC_OFF);
    XcdBarrier bar = xcd_barrier_post((unsigned*)(p.ws + WS_CTL) + CW_BAR, MISC + 8);
    const int bid = blockIdx.x, nb = gridDim.x;
    for (int s = p.lo; s < p.hi; ++s) {
        P q = p; int bido = bid, nbo = nb;
        asm volatile("" : "+s"(bido), "+s"(nbo));
        run_step(q, s, bido, nbo, lds);
        if (s + 1 < p.hi) xcd_barrier(bar);
#if PROBE_CAT == 12
        for (int r2 = 0; r2 < PROBE_N; ++r2) xcd_barrier(bar);
#endif
    }
}

extern "C" void kernel_launch(void* const* d_in, const int* in_sizes, int n_in, void* d_out, int out_size, void* d_ws, size_t ws_size, hipStream_t stream) {
    static int grid = 0;
    if (grid == 0) {
        if (n_in != 24 || ws_size < WS_END) { fprintf(stderr, "kernel_launch: n_in %d ws %zu need %zu\n", n_in, ws_size, (size_t)WS_END); grid = -1; return; }
        int dev = 0, cus = 0, per_cu = 0;
        if (hipGetDevice(&dev) != hipSuccess || hipDeviceGetAttribute(&cus, hipDeviceAttributeMultiprocessorCount, dev) != hipSuccess) { grid = -1; return; }
        if (hipFuncSetAttribute((const void*)mega, hipFuncAttributeMaxDynamicSharedMemorySize, LDS_BYTES) != hipSuccess) { fprintf(stderr, "kernel_launch: hipFuncSetAttribute failed\n"); grid = -1; return; }
        if (hipOccupancyMaxActiveBlocksPerMultiprocessor(&per_cu, (const void*)mega, NTHREADS, LDS_BYTES) != hipSuccess || per_cu < 1) { fprintf(stderr, "kernel_launch: occupancy query says %d\n", per_cu); per_cu = 1; }
        (void)hipGetLastError();
        grid = cus > 256 ? 256 : cus;
    }
    if (grid < 0) return;
    (void)hipMemsetAsync((char*)d_ws + WS_CTL, 0, CTL_ZERO_BYTES, stream);
    P p{};
    const float** pp = (const float**)&p;
    for (int i = 0; i < 24; ++i) pp[i] = (const float*)d_in[i];
    p.out = (float*)d_out; p.ws = (unsigned char*)d_ws;
#if N_LAUNCH_MODE == 1
    p.lo = 0; p.hi = NSTEPS; hipLaunchKernelGGL(mega, dim3(grid), dim3(NTHREADS), LDS_BYTES, stream, p);
#else
    for (int s = 0; s < NSTEPS; ++s) { p.lo = s; p.hi = s + 1; hipLaunchKernelGGL(mega, dim3(grid), dim3(NTHREADS), LDS_BYTES, stream, p); }
#endif
}
```

```cpp
#include <hip/hip_runtime.h>
#include <cstdio>
#include <cstdint>

#ifndef PROBE_CAT
#define PROBE_CAT 0
#endif
#ifndef PROBE_N
#define PROBE_N 1
#endif
#define PEER_DBG_SIMPLE_REDUCE 0
#define PEER_DBG_NAIVE_EPI 0
#ifndef OPT_LRU
#define OPT_LRU 1
#endif
constexpr int D = 1024, NBATCH = 8, SEQ = 2048, CTXL = 256, DEPTH = 4;
constexpr int ML = NBATCH * SEQ, MC = NBATCH * CTXL, MT = ML + MC;
constexpr int DIN = 7168;
constexpr int C_U = 0, C_GL = 1024, C_Q = 2048, C_K = 3072, C_V = 4096, C_GA = 5120, C_GB = 6144;
constexpr float EPS = 1e-6f;
constexpr int NTHREADS = 512, NWAVES = 8;

typedef unsigned short bf16_t;
__device__ __forceinline__ float bf2f(bf16_t v) { return __uint_as_float(((unsigned)v) << 16); }
__device__ __forceinline__ unsigned pk2(float lo, float hi) { unsigned r; asm("v_cvt_pk_bf16_f32 %0, %1, %2" : "=v"(r) : "v"(lo), "v"(hi)); return r; }
__device__ __forceinline__ bf16_t f2bf(float f) { return (bf16_t)(pk2(f, f) & 0xffffu); }
__device__ __forceinline__ float sigmoidf_(float x) { return 1.f / (1.f + __expf(-x)); }
__device__ __forceinline__ float gelu_tanh(float x) { const float u = 0.7978845608028654f * (x + 0.044715f * x * x * x); return 0.5f * x * (1.f + tanhf(u)); }
__device__ __forceinline__ float siluf_(float x) { return x / (1.f + expf(-x)); }

constexpr size_t MiB = 1u << 20;
constexpr size_t WS_CTL = 0, CTL_ZERO_BYTES = 1 * MiB;
constexpr size_t WS_X = 1 * MiB;
constexpr size_t WS_HX = WS_X + (size_t)MT * D * 4;
constexpr size_t WS_PROJ = WS_HX + (size_t)MT * D * 2;
constexpr size_t WS_LA = WS_PROJ + (size_t)MT * DIN * 2;
constexpr size_t WS_ATT = WS_LA + (size_t)MT * D * 2;
constexpr size_t WS_MIX = WS_ATT + (size_t)MT * D * 2;
constexpr size_t WS_IDX = WS_MIX + (size_t)MT * D * 2;
constexpr size_t WS_G = WS_IDX + (size_t)MT * 128 * 4;
constexpr size_t WS_MOD = WS_G + (size_t)MT * 128 * 4;
constexpr size_t WS_ROPE = WS_MOD + (size_t)4 * 9 * 6144 * 4;
constexpr size_t WS_LAM = WS_ROPE + (size_t)2048 * 32 * 2 * 4;
constexpr size_t WS_MODP = WS_LAM + 256;
constexpr size_t WS_WIN_T = WS_MODP + (size_t)8 * 4 * 9 * 6144 * 4;
constexpr size_t WS_WBL_T = WS_WIN_T + (size_t)4 * DIN * D * 2;
constexpr size_t WS_WBA_T = WS_WBL_T + (size_t)4 * D * D * 2;
constexpr size_t WS_WOUT_T = WS_WBA_T + (size_t)4 * D * D * 2;
constexpr size_t WS_WQ_T = WS_WOUT_T + (size_t)4 * D * D * 2;
constexpr size_t WS_STASH = WS_WQ_T + (size_t)4 * D * D * 2;
constexpr size_t WS_KEYS = WS_STASH + (size_t)256 * 8 * 64 * 64 * 4;
constexpr size_t WS_PU = WS_KEYS + (size_t)4 * 16 * 128 * 64 * 2;
constexpr size_t WS_PV = WS_PU + (size_t)16384 * 1024;
constexpr size_t WS_SU = WS_PV + (size_t)16384 * 1024;
constexpr size_t WS_SV = WS_SU + (size_t)16384 * 4;
constexpr size_t WS_HF = WS_SV + (size_t)16384 * 4;
constexpr size_t WS_UC = WS_HF;
constexpr size_t WS_HD = WS_UC + (size_t)MT * D * 4;
#if OPT_LRU
constexpr size_t WS_END = WS_HF + (size_t)MT * D * 4;
#else
constexpr size_t WS_END = WS_HD + (size_t)2 * MT * D * 4;
#endif
#define WS_PQ WS_LA

struct P {
    const float *x, *c, *ctx, *c_ctx, *mod_w, *mod_b, *norm1_g, *norm2_g, *w_in, *conv_w, *conv_b, *lru_w, *lru_b, *lru_lam, *diff_lam, *subln_g,
        *w_br_lru, *w_br_attn, *w_out, *peer_wq, *peer_keys, *peer_u, *peer_v, *final_g;
    float* out; unsigned char* ws; int lo, hi;
};

__device__ __forceinline__ int otid() { int t = threadIdx.x; asm volatile("" : "+v"(t)); return t; }
__device__ __forceinline__ int row_mod_idx(int row) { return row < ML ? (row >> 11) : 8; }
__device__ __forceinline__ float lambda_init_of(int li) { return 0.8f - 0.6f * expf(-0.3f * (float)li); }

namespace pg8 {
#define PG8_LAS __attribute__((address_space(3)))
typedef unsigned short bf16_t;
typedef short bf16x8 __attribute__((ext_vector_type(8)));
typedef float f32x4 __attribute__((ext_vector_type(4)));
typedef unsigned u32x4 __attribute__((ext_vector_type(4)));
constexpr int BM = 256, BK = 64, HALF = 128, HTB = HALF * BK * 2  , STAGE_BYTES = 8 * HTB, NXCD = 8, WGM = 8;

__host__ __device__ __forceinline__ int lds_byte(int r, int c) { const int st = (r >> 4) * 2 + (c >> 5), rr = r & 15, cc = c & 31, ob = rr * 64 + cc * 2; return st * 1024 + (ob ^ (((ob >> 9) & 1) << 5)); }
__host__ __device__ __forceinline__ void stage_rc(int b, int& R, int& C) { const int st = b / 1024, sb = b % 1024, swz = sb ^ (((sb >> 9) & 1) << 5); R = (st >> 1) * 16 + swz / 64; C = (st & 1) * 32 + (swz % 64) / 2; }
__host__ __device__ __forceinline__ int perm32(int rho) { const int n = rho >> 4, i = rho & 15; return 8 * (i >> 2) + 4 * n + (i & 3); }

struct Unit { int pm, pn; };
struct Gemm { const bf16_t* A; const bf16_t* Bt; int M, N, K; };

struct StaticOrder {
    int nM, nN, nwg, G, c;
    __host__ __device__ void init(int M, int N, int G_, int c_) { nM = M / BM; nN = N / BM; nwg = nM * nN; G = G_; c = c_; }
    __host__ __device__ bool next(int i, Unit& u) const {
        const long L = (long)i * G + c; if (L >= nwg) return false;
        int wgid = (int)L; { const int q = nwg / NXCD, r = nwg % NXCD, xcd = wgid % NXCD, off = wgid / NXCD; wgid = (xcd < r ? xcd * (q + 1) : r * (q + 1) + (xcd - r) * q) + off; }
        const int nig = WGM * nN, gid = wgid / nig, fm = gid * WGM, gsz = (nM - fm) < WGM ? (nM - fm) : WGM;
        u.pm = fm + ((wgid % nig) % gsz); u.pn = (wgid % nig) / gsz; return true;
    }
    __device__ __forceinline__ void a_ready(const Unit&) const {}
    __device__ __forceinline__ void done(const Unit&) const {}
};

__device__ __forceinline__ unsigned cvt_pk_bf16(float lo, float hi) { unsigned r; asm volatile("v_cvt_pk_bf16_f32 %0, %1, %2" : "=v"(r) : "v"(lo), "v"(hi)); return r; }
typedef float f32x2 __attribute__((ext_vector_type(2)));
__device__ __forceinline__ f32x2 gelu_pk(f32x2 v) {
    const f32x2 av = __builtin_elementwise_abs(v), d = av * 0.2316418882f + 1.0f;
    f32x2 t; t.x = __builtin_amdgcn_rcpf(d.x); t.y = __builtin_amdgcn_rcpf(d.y);
    f32x2 q = t * 0.5307027145f + (-0.7265760135f); q = q * t + 0.7107068705f; q = q * t + (-0.142248368f); q = q * t + 0.127414796f; q = q * t;
    const f32x2 s = (v * v) * (-0.72134752044f);
    f32x2 e; e.x = __builtin_amdgcn_exp2f(s.x); e.y = __builtin_amdgcn_exp2f(s.y);
    const f32x2 m = v * (q * e), r = v - m;
    f32x2 o; o.x = v.x < 0.f ? m.x : r.x; o.y = v.y < 0.f ? m.y : r.y; return o;
}

template <int ACT  > struct EpiBf16 {
    static constexpr bool PERM = true, AFTER_DRAIN = false; static_assert(ACT == 0 || ACT == 1, "EpiBf16: ACT is 0 (none) or 1 (gelu_pk)");
    bf16_t* O; int ldc; const float* bias; int split_cols; size_t split_stride; float scale0;
    __device__ __forceinline__ void operator()(const f32x4 (&acc)[2][2][4][2], const Unit& u, int wr, int wc, int fr, int fq) const {
        const int row0 = u.pm * BM + wr * 64 + fr; int colt = u.pn * BM; bf16_t* base = O;
        float sc = 1.f; if (split_cols) { const int t = colt / split_cols; base += (size_t)t * split_stride; colt -= t * split_cols; if (t == 0) sc = scale0; }
        const int col0 = colt + wc * 32 + 8 * fq, bcol0 = u.pn * BM + wc * 32 + 8 * fq;
        f32x4 bv[2][2];
#pragma unroll
        for (int bj = 0; bj < 2; ++bj)
#pragma unroll
            for (int n = 0; n < 2; ++n) bv[bj][n] = bias ? *(const f32x4*)(bias + bcol0 + bj * HALF + 4 * n) : (f32x4){0.f, 0.f, 0.f, 0.f};
#pragma unroll
        for (int ai = 0; ai < 2; ++ai)
#pragma unroll
            for (int m = 0; m < 4; ++m) { bf16_t* rowp = base + (size_t)(row0 + ai * HALF + m * 16) * ldc + col0;
#pragma unroll
                for (int bj = 0; bj < 2; ++bj) { f32x4 v0 = acc[ai][bj][m][0] + bv[bj][0], v1 = acc[ai][bj][m][1] + bv[bj][1];
                    if (ACT == 1) { f32x2 a = gelu_pk((f32x2){v0[0], v0[1]}), b = gelu_pk((f32x2){v0[2], v0[3]}), c = gelu_pk((f32x2){v1[0], v1[1]}), d = gelu_pk((f32x2){v1[2], v1[3]});
                        v0 = (f32x4){a.x, a.y, b.x, b.y}; v1 = (f32x4){c.x, c.y, d.x, d.y}; }
                    v0 = v0 * sc; v1 = v1 * sc; u32x4 w; w.x = cvt_pk_bf16(v0[0], v0[1]); w.y = cvt_pk_bf16(v0[2], v0[3]); w.z = cvt_pk_bf16(v1[0], v1[1]); w.w = cvt_pk_bf16(v1[2], v1[3]);
                    *(u32x4*)(rowp + bj * HALF) = w; } }
    }
};
__device__ __forceinline__ float bflo(unsigned w) { return __uint_as_float(w << 16); }
__device__ __forceinline__ float bfhi(unsigned w) { return __uint_as_float(w & 0xffff0000u); }
__device__ __forceinline__ float sigm(float x) { return 1.f / (1.f + __expf(-x)); }

struct EpiIn {
    static constexpr bool PERM = true, AFTER_DRAIN = false;
    bf16_t* O; const float* rope;
    __device__ __forceinline__ void operator()(const f32x4 (&acc)[2][2][4][2], const Unit& u, int wr, int wc, int fr, int fq) const {
        const int row0 = u.pm * BM + wr * 64 + fr, col0 = u.pn * BM + wc * 32 + 8 * fq;
        const bool dorope = (u.pn >= 8) && (u.pn < 16) && (u.pm < 64);
        const int i0 = ((wc & 1) << 4) + 4 * fq;
        const bool qscale = (u.pn >= 8) && (u.pn < 12); constexpr float QSC = 0.125f * 1.4426950408889634f;
#pragma unroll
        for (int ai = 0; ai < 2; ++ai)
#pragma unroll
            for (int m = 0; m < 4; ++m) { const int row = row0 + ai * HALF + m * 16; bf16_t* rowp = O + (size_t)row * DIN + col0;
                f32x4 r0 = {1.f, 0.f, 1.f, 0.f}, r1 = {1.f, 0.f, 1.f, 0.f};
                if (dorope) { const f32x4* rp = (const f32x4*)(rope + ((size_t)(row & 2047) * 32 + i0) * 2); r0 = rp[0]; r1 = rp[1]; }
#pragma unroll
                for (int bj = 0; bj < 2; ++bj) { f32x4 v0 = acc[ai][bj][m][0], v1 = acc[ai][bj][m][1];
                    if (dorope) { f32x4 a, b;
                        a[0] = v0[0] * r0[0] - v0[1] * r0[1]; a[1] = v0[1] * r0[0] + v0[0] * r0[1]; a[2] = v0[2] * r0[2] - v0[3] * r0[3]; a[3] = v0[3] * r0[2] + v0[2] * r0[3];
                        b[0] = v1[0] * r1[0] - v1[1] * r1[1]; b[1] = v1[1] * r1[0] + v1[0] * r1[1]; b[2] = v1[2] * r1[2] - v1[3] * r1[3]; b[3] = v1[3] * r1[2] + v1[2] * r1[3];
                        v0 = a; v1 = b; }
                    if (qscale) { v0 *= QSC; v1 *= QSC; }
                    u32x4 w; w.x = cvt_pk_bf16(v0[0], v0[1]); w.y = cvt_pk_bf16(v0[2], v0[3]); w.z = cvt_pk_bf16(v1[0], v1[1]); w.w = cvt_pk_bf16(v1[2], v1[3]);
                    *(u32x4*)(rowp + bj * HALF) = w; } }
    }
};
struct EpiPlain {
    static constexpr bool PERM = true, AFTER_DRAIN = false;
    bf16_t* O;
    __device__ __forceinline__ void operator()(const f32x4 (&acc)[2][2][4][2], const Unit& u, int wr, int wc, int fr, int fq) const {
        const int row0 = u.pm * BM + wr * 64 + fr, col0 = u.pn * BM + wc * 32 + 8 * fq;
#pragma unroll
        for (int ai = 0; ai < 2; ++ai)
#pragma unroll
            for (int m = 0; m < 4; ++m) { bf16_t* rowp = O + (size_t)(row0 + ai * HALF + m * 16) * D + col0;
#pragma unroll
                for (int bj = 0; bj < 2; ++bj) { const f32x4 v0 = acc[ai][bj][m][0], v1 = acc[ai][bj][m][1];
                    u32x4 w; w.x = cvt_pk_bf16(v0[0], v0[1]); w.y = cvt_pk_bf16(v0[2], v0[3]); w.z = cvt_pk_bf16(v1[0], v1[1]); w.w = cvt_pk_bf16(v1[2], v1[3]);
                    *(u32x4*)(rowp + bj * HALF) = w; } }
    }
};
template <bool ADD> struct EpiBr {
    static constexpr bool PERM = true, AFTER_DRAIN = false;
    const bf16_t* PROJ; bf16_t* MIX; int gcol;
    __device__ __forceinline__ void operator()(const f32x4 (&acc)[2][2][4][2], const Unit& u, int wr, int wc, int fr, int fq) const {
        const int row0 = u.pm * BM + wr * 64 + fr, col0 = u.pn * BM + wc * 32 + 8 * fq;
#pragma unroll
        for (int ai = 0; ai < 2; ++ai)
#pragma unroll
            for (int m = 0; m < 4; ++m) { const int row = row0 + ai * HALF + m * 16; bf16_t* rowp = MIX + (size_t)row * D + col0; const bf16_t* gp = PROJ + (size_t)row * DIN + gcol + col0;
#pragma unroll
                for (int bj = 0; bj < 2; ++bj) { const f32x4 v0 = acc[ai][bj][m][0], v1 = acc[ai][bj][m][1]; const u32x4 g = *(const u32x4*)(gp + bj * HALF);
                    float o[8] = {sigm(bflo(g.x)) * v0[0], sigm(bfhi(g.x)) * v0[1], sigm(bflo(g.y)) * v0[2], sigm(bfhi(g.y)) * v0[3], sigm(bflo(g.z)) * v1[0], sigm(bfhi(g.z)) * v1[1], sigm(bflo(g.w)) * v1[2], sigm(bfhi(g.w)) * v1[3]};
                    if (ADD) { const u32x4 q = *(const u32x4*)(rowp + bj * HALF); o[0] += bflo(q.x); o[1] += bfhi(q.x); o[2] += bflo(q.y); o[3] += bfhi(q.y); o[4] += bflo(q.z); o[5] += bfhi(q.z); o[6] += bflo(q.w); o[7] += bfhi(q.w); }
                    u32x4 w; w.x = cvt_pk_bf16(o[0], o[1]); w.y = cvt_pk_bf16(o[2], o[3]); w.z = cvt_pk_bf16(o[4], o[5]); w.w = cvt_pk_bf16(o[6], o[7]);
                    *(u32x4*)(rowp + bj * HALF) = w; } }
    }
};
struct EpiOut {
    static constexpr bool PERM = true, AFTER_DRAIN = false;
    const float* Xlat; const float* Xctx; float* Xo; const float* MODL;
    __device__ __forceinline__ void operator()(const f32x4 (&acc)[2][2][4][2], const Unit& u, int wr, int wc, int fr, int fq) const {
        const int row0 = u.pm * BM + wr * 64 + fr, col0 = u.pn * BM + wc * 32 + 8 * fq;
        const float* g1 = MODL + (size_t)(u.pm < 64 ? (u.pm >> 3) : 8) * 6144 + col0;
        f32x4 gv[2][2];
#pragma unroll
        for (int bj = 0; bj < 2; ++bj) { gv[bj][0] = *(const f32x4*)(g1 + bj * HALF); gv[bj][1] = *(const f32x4*)(g1 + bj * HALF + 4); }
#pragma unroll
        for (int ai = 0; ai < 2; ++ai)
#pragma unroll
            for (int m = 0; m < 4; ++m) { const size_t ro = (size_t)(row0 + ai * HALF + m * 16) * D + col0; const float* rowp = (u.pm < 64 ? Xlat : Xctx) + ro; float* rowo = Xo + ro;
#pragma unroll
                for (int bj = 0; bj < 2; ++bj) { const f32x4* xp = (const f32x4*)(rowp + bj * HALF); f32x4* xo = (f32x4*)(rowo + bj * HALF); f32x4 x0 = xp[0], x1 = xp[1];
                    x0 += gv[bj][0] * acc[ai][bj][m][0]; x1 += gv[bj][1] * acc[ai][bj][m][1]; xo[0] = x0; xo[1] = x1; } }
    }
};
template <class Epi, class Sched, bool ALIGN_EPI = false, bool SP2 = false>
__device__ __forceinline__ void gemm_phase(PG8_LAS unsigned char* lds, const Gemm g, const Sched& S, const Epi& E) {
    const int tid = otid(), wid = __builtin_amdgcn_readfirstlane(tid >> 6), lane = tid & 63, wr = wid >> 2, wc = wid & 3, fr = lane & 15, fq = lane >> 4;
    const int K = g.K, nt = K / BK;
    unsigned voffA[2], voffB[2];
#pragma unroll
    for (int i = 0; i < 2; ++i) { int R, C; stage_rc(tid * 16 + i * 8192, R, C); const int Rb = Epi::PERM ? ((R & ~31) + perm32(R & 31)) : R;
        voffA[i] = (unsigned)(R * K + C) * 2u; voffB[i] = (unsigned)(Rb * K + C) * 2u; }
    const size_t kstep = (size_t)(BK * 2);
    const size_t hstep = (size_t)HALF * K * 2;
    const size_t tstep = 2 * hstep;
    const unsigned ldsw = (unsigned)wid * 1024u;
    const int aoff = lds_byte(wr * 64 + fr, fq * 8), boff = lds_byte(wc * 32 + fr, fq * 8);
#define PG8_SA(b, h) (((b) * 2 + (h)) * HTB)
#define PG8_SB(b, h) ((4 + (b) * 2 + (h)) * HTB)
#define PG8_STAGE(bufoff, gbase, voff) do { _Pragma("unroll") for (int _i = 0; _i < 2; ++_i) \
        __builtin_amdgcn_global_load_lds((const unsigned*)((const char*)(gbase) + (voff)[_i]), (PG8_LAS unsigned*)(lds + (bufoff) + ldsw + _i * 8192), 16, 0, 0); } while (0)
#define PG8_LDA(dst, b, h) do { _Pragma("unroll") for (int m = 0; m < 4; ++m) _Pragma("unroll") for (int k = 0; k < 2; ++k) dst[m][k] = *(const PG8_LAS bf16x8*)(lds + PG8_SA(b, h) + aoff + m * 2048 + k * 1024); } while (0)
#define PG8_LDB(dst, b, h) do { _Pragma("unroll") for (int n = 0; n < 2; ++n) _Pragma("unroll") for (int k = 0; k < 2; ++k) dst[n][k] = *(const PG8_LAS bf16x8*)(lds + PG8_SB(b, h) + boff + n * 2048 + k * 1024); } while (0)
#define PG8_MMA(ai, bj, At, Bt) do { __builtin_amdgcn_s_setprio(1); _Pragma("unroll") for (int m = 0; m < 4; ++m) _Pragma("unroll") for (int n = 0; n < 2; ++n) _Pragma("unroll") for (int k = 0; k < 2; ++k) \
        acc[ai][bj][m][n] = __builtin_amdgcn_mfma_f32_16x16x32_bf16(Bt[n][k], At[m][k], acc[ai][bj][m][n], 0, 0, 0); __builtin_amdgcn_s_setprio(0); } while (0)
#define PG8_WAIT_V(n) asm volatile("s_waitcnt vmcnt(" #n ")" ::: "memory")
#define PG8_WAIT_L(n) asm volatile("s_waitcnt lgkmcnt(" #n ")" ::: "memory")
#define PG8_BAR __builtin_amdgcn_s_barrier()
#define PG8_SCHED __builtin_amdgcn_sched_barrier(0)
    Unit cur, nxt; int ui = 0;
    if (!S.next(0, cur)) return;
    f32x4 acc[2][2][4][2];
#pragma unroll
    for (int a = 0; a < 2; ++a)
#pragma unroll
        for (int b = 0; b < 2; ++b)
#pragma unroll
            for (int m = 0; m < 4; ++m)
#pragma unroll
                for (int n = 0; n < 2; ++n) acc[a][b][m][n] = (f32x4){0.f, 0.f, 0.f, 0.f};
    bf16x8 At[4][2], B0[2][2], B1[2][2];
    const char* cA = (const char*)g.A + (size_t)cur.pm * tstep; const char* cB = (const char*)g.Bt + (size_t)cur.pn * tstep;
    S.a_ready(cur);
    if constexpr (SP2) {
        PG8_STAGE(PG8_SB(0, 0), cB, voffB); PG8_STAGE(PG8_SB(0, 1), cB + hstep, voffB); PG8_STAGE(PG8_SA(0, 0), cA, voffA); PG8_STAGE(PG8_SA(0, 1), cA + hstep, voffA);
        if (wr == 1) PG8_BAR;
        PG8_WAIT_V(2); PG8_BAR;
        PG8_STAGE(PG8_SB(1, 0), cB + kstep, voffB); PG8_STAGE(PG8_SA(1, 0), cA + kstep, voffA); PG8_STAGE(PG8_SB(1, 1), cB + hstep + kstep, voffB);
        PG8_WAIT_V(6); PG8_BAR;
    } else {
        PG8_STAGE(PG8_SB(0, 0), cB, voffB); PG8_STAGE(PG8_SA(0, 0), cA, voffA); PG8_STAGE(PG8_SB(0, 1), cB + hstep, voffB); PG8_STAGE(PG8_SA(0, 1), cA + hstep, voffA);
        if (wr == 1) PG8_BAR;
        PG8_WAIT_V(4); PG8_BAR;
        PG8_STAGE(PG8_SB(1, 0), cB + kstep, voffB); PG8_STAGE(PG8_SA(1, 0), cA + kstep, voffA); PG8_STAGE(PG8_SB(1, 1), cB + hstep + kstep, voffB);
        PG8_WAIT_V(6); PG8_BAR;
    }
    for (;;) {
        const bool has_next = S.next(ui + 1, nxt);
        const char* nA = has_next ? (const char*)g.A + (size_t)nxt.pm * tstep : cA; const char* nB = has_next ? (const char*)g.Bt + (size_t)nxt.pn * tstep : cB;
        for (int t = 0; t < nt; t += 2) {
            const bool last = (t == nt - 2);
            const char* a1 = cA + (size_t)(t + 1) * kstep;
            const char* a2 = last ? nA : cA + (size_t)(t + 2) * kstep; const char* b2 = last ? nB : cB + (size_t)(t + 2) * kstep;
            const char* a3 = a2 + kstep; const char* b3 = b2 + kstep;
            if (last && has_next) S.a_ready(nxt);
            if constexpr (SP2) {
            PG8_LDB(B0, 0, 0); PG8_LDB(B1, 0, 1); PG8_SCHED; PG8_LDA(At, 0, 0); PG8_STAGE(PG8_SA(1, 1), a1 + hstep, voffA);
            PG8_WAIT_V(8); PG8_WAIT_L(0); PG8_BAR; PG8_MMA(0, 0, At, B0); PG8_MMA(0, 1, At, B1); PG8_BAR; PG8_SCHED;
            PG8_LDA(At, 0, 1); PG8_STAGE(PG8_SB(0, 0), b2, voffB); PG8_STAGE(PG8_SB(0, 1), b2 + hstep, voffB); PG8_STAGE(PG8_SA(0, 0), a2, voffA);
            PG8_WAIT_V(8); PG8_WAIT_L(0); PG8_BAR; PG8_MMA(1, 0, At, B0); PG8_MMA(1, 1, At, B1); PG8_BAR; PG8_SCHED;
            PG8_LDB(B0, 1, 0); PG8_LDB(B1, 1, 1); PG8_SCHED; PG8_LDA(At, 1, 0); PG8_STAGE(PG8_SA(0, 1), a2 + hstep, voffA);
            PG8_WAIT_V(8); PG8_WAIT_L(0); PG8_BAR; PG8_MMA(0, 0, At, B0); PG8_MMA(0, 1, At, B1); PG8_BAR; PG8_SCHED;
            PG8_LDA(At, 1, 1); PG8_STAGE(PG8_SB(1, 0), b3, voffB); PG8_STAGE(PG8_SB(1, 1), b3 + hstep, voffB); PG8_STAGE(PG8_SA(1, 0), a3, voffA);
            PG8_WAIT_V(8); PG8_WAIT_L(0); PG8_BAR; PG8_MMA(1, 0, At, B0); PG8_MMA(1, 1, At, B1); PG8_BAR; PG8_SCHED;
            } else {
            PG8_LDB(B0, 0, 0); PG8_SCHED; PG8_LDA(At, 0, 0); PG8_STAGE(PG8_SA(1, 1), a1 + hstep, voffA);
            PG8_WAIT_L(8); PG8_BAR; PG8_WAIT_L(0); PG8_MMA(0, 0, At, B0); PG8_BAR; PG8_SCHED;
            PG8_LDB(B1, 0, 1); PG8_STAGE(PG8_SB(0, 0), b2, voffB);
            PG8_BAR; PG8_WAIT_L(0); PG8_MMA(0, 1, At, B1); PG8_BAR;
            PG8_LDA(At, 0, 1); PG8_STAGE(PG8_SA(0, 0), a2, voffA);
            PG8_BAR; PG8_WAIT_L(0); PG8_MMA(1, 0, At, B0); PG8_BAR; PG8_SCHED;
            PG8_STAGE(PG8_SB(0, 1), b2 + hstep, voffB);
            PG8_WAIT_V(6); PG8_BAR; PG8_MMA(1, 1, At, B1); PG8_BAR;
            PG8_LDB(B0, 1, 0); PG8_SCHED; PG8_LDA(At, 1, 0); PG8_STAGE(PG8_SA(0, 1), a2 + hstep, voffA);
            PG8_WAIT_L(8); PG8_BAR; PG8_WAIT_L(0); PG8_MMA(0, 0, At, B0); PG8_BAR; PG8_SCHED;
            PG8_LDB(B1, 1, 1); PG8_STAGE(PG8_SB(1, 0), b3, voffB);
            PG8_BAR; PG8_WAIT_L(0); PG8_MMA(0, 1, At, B1); PG8_BAR;
            PG8_LDA(At, 1, 1); PG8_STAGE(PG8_SA(1, 0), a3, voffA);
            PG8_BAR; PG8_WAIT_L(0); PG8_MMA(1, 0, At, B0); PG8_BAR; PG8_SCHED;
            PG8_STAGE(PG8_SB(1, 1), b3 + hstep, voffB);
            PG8_WAIT_V(6); PG8_BAR; PG8_MMA(1, 1, At, B1); PG8_BAR;
            }
        }
        if constexpr (ALIGN_EPI) { if (wr == 0) PG8_BAR; }
        if constexpr (!Epi::AFTER_DRAIN) { E(acc, cur, wr, wc, fr, fq); S.done(cur); }
        if (!has_next) break;
#pragma unroll
        for (int a = 0; a < 2; ++a)
#pragma unroll
            for (int b = 0; b < 2; ++b)
#pragma unroll
                for (int m = 0; m < 4; ++m)
#pragma unroll
                    for (int n = 0; n < 2; ++n) acc[a][b][m][n] = (f32x4){0.f, 0.f, 0.f, 0.f};
        cur = nxt; cA = nA; cB = nB; ++ui;
        if constexpr (ALIGN_EPI) { if (wr == 1) PG8_BAR; }
    }
    PG8_WAIT_V(0);
    if constexpr (!ALIGN_EPI) { if (wr == 0) PG8_BAR; }
    PG8_BAR;
    if constexpr (Epi::AFTER_DRAIN) { E.fused(acc, cur, wr, wc, fr, fq, lds, wid, lane); S.done(cur); }
#undef PG8_SA
#undef PG8_SB
#undef PG8_STAGE
#undef PG8_LDA
#undef PG8_LDB
#undef PG8_MMA
#undef PG8_WAIT_V
#undef PG8_WAIT_L
#undef PG8_BAR
#undef PG8_SCHED
}
}

#define GAS __attribute__((address_space(1)))
#define LAS __attribute__((address_space(3)))
typedef unsigned v4u __attribute__((ext_vector_type(4)));
typedef GAS unsigned gu32;
#define RLX_AGENT __ATOMIC_RELAXED, __HIP_MEMORY_SCOPE_AGENT
#define LDS_WAIT() asm volatile("s_waitcnt lgkmcnt(0)" ::: "memory")
#define XB_TMO      128
#define XB_XCNT(j)  (256  + 64 * (j))
#define XB_XSUB(j)  (1280 + 64 * (j))
#define XB_XGEN(j)  (2304 + 64 * (j))
#define XB_TOP      3328
#define XB_TOPGEN   3392
#define XCD_BAR_WORDS 3456
#define XB_SPIN_CAP (1u << 18)

__device__ __forceinline__ unsigned xb_ld(unsigned* p)              { return __hip_atomic_load(p, __ATOMIC_RELAXED, __HIP_MEMORY_SCOPE_AGENT); }
__device__ __forceinline__ unsigned xb_add(unsigned* p, unsigned v) { return __hip_atomic_fetch_add(p, v, __ATOMIC_RELAXED, __HIP_MEMORY_SCOPE_AGENT); }
__device__ __forceinline__ unsigned xb_xcc_id() { return (unsigned)__builtin_amdgcn_s_getreg((3 << 11) | 20) & 0xFu; }
#define XB_SPIN(cond, bar) do { unsigned _sp = 0; while (cond) { __builtin_amdgcn_s_sleep(1); \
    if ((++_sp & 255u) == 0u) { if (xb_ld(&(bar)[XB_TMO])) break; if (_sp > XB_SPIN_CAP) { atomicAdd(&(bar)[XB_TMO], 1u); break; } } } } while (0)

struct XcdBarrier {
    unsigned* bar; unsigned x;
    volatile LAS unsigned* st;
};

__device__ __forceinline__ XcdBarrier xcd_barrier_post(unsigned* bar, volatile LAS unsigned* st) {
    XcdBarrier b; b.bar = bar; b.x = xb_xcc_id(); b.st = st;
    if (threadIdx.x == 0) (void)xb_add(&bar[XB_XCNT(b.x)], 1u);
    return b;
}
__device__ __forceinline__ void xcd_barrier_complete(unsigned* bar, unsigned x, unsigned& nloc, unsigned& nx) {
    const unsigned G = gridDim.x * gridDim.y * gridDim.z;
    unsigned sum, cnt, mine, sp = 0u;
    for (;;) {
        sum = 0u; cnt = 0u; mine = 0u;
#pragma unroll
        for (unsigned j = 0; j < 16; ++j) { const unsigned c = xb_ld(&bar[XB_XCNT(j)]); sum += c; cnt += (c > 0u) ? 1u : 0u; mine = (j == x) ? c : mine; }
        if (sum == G) break;
        __builtin_amdgcn_s_sleep(1);
        if ((++sp & 255u) == 0u) { if (xb_ld(&bar[XB_TMO])) break; if (sp > XB_SPIN_CAP) { atomicAdd(&bar[XB_TMO], 1u); break; } }
    }
    nloc = mine > 0u ? mine : 1u; nx = cnt > 0u ? cnt : 1u;
}

__device__ __forceinline__ void xcd_barrier(const XcdBarrier& b) {
    asm volatile("s_waitcnt vmcnt(0)" ::: "memory");
    __syncthreads();
    if (threadIdx.x == 0) {
        unsigned* bar = b.bar; asm volatile("" : "+s"(bar));
        __builtin_amdgcn_s_waitcnt(0);
        unsigned nloc = b.st[0], nx = b.st[1];
        if (nloc == 0u) { xcd_barrier_complete(bar, b.x, nloc, nx); b.st[0] = nloc; b.st[1] = nx; }
        const unsigned old = xb_add(&bar[XB_XSUB(b.x)], 1u);
        const unsigned gen = old / nloc;
        if (old + 1u == (gen + 1u) * nloc) {
            __builtin_amdgcn_fence(__ATOMIC_RELEASE, "agent");
            asm volatile("s_waitcnt vmcnt(0)" ::: "memory");
            const unsigned og = xb_add(&bar[XB_TOP], 1u);
            const unsigned tg = og / nx;
            if (og + 1u == (tg + 1u) * nx) xb_add(&bar[XB_TOPGEN], 1u);
            else XB_SPIN(xb_ld(&bar[XB_TOPGEN]) == tg, bar);
            __builtin_amdgcn_fence(__ATOMIC_ACQUIRE, "agent");
            xb_add(&bar[XB_XGEN(b.x)], 1u);
            asm volatile("s_waitcnt vmcnt(0)" ::: "memory");
        } else {
            XB_SPIN(xb_ld(&bar[XB_XGEN(b.x)]) == gen, bar);
            __builtin_amdgcn_fence(__ATOMIC_ACQUIRE, "agent");
            asm volatile("s_waitcnt vmcnt(0)" ::: "memory");
        }
    }
    __syncthreads();
}

template <int O> __device__ __forceinline__ float swz_xor(float v) { return __uint_as_float((unsigned)__builtin_amdgcn_ds_swizzle((int)__float_as_uint(v), (O << 10) | 0x1F)); }
template <int O> __device__ __forceinline__ int swz_xor_i(int v) { return __builtin_amdgcn_ds_swizzle(v, (O << 10) | 0x1F); }
__device__ __forceinline__ float wave_sum(float v) {
    v += swz_xor<1>(v); v += swz_xor<2>(v); v += swz_xor<4>(v); v += swz_xor<8>(v); v += swz_xor<16>(v);
    auto rr = __builtin_amdgcn_permlane32_swap(__float_as_uint(v), __float_as_uint(v), false, false);
    return __uint_as_float(rr[0]) + __uint_as_float(rr[1]);
}

__device__ __forceinline__ void ph_norm(const P& p, int bid, int nb, const float* g, int li, int sh_i, int sc_i, int Mrows, bf16_t* out, bool from_inputs) {
    const int lane = otid() & 63, wave = otid() >> 6; const float* X = (const float*)(p.ws + WS_X); const float* MOD = (const float*)(p.ws + WS_MOD);
    for (int row = bid * 8 + wave; row < Mrows; row += nb * 8) {
        const float4* xr = (const float4*)(from_inputs ? (row < ML ? p.x + (size_t)row * D : p.ctx + (size_t)(row - ML) * D) : X + (size_t)row * D); float4 v[4]; float ss = 0;
#pragma unroll
        for (int j = 0; j < 4; ++j) { v[j] = xr[64 * j + lane]; ss += v[j].x * v[j].x + v[j].y * v[j].y + v[j].z * v[j].z + v[j].w * v[j].w; }
        const float rs = rsqrtf(wave_sum(ss) * (1.f / D) + EPS);
        const float* mrow = MOD + ((size_t)li * 9 + row_mod_idx(row)) * 6144;
#pragma unroll
        for (int j = 0; j < 4; ++j) { const int c0 = (64 * j + lane) * 4; const float4 gg = *(const float4*)(g + c0), sh = *(const float4*)(mrow + sh_i * 1024 + c0), sc = *(const float4*)(mrow + sc_i * 1024 + c0);
            ushort4 o; o.x = f2bf(v[j].x * rs * gg.x * (1.f + sc.x) + sh.x); o.y = f2bf(v[j].y * rs * gg.y * (1.f + sc.y) + sh.y); o.z = f2bf(v[j].z * rs * gg.z * (1.f + sc.z) + sh.z); o.w = f2bf(v[j].w * rs * gg.w * (1.f + sc.w) + sh.w);
            *(ushort4*)(out + (size_t)row * D + c0) = o; }
    }
}
namespace att {
using bf16x8 = __attribute__((ext_vector_type(8))) short;
using s16x4  = __attribute__((ext_vector_type(4))) short;
using f32x16 = __attribute__((ext_vector_type(16))) float;
using u32x4  = __attribute__((ext_vector_type(4))) unsigned;
constexpr int QBLK = 32, KVBLK = 64;
constexpr int KSLOT = 8192;
constexpr int OFF_K = 0, OFF_V = 3 * KSLOT, OFF_WS = OFF_V + 6 * KSLOT, OFF_OST = OFF_WS + 8 * 256, LDS_TOTAL = OFF_OST + 8 * 8192;
#define AT_SBAR() __builtin_amdgcn_sched_barrier(0)
#define AT_PIN(x) asm volatile("" : "+v"(x))
#define AT_MFMA(a, b, c) __builtin_amdgcn_mfma_f32_32x32x16_bf16(a, b, c, 0, 0, 0)
#define AT_WAIT_BAR(N) asm volatile("s_waitcnt vmcnt(" #N ") lgkmcnt(0)\n\ts_barrier" ::: "memory")
__device__ __forceinline__ int crow(int r, int hi) { return (r & 3) + 8 * (r >> 2) + 4 * hi; }
__device__ __forceinline__ unsigned cvtpk(float lo, float hi) { unsigned r; asm("v_cvt_pk_bf16_f32 %0, %1, %2" : "=v"(r) : "v"(lo), "v"(hi)); return r; }
__device__ __forceinline__ void glds16(unsigned voff, const void* sbase, unsigned lds_base) {
    unsigned sv; asm volatile("s_mov_b32 %0, m0\n\ts_mov_b32 m0, %3\n\ts_nop 0\n\tglobal_load_lds_dwordx4 %1, %2\n\ts_mov_b32 m0, %0" : "=&s"(sv) : "v"(voff), "s"(sbase), "s"(lds_base) : "memory"); }
typedef __attribute__((address_space(3))) const char* lds_cptr;
typedef short v4i16_t __attribute__((ext_vector_type(4)));
__device__ __forceinline__ void kload2(bf16x8* kf, lds_cptr kp, int d0) { kf[2 * d0] = *(const __attribute__((address_space(3))) bf16x8*)(kp + d0 * 2048); kf[2 * d0 + 1] = *(const __attribute__((address_space(3))) bf16x8*)(kp + d0 * 2048 + 512); }
__device__ __forceinline__ s16x4 vtr(lds_cptr p) { return __builtin_bit_cast(s16x4, __builtin_amdgcn_ds_read_tr16_b64_v4i16((__attribute__((address_space(3))) v4i16_t*)p)); }
#define AT_MX3(a, b, c) __builtin_fmaxf(__builtin_fmaxf((a), (b)), (c))
__device__ __forceinline__ float rowmax(const f32x16& p0, const f32x16& p1) {
    float a = AT_MX3(p0[0], p0[1], p1[0]), b = AT_MX3(p0[2], p0[3], p1[1]); a = AT_MX3(a, p1[2], p1[3]);
#pragma unroll
    for (int r = 4; r < 16; r += 4) { a = AT_MX3(a, p0[r], p0[r + 1]); b = AT_MX3(b, p0[r + 2], p0[r + 3]); a = AT_MX3(a, p1[r], p1[r + 1]); b = AT_MX3(b, p1[r + 2], p1[r + 3]); }
    float m = __builtin_fmaxf(a, b); auto rr = __builtin_amdgcn_permlane32_swap(__float_as_uint(m), __float_as_uint(m), false, false);
    return __builtin_fmaxf(__uint_as_float(rr[0]), __uint_as_float(rr[1])); }

__device__ __forceinline__ void attn_unit(const bf16_t* __restrict__ PROJ, bf16_t* __restrict__ ATT, float* stash, int h, int qrow0, int NT, int ctx0, int lat0,
                                          float lam, float osc, const float* __restrict__ sg, char* lds) {
  const int tid = otid(), lane = tid & 63, r32 = lane & 31, hi = lane >> 5; const int wid = __builtin_amdgcn_readfirstlane(tid >> 6);
  const unsigned lds0 = (unsigned)__builtin_amdgcn_readfirstlane((int)(unsigned)(uintptr_t)lds); float* wsf = (float*)(lds + OFF_WS) + wid * 64;
  const unsigned kdst = lds0 + OFF_K + wid * 1024, vdst = lds0 + OFF_V + wid * 1024;
  const lds_cptr vp0 = (lds_cptr)lds + OFF_V + ((lane >> 4) & 1) * 32 + (lane & 3) * 8 + (4 * hi + ((lane & 15) >> 2)) * 64;
  const lds_cptr kp0 = (lds_cptr)lds + OFF_K + hi * 1024 + r32 * 16;
  const unsigned voffV = (unsigned)(((16 * (wid & 3) + (lane >> 2)) * DIN + C_V + h * 128 + (wid >> 2) * 32 + (lane & 3) * 8) * 2);
  f32x16 o[4];
  const int moff0 = wid * 64 * 64 + lane;
#define AT_TBASE(t) ((const char*)PROJ + (size_t)((t) < 4 ? ctx0 + (t) * 64 : lat0 + ((t) - 4) * 64) * (size_t)(DIN * 2))
#define AT_RFL(x) ((unsigned)__builtin_amdgcn_readfirstlane((int)(x)))
#define AT_DMA_K(t, slot) glds16(voffK, AT_TBASE(t), AT_RFL(kdst + (slot)))
#define AT_DMA_V(t, slot) do { const char* tb_ = AT_TBASE(t); glds16(voffV, tb_, AT_RFL(vdst + 2 * (slot))); glds16(voffV, tb_ + 128, AT_RFL(vdst + 2 * (slot) + 8192)); } while (0)
  for (int m = 0; m < 2; ++m) {
    const unsigned voffK = (unsigned)((lane * DIN + C_K + h * 128 + m * 64 + wid * 8) * 2);
    __syncthreads();
    AT_DMA_K(0, 0); AT_DMA_V(0, 0); AT_DMA_K(1, KSLOT);
    bf16x8 qr[4];
    { const bf16_t* Qw = PROJ + (size_t)(qrow0 + wid * QBLK + r32) * DIN + C_Q + h * 128 + m * 64 + hi * 8;
#pragma unroll
      for (int d0 = 0; d0 < 4; ++d0) qr[d0] = *reinterpret_cast<const bf16x8*>(Qw + d0 * 16); }
    float mhat = 0.f, l_reg = 0.f;
#pragma unroll
    for (int d = 0; d < 4; ++d) o[d] = f32x16{};
    f32x16 negm;
    bool resc = false;
    f32x16 pA0, pA1, pB0, pB1; bf16x8 kf[8]; s16x4 vlo[4], vhi[4]; u32x4 pw0, pw1, pw2, pw3;
    int sl_prev = 0, sl_cur = 0, sl_next = KSLOT;
#define AT_ROT() do { sl_prev = sl_cur; sl_cur = sl_next; sl_next = (sl_next == 2 * KSLOT) ? 0 : sl_next + KSLOT; } while (0)
#define AT_EX(v) __builtin_amdgcn_exp2f(v)
#define AT_RESC() do { if (resc) { _Pragma("unroll") for (int d_ = 0; d_ < 4; ++d_) _Pragma("unroll") for (int r = 0; r < 16; ++r) o[d_][r] *= wsf[crow(r, hi)]; } } while (0)
    AT_DMA_K(2, 2 * KSLOT);
    AT_WAIT_BAR(4);
    _Pragma("unroll") for (int d0 = 0; d0 < 4; ++d0) kload2(kf, kp0, d0);
    pA0 = AT_MFMA(kf[0], qr[0], f32x16{}); pA1 = AT_MFMA(kf[1], qr[0], f32x16{}); pA0 = AT_MFMA(kf[2], qr[1], pA0); pA1 = AT_MFMA(kf[3], qr[1], pA1);
    pA0 = AT_MFMA(kf[4], qr[2], pA0); pA1 = AT_MFMA(kf[5], qr[2], pA1); pA0 = AT_MFMA(kf[6], qr[3], pA0); pA1 = AT_MFMA(kf[7], qr[3], pA1);
    { const float rm = rowmax(pA0, pA1); mhat = rm;
#pragma unroll
      for (int r = 0; r < 16; ++r) negm[r] = -mhat;
      asm volatile("" : "+v"(negm));
#pragma unroll
      for (int r = 0; r < 16; ++r) { pA0[r] = AT_EX(pA0[r] - rm); pA1[r] = AT_EX(pA1[r] - rm); } }
    AT_WAIT_BAR(0);
    AT_DMA_K(3, 0); AT_DMA_V(1, KSLOT); AT_ROT();
    _Pragma("unroll") for (int d0 = 0; d0 < 4; ++d0) kload2(kf, kp0 + sl_cur, d0);
    AT_WAIT_BAR(3);
#define AT_PKW(P, i) cvtpk(P[i], P[i + 1])
#define AT_PAF(k) __builtin_bit_cast(bf16x8, pw##k)
#define AT_VFR(i) (bf16x8){vlo[i][0], vlo[i][1], vlo[i][2], vlo[i][3], vhi[i][0], vhi[i][1], vhi[i][2], vhi[i][3]}
#define AT_VRDS(s, db, ks) do { vlo[s] = vtr(vp_ + ((db) * 4096 + (ks) * 1024)); vhi[s] = vtr(vp_ + ((db) * 4096 + (ks) * 1024 + 512)); } while (0)
#define AT_KRD1(G, j) do { if (G) kf[j] = *(const __attribute__((address_space(3))) bf16x8*)(kp0 + sl_next + ((j) >> 1) * 2048 + ((j) & 1) * 512); } while (0)
#define AT_GAPA(MF, a0, a1, a2, a3, W0, W1, PW) do { MF; sacc += a0; sacc += a1; sacc += a2; sacc += a3; W0; W1; AT_PIN(PW); AT_PIN(sacc); AT_SBAR(); } while (0)
#define AT_GAPB(MF, X, i) do { MF; X[i] = AT_EX(X[i]); X[i + 1] = AT_EX(X[i + 1]); AT_PIN(X); AT_SBAR(); } while (0)
#define AT_STEP(C0, C1, P0, P1, t, GK, GV, GL) do { AT_SBAR(); \
    const lds_cptr vp_ = vp0 + 2 * sl_prev; \
    float sacc = P0[0] + P0[1]; \
    AT_GAPA(C0 = AT_MFMA(kf[0], qr[0], negm), P0[2], P0[3], P0[4], P0[5],     pw0[0] = AT_PKW(P0, 0),  pw0[1] = AT_PKW(P0, 2),  pw0); \
    AT_GAPA(C1 = AT_MFMA(kf[1], qr[0], negm), P0[6], P0[7], P0[8], P0[9],     pw0[2] = AT_PKW(P0, 4),  pw0[3] = AT_PKW(P0, 6),  pw0); \
    AT_GAPA(C0 = AT_MFMA(kf[2], qr[1], C0),   P0[10], P0[11], P0[12], P0[13], pw1[0] = AT_PKW(P0, 8),  pw1[1] = AT_PKW(P0, 10), pw1); \
    AT_GAPA(C1 = AT_MFMA(kf[3], qr[1], C1),   P0[14], P0[15], P1[0], P1[1],   pw1[2] = AT_PKW(P0, 12), pw1[3] = AT_PKW(P0, 14), pw1); \
    AT_VRDS(0, 0, 0); AT_SBAR(); AT_GAPA(C0 = AT_MFMA(kf[4], qr[2], C0),   P1[2], P1[3], P1[4], P1[5],     pw2[0] = AT_PKW(P1, 0),  pw2[1] = AT_PKW(P1, 2),  pw2); \
    AT_VRDS(1, 1, 0); AT_SBAR(); AT_GAPA(C1 = AT_MFMA(kf[5], qr[2], C1),   P1[6], P1[7], P1[8], P1[9],     pw2[2] = AT_PKW(P1, 4),  pw2[3] = AT_PKW(P1, 6),  pw2); \
    AT_VRDS(2, 0, 1); AT_SBAR(); AT_GAPA(C0 = AT_MFMA(kf[6], qr[3], C0),   P1[10], P1[11], P1[12], P1[13], pw3[0] = AT_PKW(P1, 8),  pw3[1] = AT_PKW(P1, 10), pw3); \
    AT_VRDS(3, 1, 1); AT_SBAR(); AT_GAPA(C1 = AT_MFMA(kf[7], qr[3], C1),   P1[14], P1[15], 0.f, 0.f,       pw3[2] = AT_PKW(P1, 12), pw3[3] = AT_PKW(P1, 14), pw3); \
    l_reg += sacc; \
    if (GK) AT_DMA_K((t) + 3, sl_cur); if (GV) AT_DMA_V((t) + 1, sl_next);                                \
    { const float rm = rowmax(C0, C1); resc = false;                                                    \
      if (__builtin_expect(__any(rm > 8.f), 0)) { const float dl = __builtin_fmaxf(rm, 0.f); mhat += dl;     \
          _Pragma("unroll") for (int r = 0; r < 16; ++r) { C0[r] -= dl; C1[r] -= dl; } \
          _Pragma("unroll") for (int r = 0; r < 16; ++r) negm[r] = -mhat; \
          asm volatile("" : "+v"(negm)); \
          const float f = __builtin_amdgcn_exp2f(-dl); l_reg *= f; if (hi == 0) wsf[r32] = f; resc = true; } } \
    AT_SBAR(); \
    AT_GAPB(o[0] = AT_MFMA(AT_PAF(0), AT_VFR(0), o[0]), C0, 0);  AT_VRDS(0, 0, 2); AT_SBAR(); \
    AT_GAPB(o[1] = AT_MFMA(AT_PAF(0), AT_VFR(1), o[1]), C0, 2);  AT_VRDS(1, 1, 2); AT_SBAR(); \
    AT_GAPB(o[0] = AT_MFMA(AT_PAF(1), AT_VFR(2), o[0]), C0, 4);  AT_VRDS(2, 0, 3); AT_SBAR(); \
    AT_GAPB(o[1] = AT_MFMA(AT_PAF(1), AT_VFR(3), o[1]), C0, 6);  AT_VRDS(3, 1, 3); AT_SBAR(); \
    AT_GAPB(o[0] = AT_MFMA(AT_PAF(2), AT_VFR(0), o[0]), C0, 8);  AT_VRDS(0, 2, 0); AT_KRD1(GL, 0); AT_SBAR(); \
    AT_GAPB(o[1] = AT_MFMA(AT_PAF(2), AT_VFR(1), o[1]), C0, 10); AT_VRDS(1, 3, 0); AT_KRD1(GL, 1); AT_SBAR(); \
    AT_GAPB(o[0] = AT_MFMA(AT_PAF(3), AT_VFR(2), o[0]), C0, 12); AT_VRDS(2, 2, 1); AT_KRD1(GL, 2); AT_SBAR(); \
    AT_GAPB(o[1] = AT_MFMA(AT_PAF(3), AT_VFR(3), o[1]), C0, 14); AT_VRDS(3, 3, 1); AT_KRD1(GL, 3); AT_SBAR(); \
    AT_GAPB(o[2] = AT_MFMA(AT_PAF(0), AT_VFR(0), o[2]), C1, 0);  AT_VRDS(0, 2, 2); AT_KRD1(GL, 4); AT_SBAR(); \
    AT_GAPB(o[3] = AT_MFMA(AT_PAF(0), AT_VFR(1), o[3]), C1, 2);  AT_VRDS(1, 3, 2); AT_KRD1(GL, 5); AT_SBAR(); \
    AT_GAPB(o[2] = AT_MFMA(AT_PAF(1), AT_VFR(2), o[2]), C1, 4);  AT_VRDS(2, 2, 3); AT_KRD1(GL, 6); AT_SBAR(); \
    AT_GAPB(o[3] = AT_MFMA(AT_PAF(1), AT_VFR(3), o[3]), C1, 6);  AT_VRDS(3, 3, 3); AT_KRD1(GL, 7); AT_SBAR(); \
    AT_GAPB(o[2] = AT_MFMA(AT_PAF(2), AT_VFR(0), o[2]), C1, 8);  \
    AT_GAPB(o[3] = AT_MFMA(AT_PAF(2), AT_VFR(1), o[3]), C1, 10); \
    AT_GAPB(o[2] = AT_MFMA(AT_PAF(3), AT_VFR(2), o[2]), C1, 12); \
    AT_GAPB(o[3] = AT_MFMA(AT_PAF(3), AT_VFR(3), o[3]), C1, 14); \
    } while (0)
    int t = 1;
    for (; t + 5 < NT; t += 2) {
        AT_STEP(pB0, pB1, pA0, pA1, t, true, true, true);     AT_WAIT_BAR(3); AT_RESC(); AT_ROT();
        AT_STEP(pA0, pA1, pB0, pB1, t + 1, true, true, true); AT_WAIT_BAR(3); AT_RESC(); AT_ROT();
    }
#define AT_ENDW(tt) do { if ((tt) + 3 < NT) { AT_WAIT_BAR(3); } else if ((tt) + 2 < NT) { AT_WAIT_BAR(2); } else { AT_WAIT_BAR(0); } } while (0)
    for (; t + 1 < NT; t += 2) {
        AT_STEP(pB0, pB1, pA0, pA1, t, (t + 3 < NT), (t + 1 < NT), (t + 1 < NT));         AT_ENDW(t);     AT_RESC(); AT_ROT();
        AT_STEP(pA0, pA1, pB0, pB1, t + 1, (t + 4 < NT), (t + 2 < NT), (t + 2 < NT));     AT_ENDW(t + 1); AT_RESC(); AT_ROT();
    }
    AT_STEP(pB0, pB1, pA0, pA1, NT - 1, false, false, false); AT_RESC();
    { float sacc = pB0[0] + pB0[1];
#pragma unroll
      for (int r = 2; r < 16; ++r) sacc += pB0[r];
#pragma unroll
      for (int r = 0; r < 16; ++r) sacc += pB1[r];
      l_reg += sacc;
      pw0 = (u32x4){AT_PKW(pB0, 0), AT_PKW(pB0, 2), AT_PKW(pB0, 4), AT_PKW(pB0, 6)}; pw1 = (u32x4){AT_PKW(pB0, 8), AT_PKW(pB0, 10), AT_PKW(pB0, 12), AT_PKW(pB0, 14)};
      pw2 = (u32x4){AT_PKW(pB1, 0), AT_PKW(pB1, 2), AT_PKW(pB1, 4), AT_PKW(pB1, 6)}; pw3 = (u32x4){AT_PKW(pB1, 8), AT_PKW(pB1, 10), AT_PKW(pB1, 12), AT_PKW(pB1, 14)};
      const lds_cptr vp_ = vp0 + 2 * sl_cur;
#define AT_DR4(OA, OB, DA, DB, K0, K1) do { AT_VRDS(0, DA, K0); AT_VRDS(1, DB, K0); AT_VRDS(2, DA, K1); AT_VRDS(3, DB, K1); \
      OA = AT_MFMA(AT_PAF(K0), AT_VFR(0), OA); OB = AT_MFMA(AT_PAF(K0), AT_VFR(1), OB); OA = AT_MFMA(AT_PAF(K1), AT_VFR(2), OA); OB = AT_MFMA(AT_PAF(K1), AT_VFR(3), OB); AT_SBAR(); } while (0)
      AT_DR4(o[0], o[1], 0, 1, 0, 1); AT_DR4(o[0], o[1], 0, 1, 2, 3); AT_DR4(o[2], o[3], 2, 3, 0, 1); AT_DR4(o[2], o[3], 2, 3, 2, 3);
#undef AT_DR4
    }
    { auto rr = __builtin_amdgcn_permlane32_swap(__float_as_uint(l_reg), __float_as_uint(l_reg), false, false); l_reg = __uint_as_float(rr[0]) + __uint_as_float(rr[1]); }
    if (hi == 0) wsf[32 + r32] = l_reg;
    asm volatile("s_waitcnt lgkmcnt(0)" ::: "memory");
    float rli[16];
#pragma unroll
    for (int r = 0; r < 16; ++r) rli[r] = __builtin_amdgcn_rcpf(wsf[32 + crow(r, hi)]);
    if (m == 0) {
#pragma unroll
      for (int d0 = 0; d0 < 4; ++d0) { int mo_ = moff0 + d0 * 1024; asm volatile("" : "+v"(mo_)); float* ms = stash + mo_;
#pragma unroll
        for (int r = 0; r < 16; ++r) ms[r * 64] = o[d0][r] * rli[r]; }
    } else {
#pragma unroll
      for (int d0 = 0; d0 < 4; ++d0) { int mo_ = moff0 + d0 * 1024; asm volatile("" : "+v"(mo_)); const float* ms = stash + mo_;
#pragma unroll
        for (int r = 0; r < 16; ++r) o[d0][r] = ms[r * 64] - lam * (o[d0][r] * rli[r]); }
    }
#undef AT_ROT
#undef AT_EX
#undef AT_RESC
#undef AT_PKW
#undef AT_PAF
#undef AT_VFR
#undef AT_VRDS
#undef AT_KRD1
#undef AT_GAPA
#undef AT_GAPB
#undef AT_STEP
#undef AT_ENDW
  }
#undef AT_TBASE
#undef AT_RFL
#undef AT_DMA_K
#undef AT_DMA_V
  float rs[16];
#pragma unroll
  for (int r = 0; r < 16; ++r) { float s = o[0][r] * o[0][r] + o[1][r] * o[1][r] + o[2][r] * o[2][r] + o[3][r] * o[3][r];
    s += swz_xor<1>(s); s += swz_xor<2>(s); s += swz_xor<4>(s); s += swz_xor<8>(s); s += swz_xor<16>(s);
    rs[r] = rsqrtf(s * (1.f / 128.f) + EPS) * osc; }
  float sgv[4];
#pragma unroll
  for (int d0 = 0; d0 < 4; ++d0) sgv[d0] = sg[d0 * 32 + r32];
  bf16_t* stg = (bf16_t*)(lds + OFF_OST) + wid * 4096;
#pragma unroll
  for (int r = 0; r < 16; ++r) { const int orow = crow(r, hi);
#pragma unroll
    for (int d0 = 0; d0 < 4; ++d0) stg[orow * 128 + d0 * 32 + r32] = f2bf(o[d0][r] * rs[r] * sgv[d0]); }
  asm volatile("s_waitcnt lgkmcnt(0)" ::: "memory");
  bf16_t* Ow = ATT + (size_t)(qrow0 + wid * QBLK) * D + h * 128;
#pragma unroll
  for (int i = 0; i < 8; ++i) { const int row = i * 4 + (lane >> 4), ch = lane & 15; const u32x4 v = *(const u32x4*)(stg + row * 128 + ch * 8); *(u32x4*)(Ow + (size_t)row * D + ch * 8) = v; }
}
#undef AT_SBAR
#undef AT_PIN
#undef AT_MFMA
#undef AT_WAIT_BAR
#undef AT_MX3
}

__device__ __forceinline__ void ph_attn(const P& p, int li, bool do_ctx, int bid, int nb, unsigned char* lds) {
    const bf16_t* PROJ = (const bf16_t*)(p.ws + WS_PROJ); bf16_t* ATT = (bf16_t*)(p.ws + WS_ATT);
    const float lam = ((const float*)(p.ws + WS_LAM))[li]; const float osc = 1.f - lambda_init_of(li);
    const int vcu = (nb % 8 == 0) ? (bid % 8) * (nb / 8) + bid / 8 : bid;
    float* stash = (float*)(p.ws + WS_STASH) + (size_t)bid * (8 * 64 * 64);
    const int nlat = 512, nctx = do_ctx ? 64 : 0;
    const int klat = vcu < nlat ? (nlat - vcu + nb - 1) / nb : 0;
    for (int k = 0;; ++k) { int h, qrow0, NT; int b;
        if (k < klat) { const int u = vcu + k * nb; b = u >> 6; h = (u >> 3) & 7; qrow0 = b * 2048 + (u & 7) * 256; NT = 36; }
        else { const int v = bid + (k - klat) * nb; if (v >= nctx) break; b = v >> 3; h = v & 7; qrow0 = ML + b * 256; NT = 4; }
        att::attn_unit(PROJ, ATT, stash, h, qrow0, NT, ML + b * 256, b * 2048, lam, osc, p.subln_g + li * 128, (char*)lds); }
}
namespace lru {
using bf16x8 = __attribute__((ext_vector_type(8))) short;
using f32x16 = __attribute__((ext_vector_type(16))) float;
using u32x4  = __attribute__((ext_vector_type(4))) unsigned;
constexpr int T = 256;
constexpr int L_URAW = 0, L_UCF = 33280, L_UCB = L_UCF + 32768, L_GLT = L_UCB + 256 * 144, L_LAT = L_GLT + 16384, L_SUMS = L_LAT + 16384, L_BW = L_SUMS + 8192, L_END = L_BW + 8192;
__device__ __forceinline__ float fast_sigmoid(float x) { return __builtin_amdgcn_rcpf(1.f + __expf(-x)); }
__device__ __forceinline__ float one_minus_exp(float x, float a) {
    float pl = 1.f / 5040.f; pl = fmaf(pl, x, 1.f / 720.f); pl = fmaf(pl, x, 1.f / 120.f); pl = fmaf(pl, x, 1.f / 24.f); pl = fmaf(pl, x, 1.f / 6.f); pl = fmaf(pl, x, 0.5f); pl = fmaf(pl, x, 1.f);
    return x > -0.5f ? -x * pl : 1.f - a * a; }
__device__ __forceinline__ float fast_gelu(float x) { const float u = 0.7978845608028654f * (x + 0.044715f * x * x * x); return x * fast_sigmoid(2.f * u); }
}

__device__ __forceinline__ void ph_lru(const P& p, int li, int bid, int nb, unsigned char* lds) {
    using namespace lru;
    const bf16_t* PROJ = (const bf16_t*)(p.ws + WS_PROJ); float* HF = (float*)(p.ws + WS_HF); bf16_t* LA = (bf16_t*)(p.ws + WS_LA);
    const int tid = otid(), wave = tid >> 6, lane = tid & 63, r32 = lane & 31, hi = lane >> 5, tt = wave;
    const int c = r32;
    const int sub = tt * 2 + hi;
    float* UCF = (float*)(lds + L_UCF); float* SUMS = (float*)(lds + L_SUMS);
    for (int item = bid; item < 256; item += nb) {
        const int b = item >> 5, n = (item >> 1) & 15, hfi = item & 1; const int ch0 = n * 64, cb32 = ch0 + hfi * 32;
        int tid_i = tid; asm volatile("" : "+v"(tid_i));
        const int c2 = tid_i & 31, tq = tid_i >> 5;
        float cw0[4], cw1[4];
#pragma unroll
        for (int k = 0; k < 4; ++k) { cw0[k] = p.conv_w[(size_t)(li * 4 + k) * 1024 + ch0 + 2 * c2]; cw1[k] = p.conv_w[(size_t)(li * 4 + k) * 1024 + ch0 + 2 * c2 + 1]; }
        const float cb0 = p.conv_b[li * 1024 + ch0 + 2 * c2], cb1 = p.conv_b[li * 1024 + ch0 + 2 * c2 + 1];
        for (int d = 0; d < 2; ++d) {
            int c_w = c; asm volatile("" : "+v"(c_w));
            { const int g = wave >> 2, ks = wave & 3;
              const float* wp = p.lru_w + ((((size_t)(li * 2 + d) * 2 + g) * 16 + n) * 64) * 64 + hfi * 32 + c_w + (size_t)(ks * 16 + 8 * hi) * 64;
              float wf[8];
#pragma unroll
              for (int j = 0; j < 8; ++j) wf[j] = wp[(size_t)j * 64];
              asm volatile("s_waitcnt vmcnt(0)" ::: "memory");
              *(u32x4*)(lds + L_BW + ((g * 4 + ks) * 64 + lane) * 16) = (u32x4){pk2(wf[0], wf[1]), pk2(wf[2], wf[3]), pk2(wf[4], wf[5]), pk2(wf[6], wf[7])}; }
            const float bias0 = p.lru_b[((size_t)(li * 2 + d) * 2 + 0) * 1024 + cb32 + c_w], bias1 = p.lru_b[((size_t)(li * 2 + d) * 2 + 1) * 1024 + cb32 + c_w];
            float sp8; { const float lam = p.lru_lam[(size_t)(li * 2 + d) * 1024 + cb32 + c_w]; const float z = -lam; const float ez = __expf(z);
              const float spl = ez < 0.1f ? ez * (1.f - ez * (0.5f - ez * (0.33333333f - ez * (0.25f - ez * 0.2f)))) : (z > 20.f ? z : __logf(1.f + ez)); sp8 = -8.f * spl; }
            float state = 0.f;
            u32x4 st_u[5]; u32x4 st_g[2];
#define LRU_CHUNK_ROW0(step_, row0_, L_, t0_) { int cc_; if ((step_) < 1) { cc_ = 0; L_ = 256; row0_ = ML + b * 256; } else { cc_ = d == 0 ? (step_) - 1 : 8 - (step_); L_ = 2048; row0_ = b * 2048; } t0_ = cc_ * T; }
#define LRU_STAGE_LOAD(step_) { int row0_, L_, t0_; LRU_CHUNK_ROW0(step_, row0_, L_, t0_); int tid_ = tid; asm volatile("" : "+v"(tid_));   \
            _Pragma("unroll") for (int q_ = 0; q_ < 5; ++q_) { const int piece_ = tid_ + 512 * q_; const int i_ = piece_ >> 3, chk_ = piece_ & 7; const int tr_ = t0_ - 2 + i_; st_u[q_] = (u32x4){0u, 0u, 0u, 0u}; \
                if (piece_ < 259 * 8 && tr_ >= 0 && tr_ < L_) st_u[q_] = *(const u32x4*)(PROJ + (size_t)(row0_ + tr_) * DIN + C_U + ch0 + chk_ * 8); } \
            if (d == 1) { _Pragma("unroll") for (int q_ = 0; q_ < 2; ++q_) { const int piece_ = tid_ + 512 * q_; const int i_ = piece_ >> 2, chk_ = piece_ & 3; st_g[q_] = *(const u32x4*)(PROJ + (size_t)(row0_ + t0_ + i_) * DIN + C_GL + cb32 + chk_ * 8); } } }
            LRU_STAGE_LOAD(0);
            for (int step = 0; step < 9; ++step) {
                int row0, Lseq, t0; LRU_CHUNK_ROW0(step, row0, Lseq, t0);
                const int crow0 = row0 + t0;
                const int spos0 = (Lseq == 256 ? 0 : 256) + t0;
#pragma unroll
                for (int q = 0; q < 5; ++q) { const int piece = tid + 512 * q; if (piece < 259 * 8) *(u32x4*)(lds + L_URAW + piece * 16) = st_u[q]; }
                if (d == 1) {
#pragma unroll
                    for (int q = 0; q < 2; ++q) { const int piece = tid + 512 * q; *(u32x4*)(lds + L_GLT + piece * 16) = st_g[q]; } }
                __syncthreads();
                if (step + 1 < 9) LRU_STAGE_LOAD(step + 1);
                float hf[16];
                if (d == 1) { int sub_o = sub; asm volatile("" : "+v"(sub_o)); int ho_ = (item * 2304 + spos0 + 255 - sub_o * 16) * 32 + c; asm volatile("" : "+v"(ho_)); const float* hp = HF + ho_;
#pragma unroll
                    for (int r = 0; r < 16; ++r) hf[r] = hp[-r * 32]; }
#pragma unroll
                for (int hh = 0; hh < 2; ++hh) {
                    float x0[11], x1[11]; const int tb8 = tq * 16 + hh * 8;
#pragma unroll
                    for (int i = 0; i < 11; ++i) { const unsigned w = *(const unsigned*)(lds + L_URAW + (tb8 + i) * 128 + c2 * 4); x0[i] = __uint_as_float(w << 16); x1[i] = __uint_as_float(w & 0xffff0000u); }
                    const bool mine = (c2 >> 4) == hfi;
#pragma unroll
                    for (int e = 0; e < 8; ++e) { const int tk = tb8 + e, t = d ? 255 - tk : tk;
                        const float y0 = cb0 + cw0[0] * x0[e] + cw0[1] * x0[e + 1] + cw0[2] * x0[e + 2] + cw0[3] * x0[e + 3];
                        const float y1 = cb1 + cw1[0] * x1[e] + cw1[1] * x1[e + 1] + cw1[2] * x1[e + 2] + cw1[3] * x1[e + 3];
                        if (mine) *(float2*)(UCF + t * 32 + 2 * (c2 & 15)) = make_float2(y0, y1);
                        *(unsigned*)(lds + L_UCB + t * 144 + c2 * 4) = pk2(y0, y1); }
                    __builtin_amdgcn_sched_barrier(0);
                }
                __syncthreads();
                f32x16 acc0 = f32x16{}, acc1 = f32x16{};
                {
                    const int i = r32, hc = (i >> 2) & 1, rr = (i & 3) + 4 * (i >> 3), rho = (tt * 2 + hc) * 16 + rr;
                    const unsigned char* ap = lds + L_UCB + rho * 144 + hi * 16;
#pragma unroll
                    for (int ks = 0; ks < 4; ++ks) { const bf16x8 a = *(const bf16x8*)(ap + ks * 32);
                        const bf16x8 b0 = *(const bf16x8*)(lds + L_BW + (ks * 64 + lane) * 16), b1 = *(const bf16x8*)(lds + L_BW + ((4 + ks) * 64 + lane) * 16);
                        acc0 = __builtin_amdgcn_mfma_f32_32x32x16_bf16(a, b0, acc0, 0, 0, 0); acc1 = __builtin_amdgcn_mfma_f32_32x32x16_bf16(a, b1, acc1, 0, 0, 0); }
                }
                float hl[16], ap_[16]; float P = 1.f, h = 0.f;
                const float* ucp = UCF + (sub * 16) * 32 + c;
#pragma unroll
                for (int r = 0; r < 16; ++r) {
                    const float u = ucp[r * 32]; const float rec = fast_sigmoid(acc0[r] + bias0), inp = fast_sigmoid(acc1[r] + bias1);
                    const float la = sp8 * rec; const float a = __expf(la); const float m2 = one_minus_exp(2.f * la, a); const float drive = __builtin_amdgcn_sqrtf(m2) * (inp * u);
                    h = a * h + drive; P *= a; hl[r] = h; ap_[r] = P;
                    if ((r & 3) == 3) __builtin_amdgcn_sched_barrier(0); }
                float* sums = SUMS + (step & 1) * 1024;
                *(float2*)(sums + (sub * 32 + c) * 2) = make_float2(P, h);
                __syncthreads();
                float carry = state, mine = state;
#pragma unroll
                for (int s = 0; s < 16; ++s) { if (s == sub) mine = carry; const float2 ph = *(const float2*)(sums + (s * 32 + c) * 2); carry = ph.x * carry + ph.y; }
                state = carry;
                if (d == 0) {
                    int sub_o = sub; asm volatile("" : "+v"(sub_o)); int ho_ = (item * 2304 + spos0 + sub_o * 16) * 32 + c; asm volatile("" : "+v"(ho_)); float* hp = HF + ho_;
#pragma unroll
                    for (int r = 0; r < 16; ++r) hp[r * 32] = hl[r] + ap_[r] * mine;
                } else {
                    bf16_t* lat = (bf16_t*)(lds + L_LAT); const bf16_t* glt = (const bf16_t*)(lds + L_GLT);
                    const int tb = 255 - sub * 16;
#pragma unroll
                    for (int r = 0; r < 16; ++r) { const float hb = hl[r] + ap_[r] * mine; const float gl = bf2f(glt[(tb - r) * 32 + c]);
                        lat[(tb - r) * 32 + c] = f2bf((hf[r] + hb) * fast_gelu(gl)); }
                    __syncthreads();
                    int tid3 = tid; asm volatile("" : "+v"(tid3));
#pragma unroll
                    for (int q = 0; q < 2; ++q) { const int piece = tid3 + 512 * q; const int i = piece >> 2, chk = piece & 3;
                        *(u32x4*)(LA + (size_t)(crow0 + i) * D + cb32 + chk * 8) = *(const u32x4*)(lds + L_LAT + piece * 16); }
                }
            }
#undef LRU_STAGE_LOAD
#undef LRU_CHUNK_ROW0
            asm volatile("s_waitcnt vmcnt(0)" ::: "memory");
            __syncthreads();
            if (tid == 0) { __builtin_amdgcn_fence(__ATOMIC_ACQUIRE, "agent"); asm volatile("s_waitcnt vmcnt(0)" ::: "memory"); }
            __syncthreads();
        }
    }
}
namespace peer {
using bf16x8 = __attribute__((ext_vector_type(8))) short;
using f32x16 = __attribute__((ext_vector_type(16))) float;
using u32x4  = __attribute__((ext_vector_type(4))) unsigned;
typedef __bf16 bf16x2_t __attribute__((ext_vector_type(2)));
__device__ __forceinline__ unsigned sortable(float f) { const unsigned u = __float_as_uint(f); return (u & 0x80000000u) ? ~u : (u | 0x80000000u); }
__device__ __forceinline__ float unsortable(unsigned u) { return __uint_as_float((u & 0x80000000u) ? (u & 0x7fffffffu) : ~u); }
__device__ __forceinline__ unsigned umax_(unsigned a, unsigned b) { return a > b ? a : b; }
__device__ __forceinline__ unsigned umin_(unsigned a, unsigned b) { return a < b ? a : b; }
__device__ __forceinline__ void sort16_desc(unsigned (&v)[16]) {
#pragma unroll
    for (int kk = 1; kk <= 4; ++kk)
#pragma unroll
        for (int jj = 3; jj >= 0; --jj)
#pragma unroll
            for (int i = 0; i < 16; ++i) { const int k = 1 << kk, j = 1 << jj, l = i ^ j; if (jj >= kk) continue;
                if (l > i) { const unsigned mx = umax_(v[i], v[l]), mn = umin_(v[i], v[l]); if ((i & k) == 0) { v[i] = mx; v[l] = mn; } else { v[i] = mn; v[l] = mx; } } }
}
__device__ __forceinline__ void merge_top16(unsigned (&a)[16], const unsigned (&b)[16]) {
#pragma unroll
    for (int i = 0; i < 16; ++i) a[i] = umax_(a[i], b[15 - i]);
#pragma unroll
    for (int jj = 3; jj >= 0; --jj)
#pragma unroll
        for (int i = 0; i < 16; ++i) { const int j = 1 << jj, l = i ^ j; if (l > i) { const unsigned mx = umax_(a[i], a[l]), mn = umin_(a[i], a[l]); a[i] = mx; a[l] = mn; } }
}
__device__ __forceinline__ int crow(int r, int hi) { return (r & 3) + 8 * (r >> 2) + 4 * hi; }
__device__ __forceinline__ float dot2(unsigned a, unsigned b, float acc) { return __builtin_amdgcn_fdot2_f32_bf16(__builtin_bit_cast(bf16x2_t, a), __builtin_bit_cast(bf16x2_t, b), acc, false); }
__device__ __forceinline__ unsigned msel(unsigned a, unsigned b, unsigned m) { return a ^ ((a ^ b) & m); }
__device__ __forceinline__ unsigned pick16(const unsigned (&a)[16], int i) {
    const unsigned m0 = 0u - (unsigned)(i & 1), m1 = 0u - (unsigned)((i >> 1) & 1), m2 = 0u - (unsigned)((i >> 2) & 1), m3 = 0u - (unsigned)((i >> 3) & 1);
    unsigned t8[8], t4[4], t2[2];
#pragma unroll
    for (int k = 0; k < 8; ++k) t8[k] = msel(a[2 * k], a[2 * k + 1], m0);
#pragma unroll
    for (int k = 0; k < 4; ++k) t4[k] = msel(t8[2 * k], t8[2 * k + 1], m1);
#pragma unroll
    for (int k = 0; k < 2; ++k) t2[k] = msel(t4[2 * k], t4[2 * k + 1], m2);
    return msel(t2[0], t2[1], m3); }
__device__ __forceinline__ void score_list(const bf16_t* __restrict__ PQ, const bf16_t* __restrict__ KEYS, int tok, int hp, int r32, int hi, unsigned (&T)[16]) {
    const bf16_t* qp = PQ + (size_t)tok * D + hp * 64 + hi * 8; bf16x8 qf[4];
#pragma unroll
    for (int ks = 0; ks < 4; ++ks) qf[ks] = *reinterpret_cast<const bf16x8*>(qp + ks * 16);
    const bf16_t* kp = KEYS + ((size_t)hp * 128 + r32) * 64 + hi * 8;
#pragma unroll
    for (int kt = 0; kt < 4; ++kt) { f32x16 acc = f32x16{};
#pragma unroll
        for (int ks = 0; ks < 4; ++ks) { const bf16x8 a = *reinterpret_cast<const bf16x8*>(kp + (size_t)kt * 32 * 64 + ks * 16); acc = __builtin_amdgcn_mfma_f32_32x32x16_bf16(a, qf[ks], acc, 0, 0, 0); }
        unsigned v[16];
#pragma unroll
        for (int r = 0; r < 16; ++r) v[r] = (sortable(acc[r]) & ~127u) | (unsigned)(127 - (kt * 32 + crow(r, hi)));
        sort16_desc(v);
        if (kt == 0) {
#pragma unroll
            for (int r = 0; r < 16; ++r) T[r] = v[r];
        } else merge_top16(T, v);
    }
}
}

__device__ __forceinline__ void ph_peer_score(const P& p, int li, int Mrows, int bid, int nb) {
    using namespace peer;
    const bf16_t* PQ = (const bf16_t*)(p.ws + WS_PQ); const bf16_t* KEYS = (const bf16_t*)(p.ws + WS_KEYS) + (size_t)li * 16 * 128 * 64;
    int* IDX = (int*)(p.ws + WS_IDX); float* G = (float*)(p.ws + WS_G);
    const int tid = otid(), wave = tid >> 6, lane = tid & 63, r32 = lane & 31, hi = lane >> 5;
    const int gw = bid * NWAVES + wave, NGW = nb * NWAVES, ntask = (Mrows / 32) * 4;
    for (int task = gw; task < ntask; task += NGW) {
        const int tok = (task >> 2) * 32 + r32, hp2 = task & 3;
        for (int hh = 0; hh < 2; ++hh) { const int h = hp2 * 2 + hh;
            unsigned A0[16], B0[16];
            score_list(PQ, KEYS, tok, h * 2 + 0, r32, hi, A0); score_list(PQ, KEYS, tok, h * 2 + 1, r32, hi, B0);
            unsigned M[16], Y[16];
#pragma unroll
            for (int i = 0; i < 16; ++i) { auto rr = __builtin_amdgcn_permlane32_swap(A0[i], B0[i], false, false); M[i] = rr[0]; Y[i] = rr[1]; }
            merge_top16(M, Y);
            unsigned P0[16], P1[16];
#pragma unroll
            for (int i = 0; i < 16; ++i) { auto rr = __builtin_amdgcn_permlane32_swap(M[i], M[i], false, false); P0[i] = rr[0]; P1[i] = rr[1]; }
            float X[16], Yv[16];
#pragma unroll
            for (int i = 0; i < 16; ++i) { const float f0 = unsortable(P0[i]), f1 = unsortable(P1[i]); X[i] = hi ? f1 : f0; Yv[i] = hi ? f0 : f1; }
            unsigned C0[16], C1[16];
#pragma unroll
            for (int c = 0; c < 16; ++c) { const float s = X[0] + Yv[c]; const unsigned flat = hi ? (unsigned)(c * 16) : (unsigned)c; unsigned key = (sortable(s) & ~255u) | (255u - flat); if (c == 0 && hi) key = 0u; C0[c] = key; }
#define PEER_CAND(c, i, j) { const float s_ = X[i] + Yv[j]; const unsigned flat_ = hi ? (unsigned)((j) * 16 + (i)) : (unsigned)((i) * 16 + (j)); unsigned key_ = (sortable(s_) & ~255u) | (255u - flat_); if ((i) == (j) && hi) key_ = 0u; C1[c] = key_; }
            PEER_CAND(0, 1, 1) PEER_CAND(1, 1, 2) PEER_CAND(2, 1, 3) PEER_CAND(3, 1, 4) PEER_CAND(4, 1, 5) PEER_CAND(5, 1, 6) PEER_CAND(6, 1, 7) PEER_CAND(7, 2, 2) PEER_CAND(8, 2, 3) PEER_CAND(9, 2, 4) PEER_CAND(10, 3, 3)
#undef PEER_CAND
            C1[11] = 0u; C1[12] = 0u; C1[13] = 0u; C1[14] = 0u; C1[15] = 0u;
            sort16_desc(C0); sort16_desc(C1); merge_top16(C0, C1);
            unsigned F[16]; unsigned mxk;
            { unsigned Clo[16], Chi[16];
#pragma unroll
              for (int i = 0; i < 16; ++i) { auto rr = __builtin_amdgcn_permlane32_swap(C0[i], C0[i], false, false); Clo[i] = rr[0]; Chi[i] = rr[1]; }
#pragma unroll
              for (int i = 0; i < 16; ++i) F[i] = umax_(Clo[i], Chi[15 - i]);
              mxk = umax_(Clo[0], Chi[0]); }
            const float fmx = unsortable(mxk); float w[16]; float wsum = 0.f;
#pragma unroll
            for (int i = 0; i < 16; ++i) { w[i] = __expf(unsortable(F[i]) - fmx); wsum += w[i]; }
            const float inv = 1.f / wsum;
            int oi[8]; float og[8]; const unsigned him = 0u - (unsigned)hi;
#pragma unroll
            for (int k = 0; k < 8; ++k) { const unsigned e = msel(F[k], F[8 + k], him); const float wk = __uint_as_float(msel(__float_as_uint(w[k]), __float_as_uint(w[8 + k]), him));
                const int cf = 255 - (int)(e & 255u), i1 = cf >> 4, i2 = cf & 15;
                const int n1 = 127 - (int)(pick16(P0, i1) & 127u), n2 = 127 - (int)(pick16(P1, i2) & 127u);
                oi[k] = n1 * 128 + n2; og[k] = wk * inv; }
            int* ip = IDX + (size_t)tok * 128 + h * 16 + hi * 8; float* gp = G + (size_t)tok * 128 + h * 16 + hi * 8;
            *(int4*)ip = make_int4(oi[0], oi[1], oi[2], oi[3]); *(int4*)(ip + 4) = make_int4(oi[4], oi[5], oi[6], oi[7]);
            *(float4*)gp = make_float4(og[0], og[1], og[2], og[3]); *(float4*)(gp + 4) = make_float4(og[4], og[5], og[6], og[7]);
        }
    }
}

#ifndef FP6_INTERLEAVED
#define FP6_INTERLEAVED 1
#endif
namespace peer {
typedef float v16f __attribute__((ext_vector_type(16)));
typedef float v32f __attribute__((ext_vector_type(32)));
typedef unsigned v6u __attribute__((ext_vector_type(6)));
typedef unsigned v16u __attribute__((ext_vector_type(16)));
typedef unsigned u32x2 __attribute__((ext_vector_type(2)));
__host__ __device__ constexpr int fp6_src_of(int k) { return FP6_INTERLEAVED ? ((k & 1) * 16 + (k >> 1)) : k; }
}
__device__ __forceinline__ void ph_peer_tables(const P& p, int li, int bid, int nb) {
    using namespace peer;
    const int tid = otid(), lane = tid & 63, wave = tid >> 6, g = lane & 31, hb = lane >> 5;
    const int first = nb >= 128 ? 64 : 0;
    if (bid < first) return;
    const int gw = (bid - first) * NWAVES + wave, NGW = (nb - first) * NWAVES;
    for (int rp = gw; rp < 16384; rp += NGW) {
        const int rr = 2 * rp + hb, tab = rr >> 14, row = rr & 16383;
        const float4* src = (const float4*)((tab ? p.peer_v : p.peer_u) + ((size_t)li * 16384 + row) * 1024 + g * 32);
        unsigned char* dst = (unsigned char*)(p.ws + (tab ? WS_PV : WS_PU)) + (size_t)row * 512 + g * 16; float* sc = (float*)(p.ws + (tab ? WS_SV : WS_SU));
        float4 v[8]; float mx = 0.f;
#pragma unroll
        for (int j = 0; j < 8; ++j) { v[j] = src[j]; mx = fmaxf(fmaxf(mx, fmaxf(fabsf(v[j].x), fabsf(v[j].y))), fmaxf(fabsf(v[j].z), fabsf(v[j].w))); }
        mx = fmaxf(mx, swz_xor<1>(mx)); mx = fmaxf(mx, swz_xor<2>(mx)); mx = fmaxf(mx, swz_xor<4>(mx)); mx = fmaxf(mx, swz_xor<8>(mx)); mx = fmaxf(mx, swz_xor<16>(mx));
        const float top = 6.0f;
        const float inv = mx > 0.f ? top / mx : 0.f;
        v16f a, b;
#pragma unroll
        for (int j = 0; j < 4; ++j) { a[4 * j] = v[j].x * inv; a[4 * j + 1] = v[j].y * inv; a[4 * j + 2] = v[j].z * inv; a[4 * j + 3] = v[j].w * inv;
                                      b[4 * j] = v[4 + j].x * inv; b[4 * j + 1] = v[4 + j].y * inv; b[4 * j + 2] = v[4 + j].z * inv; b[4 * j + 3] = v[4 + j].w * inv; }
        { unsigned w4[4] = {0u, 0u, 0u, 0u};
#define FP4_ENC(W, SRC, I, SEL) W = __builtin_amdgcn_cvt_scalef32_pk_fp4_f32(W, SRC[2 * (I)], SRC[2 * (I) + 1], 1.0f, SEL);
            FP4_ENC(w4[0], a, 0, 0) FP4_ENC(w4[0], a, 1, 1) FP4_ENC(w4[0], a, 2, 2) FP4_ENC(w4[0], a, 3, 3) FP4_ENC(w4[1], a, 4, 0) FP4_ENC(w4[1], a, 5, 1) FP4_ENC(w4[1], a, 6, 2) FP4_ENC(w4[1], a, 7, 3)
            FP4_ENC(w4[2], b, 0, 0) FP4_ENC(w4[2], b, 1, 1) FP4_ENC(w4[2], b, 2, 2) FP4_ENC(w4[2], b, 3, 3) FP4_ENC(w4[3], b, 4, 0) FP4_ENC(w4[3], b, 5, 1) FP4_ENC(w4[3], b, 6, 2) FP4_ENC(w4[3], b, 7, 3)
#undef FP4_ENC
            *(u32x4*)dst = (u32x4){w4[0], w4[1], w4[2], w4[3]}; }
        if (g == 0) sc[row] = mx / top;
    }
}

__device__ __forceinline__ void ph_peer_expert(const P& p, int li, int Mrows, int bid, int nb, bool dry) {
    using namespace peer;
    typedef float f32x2 __attribute__((ext_vector_type(2)));
    const bf16_t* HQ = (const bf16_t*)(p.ws + WS_HX); const int* IDX = (const int*)(p.ws + WS_IDX); const float* G = (const float*)(p.ws + WS_G);
    const float* X = (const float*)(p.ws + WS_X); const float* MOD = (const float*)(p.ws + WS_MOD);
    float* Xw = dry ? (float*)(p.ws + WS_HF) : (float*)(p.ws + WS_X); bf16_t* HXo = dry ? (bf16_t*)(p.ws + WS_ATT) : (bf16_t*)(p.ws + WS_HX); float* OUTw = dry ? (float*)(p.ws + WS_HF) : p.out;
    const unsigned char* UT = (const unsigned char*)(p.ws + WS_PU); const unsigned char* VT = (const unsigned char*)(p.ws + WS_PV);
    const float* SU = (const float*)(p.ws + WS_SU); const float* SV = (const float*)(p.ws + WS_SV);
    const auto rsU = __builtin_amdgcn_make_buffer_rsrc((void*)UT, 0, 16384 * 512, 0x00020000); const auto rsV = __builtin_amdgcn_make_buffer_rsrc((void*)VT, 0, 16384 * 512, 0x00020000);
    const int tid = otid(), lane = tid & 63, wave = __builtin_amdgcn_readfirstlane(tid >> 6), g = lane & 31, hb = lane >> 5;
    const bool b4 = (lane >> 4) & 1, b3 = (lane >> 3) & 1;
    const int eL = 2 * (2 * (int)b4 + (int)b3) + hb;
        for (int tok = bid * NWAVES + wave; tok < Mrows; tok += nb * NWAVES) {
        f32x2 hv2[16];
        { int g_t = g; asm volatile("" : "+v"(g_t)); const u32x4* hsrc = (const u32x4*)(HQ + (size_t)tok * D + g_t * 32);
#pragma unroll
          for (int j = 0; j < 4; ++j) { const u32x4 hw = hsrc[j]; hv2[4 * j] = (f32x2){pg8::bflo(hw.x), pg8::bfhi(hw.x)}; hv2[4 * j + 1] = (f32x2){pg8::bflo(hw.y), pg8::bfhi(hw.y)};
              hv2[4 * j + 2] = (f32x2){pg8::bflo(hw.z), pg8::bfhi(hw.z)}; hv2[4 * j + 3] = (f32x2){pg8::bflo(hw.w), pg8::bfhi(hw.w)}; } }
        f32x2 y2[16];
#pragma unroll
        for (int k = 0; k < 16; ++k) y2[k] = (f32x2){0.f, 0.f};
        const int* ip = IDX + (size_t)tok * 128; const float* gp = G + (size_t)tok * 128;
        int idx_nx = ip[lane & 7]; u32x4 ud[4]; u32x4 vd[4]; const unsigned goff4 = (unsigned)g * 16u;
#define PEER_ISSUE(dst, RS, idxreg) { _Pragma("unroll") for (int j_ = 0; j_ < 4; ++j_) { const int e0_ = __builtin_amdgcn_readlane(idxreg, 2 * j_), e1_ = __builtin_amdgcn_readlane(idxreg, 2 * j_ + 1); \
            dst[j_] = __builtin_amdgcn_raw_buffer_load_b128(RS, (unsigned)(hb ? e1_ : e0_) * 512u + goff4, 0, 0); } __builtin_amdgcn_sched_barrier(0); }
#define PEER_ISSUE_U(idxreg) { _Pragma("unroll") for (int j_ = 0; j_ < 4; ++j_) { const int e0_ = __builtin_amdgcn_readlane(idxreg, 2 * j_), e1_ = __builtin_amdgcn_readlane(idxreg, 2 * j_ + 1); \
            ud[j_] = __builtin_amdgcn_raw_buffer_load_b128(rsU, (unsigned)(hb ? e1_ : e0_) * 512u + goff4, 0, 0); } __builtin_amdgcn_sched_barrier(0); }
        PEER_ISSUE_U(idx_nx); PEER_ISSUE(vd, rsV, idx_nx);
        for (int hu = 0; hu < 16; ++hu) {
            const int idxL = ip[hu * 8 + eL]; const float gL = gp[hu * 8 + eL] * SV[idxL]; const float suL = SU[idxL];
            if (hu < 15) idx_nx = ip[(hu + 1) * 8 + (lane & 7)];
            float part[4];
#pragma unroll
            for (int j = 0; j < 4; ++j) { const unsigned uw[4] = {ud[j].x, ud[j].y, ud[j].z, ud[j].w}; f32x2 a0 = (f32x2){0.f, 0.f}, a1 = (f32x2){0.f, 0.f};
#define FP4_FMA(ACC, KK, SEL) ACC += hv2[KK] * __builtin_amdgcn_cvt_scalef32_pk_f32_fp4(uw[(KK) >> 2], 1.0f, SEL);
                FP4_FMA(a0, 0, 0) FP4_FMA(a1, 1, 1) FP4_FMA(a0, 2, 2) FP4_FMA(a1, 3, 3) FP4_FMA(a0, 4, 0) FP4_FMA(a1, 5, 1) FP4_FMA(a0, 6, 2) FP4_FMA(a1, 7, 3)
                FP4_FMA(a0, 8, 0) FP4_FMA(a1, 9, 1) FP4_FMA(a0, 10, 2) FP4_FMA(a1, 11, 3) FP4_FMA(a0, 12, 0) FP4_FMA(a1, 13, 1) FP4_FMA(a0, 14, 2) FP4_FMA(a1, 15, 3)
#undef FP4_FMA
                a0 += a1; part[j] = a0.x + a0.y; __builtin_amdgcn_sched_barrier(0); }
            if (hu < 15) PEER_ISSUE_U(idx_nx);
            float s2[2];
#pragma unroll
            for (int k = 0; k < 2; ++k) { const float keep = b4 ? part[k + 2] : part[k], send = b4 ? part[k] : part[k + 2]; s2[k] = keep + swz_xor<16>(send); }
            float s1; { const float keep = b3 ? s2[1] : s2[0], send = b3 ? s2[0] : s2[1]; s1 = keep + swz_xor<8>(send); }
            s1 += swz_xor<4>(s1); s1 += swz_xor<1>(s1); s1 += swz_xor<2>(s1);
            const float wL = lru::fast_gelu(s1 * suL) * gL;
#pragma unroll
            for (int j = 0; j < 4; ++j) {
                const int src0 = ((j >> 1) & 1) * 16 + (j & 1) * 8;
                const float w0 = __uint_as_float(__builtin_amdgcn_readlane(__float_as_uint(wL), src0)), w1 = __uint_as_float(__builtin_amdgcn_readlane(__float_as_uint(wL), src0 + 32));
                const float wk = hb ? w1 : w0;
                const unsigned vw[4] = {vd[j].x, vd[j].y, vd[j].z, vd[j].w}; const f32x2 wk2 = (f32x2){wk, wk};
#define FP4_AXPY(KK, SEL) y2[KK] += wk2 * __builtin_amdgcn_cvt_scalef32_pk_f32_fp4(vw[(KK) >> 2], 1.0f, SEL);
                FP4_AXPY(0, 0) FP4_AXPY(1, 1) FP4_AXPY(2, 2) FP4_AXPY(3, 3) FP4_AXPY(4, 0) FP4_AXPY(5, 1) FP4_AXPY(6, 2) FP4_AXPY(7, 3)
                FP4_AXPY(8, 0) FP4_AXPY(9, 1) FP4_AXPY(10, 2) FP4_AXPY(11, 3) FP4_AXPY(12, 0) FP4_AXPY(13, 1) FP4_AXPY(14, 2) FP4_AXPY(15, 3)
#undef FP4_AXPY
                __builtin_amdgcn_sched_barrier(0); }
            if (hu < 15) PEER_ISSUE(vd, rsV, idx_nx);
        }
#undef PEER_ISSUE
#undef PEER_ISSUE_U
        float ye[16];
        { float yt[32];
#pragma unroll
          for (int k = 0; k < 32; ++k) { const float yk = (k & 1) ? y2[k >> 1].y : y2[k >> 1].x; auto rr = __builtin_amdgcn_permlane32_swap(__float_as_uint(yk), __float_as_uint(yk), false, false); yt[k] = __uint_as_float(rr[0]) + __uint_as_float(rr[1]); }
          float yo[32];
#pragma unroll
          for (int k = 0; k < 32; ++k) yo[k] = yt[k];
          const unsigned hm = 0u - (unsigned)hb;
#pragma unroll
          for (int e = 0; e < 16; ++e) ye[e] = __uint_as_float(msel(__float_as_uint(yo[e]), __float_as_uint(yo[16 + e]), hm)); }
        int lane_e = lane; asm volatile("" : "+v"(lane_e));
        const int ridx = row_mod_idx(tok); const float* g2 = MOD + ((size_t)li * 9 + ridx) * 6144 + 5 * 1024; const int c0 = (lane_e & 31) * 32 + (lane_e >> 5) * 16;
        float xn[16]; float ss = 0.f; const float* xp = X + (size_t)tok * D + c0; float* xw = Xw + (size_t)tok * D + c0;
#pragma unroll
        for (int q = 0; q < 4; ++q) { const float4 xv = *(const float4*)(xp + 4 * q), gg = *(const float4*)(g2 + c0 + 4 * q);
            xn[4 * q] = xv.x + gg.x * ye[4 * q]; xn[4 * q + 1] = xv.y + gg.y * ye[4 * q + 1]; xn[4 * q + 2] = xv.z + gg.z * ye[4 * q + 2]; xn[4 * q + 3] = xv.w + gg.w * ye[4 * q + 3];
            *(float4*)(xw + 4 * q) = make_float4(xn[4 * q], xn[4 * q + 1], xn[4 * q + 2], xn[4 * q + 3]);
            ss += xn[4 * q] * xn[4 * q] + xn[4 * q + 1] * xn[4 * q + 1] + xn[4 * q + 2] * xn[4 * q + 2] + xn[4 * q + 3] * xn[4 * q + 3]; }
        const float rs = rsqrtf(wave_sum(ss) * (1.f / D) + EPS);
        if (li < DEPTH - 1) {
            const float* gN = p.norm1_g + (li + 1) * D; const float* mrow = MOD + ((size_t)(li + 1) * 9 + ridx) * 6144; float o[16];
#pragma unroll
            for (int q = 0; q < 4; ++q) { const float4 gg = *(const float4*)(gN + c0 + 4 * q), sh = *(const float4*)(mrow + c0 + 4 * q), sc = *(const float4*)(mrow + 1024 + c0 + 4 * q);
                o[4 * q] = xn[4 * q] * rs * gg.x * (1.f + sc.x) + sh.x; o[4 * q + 1] = xn[4 * q + 1] * rs * gg.y * (1.f + sc.y) + sh.y;
                o[4 * q + 2] = xn[4 * q + 2] * rs * gg.z * (1.f + sc.z) + sh.z; o[4 * q + 3] = xn[4 * q + 3] * rs * gg.w * (1.f + sc.w) + sh.w; }
            *(u32x4*)(HXo + (size_t)tok * D + c0) = (u32x4){pk2(o[0], o[1]), pk2(o[2], o[3]), pk2(o[4], o[5]), pk2(o[6], o[7])};
            *(u32x4*)(HXo + (size_t)tok * D + c0 + 8) = (u32x4){pk2(o[8], o[9]), pk2(o[10], o[11]), pk2(o[12], o[13]), pk2(o[14], o[15])};
        } else {
            float* op = OUTw + (size_t)tok * D + c0;
#pragma unroll
            for (int q = 0; q < 4; ++q) { const float4 gg = *(const float4*)(p.final_g + c0 + 4 * q);
                *(float4*)(op + 4 * q) = make_float4(xn[4 * q] * rs * gg.x, xn[4 * q + 1] * rs * gg.y, xn[4 * q + 2] * rs * gg.z, xn[4 * q + 3] * rs * gg.w); }
        }
    }
}
template <bool ROPEPERM>
__device__ __forceinline__ void p0_transpose_item(const float* W, int K, int N, bf16_t* WT, LAS float* scr, int item, int lane) {
    const int nblk = N / 32, kb = item / nblk, nbk = item % nblk, k0 = 64 * kb, n0 = 32 * nbk;
#pragma unroll 8
    for (int i = 0; i < 32; ++i) { const int kk = 2 * i + (lane >> 5); scr[kk * 33 + (lane & 31)] = W[(size_t)(k0 + kk) * N + n0 + (lane & 31)]; }
    LDS_WAIT(); asm volatile("" ::: "memory");
    const int c = lane & 7;
#pragma unroll
    for (int j = 0; j < 4; ++j) { const int n = (lane >> 3) + 8 * j; const int ns = ROPEPERM ? ((n & 1) * 16 + (n >> 1)) : n; const LAS float* s = scr + (8 * c) * 33 + ns;
        v4u o; o.x = pk2(s[0 * 33], s[1 * 33]); o.y = pk2(s[2 * 33], s[3 * 33]); o.z = pk2(s[4 * 33], s[5 * 33]); o.w = pk2(s[6 * 33], s[7 * 33]);
        *(GAS v4u*)(WT + (size_t)(n0 + n) * K + k0 + 8 * c) = o; }
    LDS_WAIT(); asm volatile("" ::: "memory");
}

__device__ __forceinline__ void ph_prologue(const P& p, int bid, int nb, unsigned char* lds) {
    const int tid = otid(), lane = tid & 63, wave = tid >> 6; const long gtid = (long)bid * NTHREADS + tid, gsz = (long)nb * NTHREADS;
    float2* R = (float2*)(p.ws + WS_ROPE);
    for (long i = gtid; i < 2048 * 32; i += gsz) { const int t = (int)(i >> 5), j = (int)(i & 31), a = j >> 4, f = j & 15;
        const float pos = a == 0 ? (float)(t >> 6) : (float)(t & 63); const float inv = exp2f(-(float)f * (13.287712379549449f / 16.0f)); const float ang = pos * inv;
        R[i] = make_float2(__cosf(ang), __sinf(ang)); }
    if (gtid < 4) { const int li = (int)gtid; const float* lp = p.diff_lam + li * 4 * 64; float s0 = 0, s1 = 0; for (int d = 0; d < 64; ++d) { s0 += lp[d] * lp[64 + d]; s1 += lp[128 + d] * lp[192 + d]; }
        ((float*)(p.ws + WS_LAM))[li] = expf(s0) - expf(s1) + lambda_init_of(li); }
    { bf16_t* KB = (bf16_t*)(p.ws + WS_KEYS); for (long i = gtid; i < (long)4 * 16 * 128 * 64; i += gsz) KB[i] = f2bf(p.peer_keys[i]); }
    {
        float* s = (float*)lds;
        for (int i = tid; i < 9 * 1024; i += NTHREADS) { const int r = i >> 10, k = i & 1023; const float v = r < 8 ? p.c[r * 1024 + k] : p.c_ctx[k]; s[i] = siluf_(v); }
        __syncthreads();
        float* MODP = (float*)(p.ws + WS_MODP);
        for (int item = bid; item < 8 * 4 * 12; item += nb) {
            const int ks = item / 48, li = (item / 12) & 3, jb = item % 12; const int j = jb * 512 + tid; const float* W = p.mod_w + ((size_t)li * 1024 + ks * 128) * 6144 + j; const float* sk = s + ks * 128;
            float a0 = 0, a1 = 0, a2 = 0, a3 = 0, a4 = 0, a5 = 0, a6 = 0, a7 = 0, a8 = 0;
#pragma unroll 4
            for (int k = 0; k < 128; ++k) { const float w = W[(size_t)k * 6144];
                a0 += sk[k] * w; a1 += sk[1024 + k] * w; a2 += sk[2048 + k] * w; a3 += sk[3072 + k] * w; a4 += sk[4096 + k] * w; a5 += sk[5120 + k] * w; a6 += sk[6144 + k] * w; a7 += sk[7168 + k] * w; a8 += sk[8192 + k] * w; }
            float* o = MODP + ((size_t)(ks * 4 + li) * 9) * 6144 + j;
            o[0 * 6144] = a0; o[1 * 6144] = a1; o[2 * 6144] = a2; o[3 * 6144] = a3; o[4 * 6144] = a4; o[5 * 6144] = a5; o[6 * 6144] = a6; o[7 * 6144] = a7; o[8 * 6144] = a8;
        }
        __syncthreads();
    }
    {
        LAS float* scr = (LAS float*)((LAS unsigned char*)lds + wave * 16384);
        const int gw = bid * NWAVES + wave, NGW = nb * NWAVES;
        constexpr int I_IN = (D / 64) * (DIN / 32), I_SQ = (D / 64) * (D / 32);
        constexpr int PER_L = I_IN + 4 * I_SQ, NITEMS = DEPTH * PER_L;
        for (int it = gw; it < NITEMS; it += NGW) {
            const int li = it / PER_L; int r = it % PER_L;
            if (r < I_IN) { const int nbk = r % (DIN / 32); const bool perm = nbk >= (C_Q / 32) && nbk < (C_V / 32);
                const float* W = p.w_in + (size_t)li * D * DIN; bf16_t* WT = (bf16_t*)(p.ws + WS_WIN_T) + (size_t)li * DIN * D;
                if (perm) p0_transpose_item<true>(W, D, DIN, WT, scr, r, lane); else p0_transpose_item<false>(W, D, DIN, WT, scr, r, lane);
                continue; }
            r -= I_IN; const int which = r / I_SQ; r %= I_SQ;
            const float* W = (which == 0 ? p.w_br_lru : which == 1 ? p.w_br_attn : which == 2 ? p.w_out : p.peer_wq) + (size_t)li * D * D;
            bf16_t* WT = (bf16_t*)(p.ws + (which == 0 ? WS_WBL_T : which == 1 ? WS_WBA_T : which == 2 ? WS_WOUT_T : WS_WQ_T)) + (size_t)li * D * D;
            p0_transpose_item<false>(W, D, D, WT, scr, r, lane);
        }
    }
}
__device__ __forceinline__ void ph_modfin(const P& p, int bid, int nb) {
    const long gtid = (long)bid * NTHREADS + otid(), gsz = (long)nb * NTHREADS; const float* MODP = (const float*)(p.ws + WS_MODP); float* MOD = (float*)(p.ws + WS_MOD);
    for (long i = gtid; i < 4 * 9 * 6144; i += gsz) { const int j = (int)(i % 6144), li = (int)(i / (9 * 6144)); float a = p.mod_b[li * 6144 + j];
#pragma unroll
        for (int ks = 0; ks < 8; ++ks) a += MODP[(size_t)ks * 4 * 9 * 6144 + i];
        MOD[i] = a; }
}

constexpr int NPL = 8;
constexpr int NSTEPS = 3 + DEPTH * NPL;

__device__ __forceinline__ void run_step(const P& p, int s, int bid, int nb, unsigned char* lds) {
    bf16_t* HX = (bf16_t*)(p.ws + WS_HX); bf16_t* PROJ = (bf16_t*)(p.ws + WS_PROJ); bf16_t* LA = (bf16_t*)(p.ws + WS_LA); bf16_t* ATT = (bf16_t*)(p.ws + WS_ATT);
    bf16_t* MIX = (bf16_t*)(p.ws + WS_MIX); bf16_t* PQ = (bf16_t*)(p.ws + WS_PQ); float* X = (float*)(p.ws + WS_X); const float* MOD = (const float*)(p.ws + WS_MOD);
    PG8_LAS unsigned char* glds = (PG8_LAS unsigned char*)lds;
    if (s == 0) { ph_prologue(p, bid, nb, lds);
#if PROBE_CAT == 11
        for (int r2 = 0; r2 < PROBE_N; ++r2) { __syncthreads(); ph_prologue(p, bid, nb, lds); }
#endif
        return; }
    if (s == 1) { ph_modfin(p, bid, nb); return; }
    if (s == 2) { ph_norm(p, bid, nb, p.norm1_g, 0, 0, 1, MT, HX, true); return; }
    const int li = (s - 3) / NPL, ph = (s - 3) % NPL; const bool do_ctx = li < DEPTH - 1; const int Mr = do_ctx ? MT : ML;
    const int extra = (PROBE_CAT != 0 && ph + 1 == PROBE_CAT) ? PROBE_N : 0;
    for (int rep = 0; rep <= extra; ++rep) { const bool dry = rep < extra;
    float* Xo = dry ? (float*)(p.ws + WS_HF) : X;
    switch (ph) {
    case 0: {
        pg8::Gemm g{HX, (const bf16_t*)(p.ws + WS_WIN_T) + (size_t)li * DIN * D, MT, DIN, D}; pg8::StaticOrder S; S.init(MT, DIN, nb, bid);
        pg8::EpiIn E{PROJ, (const float*)(p.ws + WS_ROPE)};
        pg8::gemm_phase<pg8::EpiIn, pg8::StaticOrder, true, true>(glds, g, S, E);
    } break;
    case 1: ph_lru(p, li, bid, nb, lds);
        ph_peer_tables(p, li, bid, nb);
#if PROBE_CAT == 10
        for (int r2 = 0; r2 < PROBE_N; ++r2) ph_lru(p, li, bid, nb, lds);
#endif
        ph_attn(p, li, do_ctx, bid, nb, lds);
#if PROBE_CAT == 9
        for (int r2 = 0; r2 < PROBE_N; ++r2) ph_attn(p, li, do_ctx, bid, nb, lds);
#endif
        break;
    case 2: {
        { pg8::Gemm g{LA, (const bf16_t*)(p.ws + WS_WBL_T) + (size_t)li * D * D, Mr, D, D}; pg8::StaticOrder S; S.init(Mr, D, nb, bid);
          pg8::EpiBr<false> E{PROJ, MIX, C_GA}; pg8::gemm_phase<pg8::EpiBr<false>, pg8::StaticOrder, true, true>(glds, g, S, E); }
        { pg8::Gemm g{ATT, (const bf16_t*)(p.ws + WS_WBA_T) + (size_t)li * D * D, Mr, D, D}; pg8::StaticOrder S; S.init(Mr, D, nb, bid);
          pg8::EpiBr<true> E{PROJ, MIX, C_GB}; pg8::gemm_phase<pg8::EpiBr<true>, pg8::StaticOrder, true, true>(glds, g, S, E); }
    } break;
    case 3: {
        pg8::Gemm g{MIX, (const bf16_t*)(p.ws + WS_WOUT_T) + (size_t)li * D * D, Mr, D, D}; pg8::StaticOrder S; S.init(Mr, D, nb, bid);
        pg8::EpiOut E{li == 0 ? p.x : X, li == 0 ? p.ctx - (size_t)ML * D : X, Xo, MOD + (size_t)li * 9 * 6144 + 2 * 1024};   pg8::gemm_phase<pg8::EpiOut, pg8::StaticOrder, true, true>(glds, g, S, E);
    } break;
    case 4: ph_norm(p, bid, nb, p.norm2_g + li * D, li, 3, 4, Mr, HX, false); break;
    case 5: {
        pg8::Gemm g{HX, (const bf16_t*)(p.ws + WS_WQ_T) + (size_t)li * D * D, Mr, D, D}; pg8::StaticOrder S; S.init(Mr, D, nb, bid);
        pg8::EpiPlain E{PQ}; pg8::gemm_phase<pg8::EpiPlain, pg8::StaticOrder, true, true>(glds, g, S, E);
    } break;
    case 6: ph_peer_score(p, li, Mr, bid, nb); break;
    case 7: ph_peer_expert(p, li, Mr, bid, nb, dry); break;
    }
    }
}

constexpr int RING_BYTES = 155648, LDSCTL_OFF = RING_BYTES, MISC_OFF = LDSCTL_OFF + 320, LDS_BYTES = RING_BYTES + 1024;
constexpr int CW_BAR = 4096;
#ifndef N_LAUNCH_MODE
#define N_LAUNCH_MODE 1
#endif

__global__ void __launch_bounds__(NTHREADS, 2) mega(P p) {
    extern __shared__ __attribute__((aligned(16))) unsigned char lds[];
    const int tid = threadIdx.x;
    for (int u = tid; u < (LDS_BYTES - LDSCTL_OFF) / 4; u += NTHREADS) ((LAS unsigned*)((LAS unsigned char*)lds + LDSCTL_OFF))[u] = 0u;
    __syncthreads();
    volatile LAS unsigned* MISC = (volatile LAS unsigned*)((LAS unsigned char*)lds + MISC_OFF);
    XcdBarrier bar = xcd_barrier_post((unsigned*)(p.ws + WS_CTL) + CW_BAR, MISC + 8);
    const int bid = blockIdx.x, nb = gridDim.x;
    for (int s = p.lo; s < p.hi; ++s) {
        P q = p; int bido = bid, nbo = nb;
        asm volatile("" : "+s"(bido), "+s"(nbo));
        run_step(q, s, bido, nbo, lds);
        if (s + 1 < p.hi) xcd_barrier(bar);
#if PROBE_CAT == 12
        for (int r2 = 0; r2 < PROBE_N; ++r2) xcd_barrier(bar);
#endif
    }
}

extern "C" void kernel_launch(void* const* d_in, const int* in_sizes, int n_in, void* d_out, int out_size, void* d_ws, size_t ws_size, hipStream_t stream) {
    static int grid = 0;
    if (grid == 0) {
        if (n_in != 24 || ws_size < WS_END) { fprintf(stderr, "kernel_launch: n_in %d ws %zu need %zu\n", n_in, ws_size, (size_t)WS_END); grid = -1; return; }
        int dev = 0, cus = 0, per_cu = 0;
        if (hipGetDevice(&dev) != hipSuccess || hipDeviceGetAttribute(&cus, hipDeviceAttributeMultiprocessorCount, dev) != hipSuccess) { grid = -1; return; }
        if (hipFuncSetAttribute((const void*)mega, hipFuncAttributeMaxDynamicSharedMemorySize, LDS_BYTES) != hipSuccess) { fprintf(stderr, "kernel_launch: hipFuncSetAttribute failed\n"); grid = -1; return; }
        if (hipOccupancyMaxActiveBlocksPerMultiprocessor(&per_cu, (const void*)mega, NTHREADS, LDS_BYTES) != hipSuccess || per_cu < 1) { fprintf(stderr, "kernel_launch: occupancy query says %d\n", per_cu); per_cu = 1; }
        (void)hipGetLastError();
        grid = cus > 256 ? 256 : cus;
    }
    if (grid < 0) return;
    (void)hipMemsetAsync((char*)d_ws + WS_CTL, 0, CTL_ZERO_BYTES, stream);
    P p{};
    const float** pp = (const float**)&p;
    for (int i = 0; i < 24; ++i) pp[i] = (const float*)d_in[i];
    p.out = (float*)d_out; p.ws = (unsigned char*)d_ws;
#if N_LAUNCH_MODE == 1
    p.lo = 0; p.hi = NSTEPS; hipLaunchKernelGGL(mega, dim3(grid), dim3(NTHREADS), LDS_BYTES, stream, p);
#else
    for (int s = 0; s < NSTEPS; ++s) { p.lo = s; p.hi = s + 1; hipLaunchKernelGGL(mega, dim3(grid), dim3(NTHREADS), LDS_BYTES, stream, p); }
#endif
}
```
